# Optimizing an MI355X kernel written in HIP

```python
import jax, jax.numpy as jnp
from jax import lax
import numpy as np

D_MODEL = 1024
BATCH = 8
SEQ = 4096
DEPTH = 1

GRID_W = 64
D_MIX = D_MODEL
D_ATTN = D_MIX // 2
D_FOUR = D_MIX - D_ATTN
N_HEADS_A = 8
HEAD_DIM = D_ATTN // N_HEADS_A
WIN_H = 8
WIN_W = 16
N_FOUR_GROUPS = 8
FOUR_GROUP_DIM = D_FOUR // N_FOUR_GROUPS
D_PROJ = 3 * D_ATTN + D_FOUR
N_EXPERT_GROUPS = 4
EXPERTS_PER_GROUP = 8
N_EXPERTS = N_EXPERT_GROUPS * EXPERTS_PER_GROUP
TOP_K_FINE = 2
D_EXPERT = D_MODEL // 4
RMS_EPS = 1e-6

kernel_name = "hymba_natten_fnet_hiermoe_encoder"


def rmsnorm(x, g):
    xf = x.astype(jnp.float32)
    y = xf * lax.rsqrt(jnp.mean(xf * xf, axis=-1, keepdims=True) + RMS_EPS)
    return (y * g.astype(jnp.float32)).astype(x.dtype)


def neighbourhood_attention(q, k, v, rpb):
    b, t, h, dh = q.shape
    rows = t // GRID_W
    kh = min(WIN_H, rows)
    q = q.reshape(b, rows, GRID_W, h, dh)
    k = k.reshape(b, rows, GRID_W, h, dh)
    v = v.reshape(b, rows, GRID_W, h, dh)
    cols = jnp.arange(GRID_W)
    col_start = jnp.clip(cols - WIN_W // 2, 0, GRID_W - WIN_W)
    col_idx = col_start[:, None] + jnp.arange(WIN_W)[None, :]
    dc = col_idx - cols[:, None] + (WIN_W - 1)
    scale = HEAD_DIM ** -0.5

    def row_block(r):
        rs = jnp.clip(r - kh // 2, 0, rows - kh)
        k_rows = lax.dynamic_slice_in_dim(k, rs, kh, axis=1)
        v_rows = lax.dynamic_slice_in_dim(v, rs, kh, axis=1)
        k_win = k_rows[:, :, col_idx]
        v_win = v_rows[:, :, col_idx]
        q_row = lax.dynamic_index_in_dim(q, r, axis=1, keepdims=False)
        s = jnp.einsum('bchd,bicjhd->bhcij', q_row, k_win).astype(jnp.float32) * scale
        dr = rs + jnp.arange(kh) - r + (WIN_H - 1)
        bias = rpb[:, dr[None, :, None], dc[:, None, :]]
        s = s + bias.astype(jnp.float32)[None]
        p = jax.nn.softmax(s.reshape(b, h, GRID_W, kh * WIN_W), axis=-1)
        p = p.reshape(b, h, GRID_W, kh, WIN_W).astype(v.dtype)
        return jnp.einsum('bhcij,bicjhd->bchd', p, v_win)

    o = lax.map(row_block, jnp.arange(rows))
    return jnp.moveaxis(o, 0, 1).reshape(b, t, h * dh)


def fourier_mix(u, w_four, b_four):
    b, t, _ = u.shape
    ug = u.reshape(b, t, N_FOUR_GROUPS, FOUR_GROUP_DIM).astype(jnp.float32)
    f = jnp.fft.fft2(ug, axes=(1, 3), norm="ortho").real
    y = jnp.einsum('btgc,gcd->btgd', f, w_four.astype(jnp.float32)).reshape(b, t, D_FOUR)
    return (y + b_four.astype(jnp.float32)).astype(u.dtype)


def hybrid_mixer(xn, w_in, rpb, w_four, b_four, g_attn_out, g_four_out, w_out):
    b, t, _ = xn.shape
    proj = xn @ w_in
    q, k, v, u = jnp.split(proj, [D_ATTN, 2 * D_ATTN, 3 * D_ATTN], axis=-1)
    q = q.reshape(b, t, N_HEADS_A, HEAD_DIM)
    k = k.reshape(b, t, N_HEADS_A, HEAD_DIM)
    v = v.reshape(b, t, N_HEADS_A, HEAD_DIM)
    o_a = neighbourhood_attention(q, k, v, rpb)
    o_f = fourier_mix(u, w_four, b_four)
    merged = jnp.concatenate([rmsnorm(o_a, g_attn_out), rmsnorm(o_f, g_four_out)], axis=-1)
    return merged @ w_out


def hierarchical_moe(x, w_rc, b_rc, w_rf, b_rf, w_gate, w_up, w_down):
    b, t, d = x.shape
    n = b * t
    xt = x.reshape(n, d)
    coarse = (xt @ w_rc).astype(jnp.float32) + b_rc.astype(jnp.float32)
    coarse_p = jax.nn.softmax(coarse, axis=-1)
    g_w, g_idx = lax.top_k(coarse_p, 1)
    fine = ((xt @ w_rf).astype(jnp.float32) + b_rf.astype(jnp.float32))
    fine = fine.reshape(n, N_EXPERT_GROUPS, EXPERTS_PER_GROUP)
    fine_sel = jnp.take_along_axis(fine, g_idx[:, :, None], axis=1)[:, 0]
    f_val, f_idx = lax.top_k(fine_sel, TOP_K_FINE)
    f_w = jax.nn.softmax(f_val, axis=-1) * g_w
    expert_id = g_idx * EXPERTS_PER_GROUP + f_idx
    combine = jnp.sum(jax.nn.one_hot(expert_id, N_EXPERTS, dtype=jnp.float32)
                      * f_w[..., None], axis=1)
    y = jnp.zeros((n, d), jnp.float32)
    for e in range(N_EXPERTS):
        hdn = jax.nn.silu(xt @ w_gate[e]) * (xt @ w_up[e])
        y = y + combine[:, e:e + 1] * (hdn @ w_down[e]).astype(jnp.float32)
    return y.astype(x.dtype).reshape(b, t, d)


def setup_inputs(seed: int = 0) -> dict:
    key = jax.random.key(seed)
    ks = jax.random.split(key, 18)
    f32 = jnp.float32
    nrm = lambda k, shape, s: jax.random.normal(k, shape, f32) * s
    gain = lambda k, shape: 1.0 + 0.05 * jax.random.normal(k, shape, f32)
    return {
        "x": jax.random.normal(ks[0], (BATCH, SEQ, D_MODEL), f32),
        "norm_mix": gain(ks[1], (DEPTH, D_MODEL)),
        "w_in": nrm(ks[2], (DEPTH, D_MODEL, D_PROJ), D_MODEL ** -0.5),
        "rpb": nrm(ks[3], (DEPTH, N_HEADS_A, 2 * WIN_H - 1, 2 * WIN_W - 1), 0.5),
        "w_four": nrm(ks[4], (DEPTH, N_FOUR_GROUPS, FOUR_GROUP_DIM, FOUR_GROUP_DIM), FOUR_GROUP_DIM ** -0.5),
        "b_four": nrm(ks[5], (DEPTH, D_FOUR), 0.02),
        "g_attn_out": gain(ks[6], (DEPTH, D_ATTN)),
        "g_four_out": gain(ks[7], (DEPTH, D_FOUR)),
        "w_out": nrm(ks[8], (DEPTH, D_MIX, D_MODEL), D_MIX ** -0.5),
        "norm_moe": gain(ks[9], (DEPTH, D_MODEL)),
        "w_router_coarse": nrm(ks[10], (DEPTH, D_MODEL, N_EXPERT_GROUPS), D_MODEL ** -0.5),
        "b_router_coarse": nrm(ks[11], (DEPTH, N_EXPERT_GROUPS), 0.01),
        "w_router_fine": nrm(ks[12], (DEPTH, D_MODEL, N_EXPERTS), D_MODEL ** -0.5),
        "b_router_fine": nrm(ks[13], (DEPTH, N_EXPERTS), 0.01),
        "w_gate": nrm(ks[14], (DEPTH, N_EXPERTS, D_MODEL, D_EXPERT), D_MODEL ** -0.5),
        "w_up": nrm(ks[15], (DEPTH, N_EXPERTS, D_MODEL, D_EXPERT), D_MODEL ** -0.5),
        "w_down": nrm(ks[16], (DEPTH, N_EXPERTS, D_EXPERT, D_MODEL), D_EXPERT ** -0.5),
        "norm_final": gain(ks[17], (D_MODEL,)),
    }


def reference(x, norm_mix, w_in, rpb, w_four, b_four, g_attn_out, g_four_out, w_out,
              norm_moe, w_router_coarse, b_router_coarse, w_router_fine, b_router_fine,
              w_gate, w_up, w_down, norm_final):
    h = x
    for layer in range(DEPTH):
        xn = rmsnorm(h, norm_mix[layer])
        h = h + hybrid_mixer(xn, w_in[layer], rpb[layer], w_four[layer], b_four[layer],
                             g_attn_out[layer], g_four_out[layer], w_out[layer])
        hn = rmsnorm(h, norm_moe[layer])
        h = h + hierarchical_moe(hn, w_router_coarse[layer], b_router_coarse[layer],
                                 w_router_fine[layer], b_router_fine[layer],
                                 w_gate[layer], w_up[layer], w_down[layer])
    return rmsnorm(h, norm_final)
```

```cpp
#include <hip/hip_runtime.h>
#include <cstdint>
#include <cstdio>

namespace {
constexpr int NB = 8, T = 4096, D = 1024, NTOK = NB * T;
constexpr int DA = 512, DF = 512, NH = 8, HD = 64, WH = 8, WW = 16, GW = 64, ROWS = 64;
constexpr int NPROJ = 2048, NEG = 4, EPG = 8, NE = 32, DE = 256;
constexpr float EPS = 1e-6f;
constexpr size_t MiB = 1u << 20;
constexpr size_t WS_A = 0;
constexpr size_t WS_B = 128 * MiB;
constexpr size_t WS_C = 320 * MiB;
constexpr size_t WS_DE = 384 * MiB;
constexpr float PI2 = 6.283185307179586f;

__device__ __forceinline__ float wave_sum(float v) {
#pragma unroll
    for (int o = 1; o < 64; o <<= 1) v += __shfl_xor(v, o);
    return v;
}

__global__ void k_rmsnorm(const float* in, int ldi, const float* g, float* out, int ldo, int ncol, int nrow) {
    int w = (blockIdx.x * blockDim.x + threadIdx.x) >> 6, lane = threadIdx.x & 63;
    if (w >= nrow) return;
    const float* r = in + (size_t)w * ldi;
    float s = 0.f;
    for (int c = lane; c < ncol; c += 64) { float v = r[c]; s += v * v; }
    s = wave_sum(s);
    float rs = 1.0f / sqrtf(s / ncol + EPS);
    float* o = out + (size_t)w * ldo;
    for (int c = lane; c < ncol; c += 64) o[c] = r[c] * rs * g[c];
}

__global__ void __launch_bounds__(256) k_sgemm(const float* A, int lda, const float* B, int ldb, float* C, int ldc, const float* R, int ldr, int M, int N, int K) {
    __shared__ float sA[16][64 + 1];
    __shared__ float sB[16][64 + 1];
    const int tx = threadIdx.x & 15, ty = threadIdx.x >> 4;
    const int m0 = blockIdx.y * 64, n0 = blockIdx.x * 64;
    float acc[4][4] = {};
    for (int k0 = 0; k0 < K; k0 += 16) {
        for (int e = threadIdx.x; e < 64 * 16; e += 256) {
            int r = e >> 4, c = e & 15;
            sA[c][r] = A[(size_t)(m0 + r) * lda + k0 + c];
            int kr = e >> 6, nc = e & 63;
            sB[kr][nc] = B[(size_t)(k0 + kr) * ldb + n0 + nc];
        }
        __syncthreads();
#pragma unroll
        for (int k = 0; k < 16; ++k) {
            float a[4], b[4];
#pragma unroll
            for (int i = 0; i < 4; ++i) { a[i] = sA[k][ty * 4 + i]; b[i] = sB[k][tx * 4 + i]; }
#pragma unroll
            for (int i = 0; i < 4; ++i)
#pragma unroll
                for (int j = 0; j < 4; ++j) acc[i][j] += a[i] * b[j];
        }
        __syncthreads();
    }
#pragma unroll
    for (int i = 0; i < 4; ++i)
#pragma unroll
        for (int j = 0; j < 4; ++j) {
            int m = m0 + ty * 4 + i, n = n0 + tx * 4 + j;
            float v = acc[i][j];
            if (R) v += R[(size_t)m * ldr + n];
            C[(size_t)m * ldc + n] = v;
        }
}

__global__ void k_attn(const float* proj, const float* rpb, float* merged) {
    int w = (blockIdx.x * blockDim.x + threadIdx.x) >> 6, lane = threadIdx.x & 63;
    if (w >= NTOK * NH) return;
    int h = w % NH, tok = w / NH;
    int b = tok / T, t = tok % T, r = t / GW, c = t % GW;
    int rs = min(max(r - WH / 2, 0), ROWS - WH), cs = min(max(c - WW / 2, 0), GW - WW);
    const float* q = proj + (size_t)tok * NPROJ + h * HD;
    float sc[2]; int kt[2];
    for (int e = 0; e < 2; ++e) {
        int kk = lane * 2 + e, i = kk / WW, j = kk % WW;
        int ktok = b * T + (rs + i) * GW + cs + j; kt[e] = ktok;
        const float* k = proj + (size_t)ktok * NPROJ + DA + h * HD;
        float s = 0.f;
        for (int d = 0; d < HD; ++d) s += q[d] * k[d];
        int dr = rs + i - r + (WH - 1), dc = cs + j - c + (WW - 1);
        sc[e] = s * 0.125f + rpb[(h * (2 * WH - 1) + dr) * (2 * WW - 1) + dc];
    }
    float m = fmaxf(sc[0], sc[1]);
#pragma unroll
    for (int o = 1; o < 64; o <<= 1) m = fmaxf(m, __shfl_xor(m, o));
    float p0 = expf(sc[0] - m), p1 = expf(sc[1] - m);
    float l = wave_sum(p0 + p1);
    p0 /= l; p1 /= l;
    float o = 0.f;
    for (int src = 0; src < 64; ++src) {
        float a0 = __shfl(p0, src), a1 = __shfl(p1, src);
        int t0 = __shfl(kt[0], src), t1 = __shfl(kt[1], src);
        o += a0 * proj[(size_t)t0 * NPROJ + 2 * DA + h * HD + lane] + a1 * proj[(size_t)t1 * NPROJ + 2 * DA + h * HD + lane];
    }
    merged[(size_t)tok * D + h * HD + lane] = o;
}

__global__ void k_fft1(const float* proj, float2* X1) {
    size_t idx = (size_t)blockIdx.x * blockDim.x + threadIdx.x;
    if (idx >= (size_t)NB * 64 * 64 * DF) return;
    int c = idx % DF; size_t r = idx / DF; int t2 = r % 64; r /= 64; int k1 = r % 64; int b = r / 64;
    float re = 0.f, im = 0.f;
    for (int t1 = 0; t1 < 64; ++t1) {
        float v = proj[(size_t)(b * T + 64 * t1 + t2) * NPROJ + 3 * DA + c];
        int ph = (t1 * k1) & 63; float ang = PI2 * ph / 64.f;
        re += v * cosf(ang); im -= v * sinf(ang);
    }
    float ang = PI2 * (float)(t2 * k1) / 4096.f; float cs = cosf(ang), sn = -sinf(ang);
    X1[idx] = make_float2(re * cs - im * sn, re * sn + im * cs);
}
__global__ void k_fft2(const float2* X1, float2* Y) {
    size_t idx = (size_t)blockIdx.x * blockDim.x + threadIdx.x;
    if (idx >= (size_t)NB * 64 * 64 * DF) return;
    int c = idx % DF; size_t r = idx / DF; int k1 = r % 64; r /= 64; int k2 = r % 64; int b = r / 64;
    float re = 0.f, im = 0.f;
    for (int t2 = 0; t2 < 64; ++t2) {
        float2 v = X1[((size_t)(b * 64 + k1) * 64 + t2) * DF + c];
        int ph = (t2 * k2) & 63; float ang = PI2 * ph / 64.f; float cs = cosf(ang), sn = -sinf(ang);
        re += v.x * cs - v.y * sn; im += v.x * sn + v.y * cs;
    }
    Y[idx] = make_float2(re, im);
}
__global__ void k_mkab(const float* w_four, float* AB) {
    int idx = blockIdx.x * blockDim.x + threadIdx.x; if (idx >= 8 * 64 * 64) return;
    int d = idx % 64, c = (idx / 64) % 64, g = idx / 4096;
    float a = 0.f, bb = 0.f;
    for (int e = 0; e < 64; ++e) { int ph = (c * e) & 63; float ang = PI2 * ph / 64.f; float wv = w_four[(g * 64 + e) * 64 + d]; a += cosf(ang) * wv; bb += sinf(ang) * wv; }
    AB[(g * 64 + c) * 128 + d] = a / 512.f; AB[(g * 64 + c) * 128 + 64 + d] = bb / 512.f;
}
__global__ void k_mix(const float2* Y, const float* AB, const float* b_four, float* merged) {
    size_t idx = (size_t)blockIdx.x * blockDim.x + threadIdx.x; if (idx >= (size_t)NTOK * DF) return;
    int n = idx % DF; size_t tok = idx / DF; int g = n / 64, d = n % 64;
    float s = b_four[n];
    for (int c = 0; c < 64; ++c) { float2 v = Y[tok * DF + g * 64 + c]; s += v.x * AB[(g * 64 + c) * 128 + d] + v.y * AB[(g * 64 + c) * 128 + 64 + d]; }
    merged[tok * D + DA + n] = s;
}

struct Route { int e0, e1; float w0, w1; };
__global__ void k_router(const float* h, const float* norm_moe, const float* wrc, const float* brc, const float* wrf, const float* brf, Route* route) {
    int w = (blockIdx.x * blockDim.x + threadIdx.x) >> 6, lane = threadIdx.x & 63;
    if (w >= NTOK) return;
    const float* r = h + (size_t)w * D;
    float s = 0.f;
    for (int c = lane; c < D; c += 64) s += r[c] * r[c];
    s = wave_sum(s); float rs = 1.0f / sqrtf(s / D + EPS);
    float lg[36];
#pragma unroll
    for (int j = 0; j < 36; ++j) lg[j] = 0.f;
    for (int c = lane; c < D; c += 64) {
        float v = r[c] * rs * norm_moe[c];
#pragma unroll
        for (int j = 0; j < 4; ++j) lg[j] += v * wrc[c * 4 + j];
#pragma unroll
        for (int j = 0; j < 32; ++j) lg[4 + j] += v * wrf[c * 32 + j];
    }
#pragma unroll
    for (int j = 0; j < 36; ++j) lg[j] = wave_sum(lg[j]);
    {
        float c0 = lg[0] + brc[0], c1 = lg[1] + brc[1], c2 = lg[2] + brc[2], c3 = lg[3] + brc[3];
        int gi = 0; float mx = c0;
        if (c1 > mx) { mx = c1; gi = 1; }
        if (c2 > mx) { mx = c2; gi = 2; }
        if (c3 > mx) { mx = c3; gi = 3; }
        float den = expf(c0 - mx) + expf(c1 - mx) + expf(c2 - mx) + expf(c3 - mx);
        float gw = 1.0f / den;
        float v0 = -1e30f, v1 = -1e30f; int i0 = 0, i1 = 0;
#pragma unroll
        for (int j = 0; j < 8; ++j) {
            float f = 0.f;
#pragma unroll
            for (int g = 0; g < 4; ++g) f = (g == gi) ? (lg[4 + g * 8 + j] + brf[g * 8 + j]) : f;
            if (f > v0) { v1 = v0; i1 = i0; v0 = f; i0 = j; }
            else if (f > v1) { v1 = f; i1 = j; }
        }
        float e1 = expf(v1 - v0); float p0 = 1.f / (1.f + e1), p1 = e1 / (1.f + e1);
        if (lane == 0) { Route ro; ro.e0 = gi * 8 + i0; ro.e1 = gi * 8 + i1; ro.w0 = p0 * gw; ro.w1 = p1 * gw; route[w] = ro; }
    }
}
__global__ void __launch_bounds__(256) k_moe(const float* h, const float* norm_moe, const Route* route, const float* wg, const float* wu, const float* wd, const float* norm_final, float* out) {
    __shared__ float hn[D];
    __shared__ float hd[2][DE];
    __shared__ float red[8];
    int tok = blockIdx.x, tid = threadIdx.x;
    const float* r = h + (size_t)tok * D;
    float s = 0.f;
    for (int c = tid; c < D; c += 256) s += r[c] * r[c];
    s = wave_sum(s); if ((tid & 63) == 0) red[tid >> 6] = s; __syncthreads();
    float tot = red[0] + red[1] + red[2] + red[3]; float rs = 1.0f / sqrtf(tot / D + EPS);
    for (int c = tid; c < D; c += 256) hn[c] = r[c] * rs * norm_moe[c];
    __syncthreads();
    Route ro = route[tok];
    for (int sl = 0; sl < 2; ++sl) {
        int e = sl ? ro.e1 : ro.e0;
        const float* g = wg + (size_t)e * D * DE; const float* u = wu + (size_t)e * D * DE;
        float a = 0.f, b = 0.f;
        for (int k = 0; k < D; ++k) { a += hn[k] * g[(size_t)k * DE + tid]; b += hn[k] * u[(size_t)k * DE + tid]; }
        hd[sl][tid] = (a / (1.f + expf(-a))) * b * (sl ? ro.w1 : ro.w0);
    }
    __syncthreads();
    float o[4]; float ss = 0.f;
    for (int i = 0; i < 4; ++i) {
        int n = tid + 256 * i; float y = 0.f;
        for (int sl = 0; sl < 2; ++sl) { int e = sl ? ro.e1 : ro.e0; const float* dw = wd + (size_t)e * DE * D;
            for (int k = 0; k < DE; ++k) y += hd[sl][k] * dw[(size_t)k * D + n]; }
        o[i] = r[n] + y; ss += o[i] * o[i];
    }
    __syncthreads();
    ss = wave_sum(ss); if ((tid & 63) == 0) red[4 + (tid >> 6)] = ss; __syncthreads();
    float tot2 = red[4] + red[5] + red[6] + red[7]; float rs2 = 1.0f / sqrtf(tot2 / D + EPS);
    for (int i = 0; i < 4; ++i) { int n = tid + 256 * i; out[(size_t)tok * D + n] = o[i] * rs2 * norm_final[n]; }
}
}

extern "C" void kernel_launch(void* const* d_in, const int* in_sizes, int n_in, void* d_out, int out_size, void* d_ws, size_t ws_size, hipStream_t stream) {
    const float* x = (const float*)d_in[0]; const float* norm_mix = (const float*)d_in[1]; const float* w_in = (const float*)d_in[2];
    const float* rpb = (const float*)d_in[3]; const float* w_four = (const float*)d_in[4]; const float* b_four = (const float*)d_in[5];
    const float* g_attn = (const float*)d_in[6]; const float* g_four = (const float*)d_in[7]; const float* w_out = (const float*)d_in[8];
    const float* norm_moe = (const float*)d_in[9]; const float* wrc = (const float*)d_in[10]; const float* brc = (const float*)d_in[11];
    const float* wrf = (const float*)d_in[12]; const float* brf = (const float*)d_in[13]; const float* wg = (const float*)d_in[14];
    const float* wu = (const float*)d_in[15]; const float* wd = (const float*)d_in[16]; const float* norm_final = (const float*)d_in[17];
    char* ws = (char*)d_ws; float* out = (float*)d_out;
    float* xn = (float*)(ws + WS_A); float2* X1 = (float2*)(ws + WS_A);
    float* proj = (float*)(ws + WS_B);
    float2* Y = (float2*)(ws + WS_B);
    float* merged = (float*)(ws + WS_DE);
    float* h = out;
    k_rmsnorm<<<NTOK / 4, 256, 0, stream>>>(x, D, norm_mix, xn, D, D, NTOK);
    k_sgemm<<<dim3(NPROJ / 64, NTOK / 64), 256, 0, stream>>>(xn, D, w_in, NPROJ, proj, NPROJ, nullptr, 0, NTOK, NPROJ, D);
    k_attn<<<NTOK * NH / 4, 256, 0, stream>>>(proj, rpb, merged);
    k_fft1<<<(unsigned)(((size_t)NB * 64 * 64 * DF) / 256), 256, 0, stream>>>(proj, X1);
    k_fft2<<<(unsigned)(((size_t)NB * 64 * 64 * DF) / 256), 256, 0, stream>>>(X1, Y);
    float* AB = (float*)(ws + WS_A); Route* route = (Route*)(ws + WS_A + 1 * MiB);
    k_mkab<<<8 * 64 * 64 / 256, 256, 0, stream>>>(w_four, AB);
    k_mix<<<(unsigned)(((size_t)NTOK * DF) / 256), 256, 0, stream>>>(Y, AB, b_four, merged);
    k_rmsnorm<<<NTOK / 4, 256, 0, stream>>>(merged, D, g_attn, merged, D, DA, NTOK);
    k_rmsnorm<<<NTOK / 4, 256, 0, stream>>>(merged + DA, D, g_four, merged + DA, D, DF, NTOK);
    k_sgemm<<<dim3(D / 64, NTOK / 64), 256, 0, stream>>>(merged, D, w_out, D, h, D, x, D, NTOK, D, D);
    k_router<<<NTOK / 4, 256, 0, stream>>>(h, norm_moe, wrc, brc, wrf, brf, route);
    k_moe<<<NTOK, 256, 0, stream>>>(h, norm_moe, route, wg, wu, wd, norm_final, out);
}
```

```cpp
#include <hip/hip_runtime.h>
#include <cstdint>
#include <cstdio>
namespace pg8 {
#define PG8_LAS __attribute__((address_space(3)))
typedef unsigned short bf16_t;
typedef short bf16x8 __attribute__((ext_vector_type(8)));
typedef float f32x4 __attribute__((ext_vector_type(4)));
typedef unsigned u32x4 __attribute__((ext_vector_type(4)));
constexpr int BM = 256, BK = 64, HALF = 128, HTB = HALF * BK * 2  , STAGE_BYTES = 8 * HTB, NXCD = 8, WGM = 8;

__host__ __device__ __forceinline__ int lds_byte(int r, int c) { const int st = (r >> 4) * 2 + (c >> 5), rr = r & 15, cc = c & 31, ob = rr * 64 + cc * 2; return st * 1024 + (ob ^ (((ob >> 9) & 1) << 5)); }
__host__ __device__ __forceinline__ void stage_rc(int b, int& R, int& C) { const int st = b / 1024, sb = b % 1024, swz = sb ^ (((sb >> 9) & 1) << 5); R = (st >> 1) * 16 + swz / 64; C = (st & 1) * 32 + (swz % 64) / 2; }
__host__ __device__ __forceinline__ int perm32(int rho) { const int n = rho >> 4, i = rho & 15; return 8 * (i >> 2) + 4 * n + (i & 3); }

struct Unit { int pm, pn; };
struct Gemm { const bf16_t* A; const bf16_t* Bt; int M, N, K; };

struct StaticOrder {
    int nM, nN, nwg, G, c;
    __host__ __device__ void init(int M, int N, int G_, int c_) { nM = M / BM; nN = N / BM; nwg = nM * nN; G = G_; c = c_; }
    __host__ __device__ bool next(int i, Unit& u) const {
        const long L = (long)i * G + c; if (L >= nwg) return false;
        int wgid = (int)L; { const int q = nwg / NXCD, r = nwg % NXCD, xcd = wgid % NXCD, off = wgid / NXCD; wgid = (xcd < r ? xcd * (q + 1) : r * (q + 1) + (xcd - r) * q) + off; }
        const int nig = WGM * nN, gid = wgid / nig, fm = gid * WGM, gsz = (nM - fm) < WGM ? (nM - fm) : WGM;
        u.pm = fm + ((wgid % nig) % gsz); u.pn = (wgid % nig) / gsz; return true;
    }
    __device__ __forceinline__ void a_ready(const Unit&) const {}
    __device__ __forceinline__ void done(const Unit&) const {}
};

__device__ __forceinline__ unsigned cvt_pk_bf16(float lo, float hi) { unsigned r; asm volatile("v_cvt_pk_bf16_f32 %0, %1, %2" : "=v"(r) : "v"(lo), "v"(hi)); return r; }
typedef float f32x2 __attribute__((ext_vector_type(2)));
struct EpiBf16 {
    static constexpr bool PERM = true, AFTER_DRAIN = false;
    bf16_t* O; int ldc; int split_cols; size_t split_stride; float scale0;
    __device__ __forceinline__ void operator()(const f32x4 (&acc)[2][2][4][2], const Unit& u, int wr, int wc, int fr, int fq) const {
        const int row0 = u.pm * BM + wr * 64 + fr; int colt = u.pn * BM; bf16_t* base = O;
        float sc = 1.f; { const int t = colt / split_cols; base += (size_t)t * split_stride; colt -= t * split_cols; if (t == 0) sc = scale0; }
        const int col0 = colt + wc * 32 + 8 * fq;
#pragma unroll
        for (int ai = 0; ai < 2; ++ai)
#pragma unroll
            for (int m = 0; m < 4; ++m) { bf16_t* rowp = base + (size_t)(row0 + ai * HALF + m * 16) * ldc + col0;
#pragma unroll
                for (int bj = 0; bj < 2; ++bj) { f32x4 v0 = acc[ai][bj][m][0] * sc, v1 = acc[ai][bj][m][1] * sc;
                    u32x4 w; w.x = cvt_pk_bf16(v0[0], v0[1]); w.y = cvt_pk_bf16(v0[2], v0[3]); w.z = cvt_pk_bf16(v1[0], v1[1]); w.w = cvt_pk_bf16(v1[2], v1[3]);
                    *(u32x4*)(rowp + bj * HALF) = w; } }
    }
};
struct EpiResH {
    static constexpr bool PERM = true, AFTER_DRAIN = false;
    const float* x; bf16_t* h;
    __device__ __forceinline__ void operator()(const f32x4 (&acc)[2][2][4][2], const Unit& u, int wr, int wc, int fr, int fq) const {
        const int row0 = u.pm * BM + wr * 64 + fr, col0 = u.pn * BM + wc * 32 + 8 * fq;
#pragma unroll
        for (int ai = 0; ai < 2; ++ai)
#pragma unroll
            for (int m = 0; m < 4; ++m) { const size_t off = (size_t)(row0 + ai * HALF + m * 16) * 1024 + col0;
#pragma unroll
                for (int bj = 0; bj < 2; ++bj) { const f32x4 xa = *(const f32x4*)(x + off + bj * HALF), xb = *(const f32x4*)(x + off + bj * HALF + 4);
                    const f32x4 v0 = acc[ai][bj][m][0] + xa, v1 = acc[ai][bj][m][1] + xb;
                    u32x4 w; w.x = cvt_pk_bf16(v0[0], v0[1]); w.y = cvt_pk_bf16(v0[2], v0[3]); w.z = cvt_pk_bf16(v1[0], v1[1]); w.w = cvt_pk_bf16(v1[2], v1[3]);
                    *(u32x4*)(h + off + bj * HALF) = w; } }
    }
};
struct EpiMoe1 {
    static constexpr bool PERM = true, AFTER_DRAIN = false;
    const float* rstd_s; const float* w_s; bf16_t* hd;
    __device__ __forceinline__ void operator()(const f32x4 (&acc)[2][2][4][2], const Unit& u, int wr, int wc, int fr, int fq) const {
        const int row0 = u.pm * BM + wr * 64 + fr, col0 = (u.pn & 1) * HALF + wc * 32 + 8 * fq;
#pragma unroll
        for (int ai = 0; ai < 2; ++ai)
#pragma unroll
            for (int m = 0; m < 4; ++m) { const int row = row0 + ai * HALF + m * 16; const float rs = rstd_s[row], wv = w_s[row];
                float o[8];
#pragma unroll
                for (int n = 0; n < 2; ++n)
#pragma unroll
                    for (int j = 0; j < 4; ++j) { const float g = acc[ai][0][m][n][j] * rs, uu = acc[ai][1][m][n][j] * rs;
                        o[n * 4 + j] = g * __builtin_amdgcn_rcpf(1.0f + __builtin_amdgcn_exp2f(-1.4426950408889634f * g)) * uu * wv; }
                u32x4 w; w.x = cvt_pk_bf16(o[0], o[1]); w.y = cvt_pk_bf16(o[2], o[3]); w.z = cvt_pk_bf16(o[4], o[5]); w.w = cvt_pk_bf16(o[6], o[7]);
                *(u32x4*)(hd + (size_t)row * 256 + col0) = w; }
    }
};
struct EpiMoe2 {
    static constexpr bool PERM = true, AFTER_DRAIN = false;
    const int* slotrow_s; bf16_t* y2;
    __device__ __forceinline__ void operator()(const f32x4 (&acc)[2][2][4][2], const Unit& u, int wr, int wc, int fr, int fq) const {
        const int row0 = u.pm * BM + wr * 64 + fr, col0 = (u.pn & 3) * BM + wc * 32 + 8 * fq;
#pragma unroll
        for (int ai = 0; ai < 2; ++ai)
#pragma unroll
            for (int m = 0; m < 4; ++m) { const int sr = slotrow_s[row0 + ai * HALF + m * 16];
                bf16_t* rowp = y2 + (size_t)sr * 1024 + col0;
#pragma unroll
                for (int bj = 0; bj < 2; ++bj) { const f32x4 v0 = acc[ai][bj][m][0], v1 = acc[ai][bj][m][1];
                    u32x4 w; w.x = cvt_pk_bf16(v0[0], v0[1]); w.y = cvt_pk_bf16(v0[2], v0[3]); w.z = cvt_pk_bf16(v1[0], v1[1]); w.w = cvt_pk_bf16(v1[2], v1[3]);
                    *(u32x4*)(rowp + bj * HALF) = w; }
                asm volatile("" ::: "memory"); }
    }
};
struct MoeOrder {
    const PG8_LAS int* pbase; int ntn, G, c;
    __device__ __forceinline__ bool next(int i, Unit& u) const {
        const int L = i * G + c; const int total = pbase[32] * ntn; if (L >= total) return false;
        const int pm = L / ntn, pl = L - pm * ntn; int e = 0;
#pragma unroll 1
        for (int j = 1; j < 32; ++j) e += (pbase[j] <= pm) ? 1 : 0;
        u.pm = pm; u.pn = e * ntn + pl; return true;
    }
    __device__ __forceinline__ void a_ready(const Unit&) const {}
    __device__ __forceinline__ void done(const Unit&) const {}
};
template <class Epi, class Sched, bool ALIGN_EPI = false, bool SP2 = false>
__device__ __forceinline__ void gemm_phase(PG8_LAS unsigned char* lds, const Gemm g, const Sched& S, const Epi& E) {
    int tid_ = threadIdx.x; asm volatile("" : "+v"(tid_));
    const int tid = tid_, wid = __builtin_amdgcn_readfirstlane(tid >> 6), lane = tid & 63, wr = wid >> 2, wc = wid & 3, fr = lane & 15, fq = lane >> 4;
    const int K = g.K; int nt_ = K / BK; asm volatile("" : "+s"(nt_)); const int nt = nt_;
    unsigned voffA[2], voffB[2];
#pragma unroll
    for (int i = 0; i < 2; ++i) { int R, C; stage_rc(tid * 16 + i * 8192, R, C); const int Rb = Epi::PERM ? ((R & ~31) + perm32(R & 31)) : R;
        voffA[i] = (unsigned)(R * K + C) * 2u; voffB[i] = (unsigned)(Rb * K + C) * 2u; }
    const size_t kstep = (size_t)(BK * 2);
    const size_t hstep = (size_t)HALF * K * 2;
    const size_t tstep = 2 * hstep;
    const unsigned ldsw = (unsigned)wid * 1024u;
    const int aoff = lds_byte(wr * 64 + fr, fq * 8), boff = lds_byte(wc * 32 + fr, fq * 8);
#define PG8_SA(b, h) (((b) * 2 + (h)) * HTB)
#define PG8_SB(b, h) ((4 + (b) * 2 + (h)) * HTB)
#define PG8_STAGE(bufoff, gbase, voff) do { _Pragma("unroll") for (int _i = 0; _i < 2; ++_i) \
        __builtin_amdgcn_global_load_lds((const unsigned*)((const char*)(gbase) + (voff)[_i]), (PG8_LAS unsigned*)(lds + (bufoff) + ldsw + _i * 8192), 16, 0, 0); } while (0)
#define PG8_LDA(dst, b, h) do { _Pragma("unroll") for (int m = 0; m < 4; ++m) _Pragma("unroll") for (int k = 0; k < 2; ++k) dst[m][k] = *(const PG8_LAS bf16x8*)(lds + PG8_SA(b, h) + aoff + m * 2048 + k * 1024); } while (0)
#define PG8_LDB(dst, b, h) do { _Pragma("unroll") for (int n = 0; n < 2; ++n) _Pragma("unroll") for (int k = 0; k < 2; ++k) dst[n][k] = *(const PG8_LAS bf16x8*)(lds + PG8_SB(b, h) + boff + n * 2048 + k * 1024); } while (0)
#define PG8_MMA(ai, bj, At, Bt) do { __builtin_amdgcn_s_setprio(1); _Pragma("unroll") for (int m = 0; m < 4; ++m) _Pragma("unroll") for (int n = 0; n < 2; ++n) _Pragma("unroll") for (int k = 0; k < 2; ++k) \
        acc[ai][bj][m][n] = __builtin_amdgcn_mfma_f32_16x16x32_bf16(Bt[n][k], At[m][k], acc[ai][bj][m][n], 0, 0, 0); __builtin_amdgcn_s_setprio(0); } while (0)
#define PG8_WAIT_V(n) asm volatile("s_waitcnt vmcnt(" #n ")" ::: "memory")
#define PG8_WAIT_L(n) asm volatile("s_waitcnt lgkmcnt(" #n ")" ::: "memory")
#define PG8_BAR __builtin_amdgcn_s_barrier()
#define PG8_SCHED __builtin_amdgcn_sched_barrier(0)
    Unit cur, nxt; int ui = 0;
    if (!S.next(0, cur)) return;
    f32x4 acc[2][2][4][2];
#pragma unroll
    for (int a = 0; a < 2; ++a)
#pragma unroll
        for (int b = 0; b < 2; ++b)
#pragma unroll
            for (int m = 0; m < 4; ++m)
#pragma unroll
                for (int n = 0; n < 2; ++n) acc[a][b][m][n] = (f32x4){0.f, 0.f, 0.f, 0.f};
    bf16x8 At[4][2], B0[2][2], B1[2][2];
    const char* cA = (const char*)g.A + (size_t)cur.pm * tstep; const char* cB = (const char*)g.Bt + (size_t)cur.pn * tstep;
    S.a_ready(cur);
    if constexpr (SP2) {
        PG8_STAGE(PG8_SB(0, 0), cB, voffB); PG8_STAGE(PG8_SB(0, 1), cB + hstep, voffB); PG8_STAGE(PG8_SA(0, 0), cA, voffA); PG8_STAGE(PG8_SA(0, 1), cA + hstep, voffA);
        if (wr == 1) PG8_BAR;
        PG8_WAIT_V(2); PG8_BAR;
        PG8_STAGE(PG8_SB(1, 0), cB + kstep, voffB); PG8_STAGE(PG8_SA(1, 0), cA + kstep, voffA); PG8_STAGE(PG8_SB(1, 1), cB + hstep + kstep, voffB);
        PG8_WAIT_V(6); PG8_BAR;
    } else {
        PG8_STAGE(PG8_SB(0, 0), cB, voffB); PG8_STAGE(PG8_SA(0, 0), cA, voffA); PG8_STAGE(PG8_SB(0, 1), cB + hstep, voffB); PG8_STAGE(PG8_SA(0, 1), cA + hstep, voffA);
        if (wr == 1) PG8_BAR;
        PG8_WAIT_V(4); PG8_BAR;
        PG8_STAGE(PG8_SB(1, 0), cB + kstep, voffB); PG8_STAGE(PG8_SA(1, 0), cA + kstep, voffA); PG8_STAGE(PG8_SB(1, 1), cB + hstep + kstep, voffB);
        PG8_WAIT_V(6); PG8_BAR;
    }
    for (;;) {
        const bool has_next = S.next(ui + 1, nxt);
        const char* nA = has_next ? (const char*)g.A + (size_t)nxt.pm * tstep : cA; const char* nB = has_next ? (const char*)g.Bt + (size_t)nxt.pn * tstep : cB;
        for (int t = 0; t < nt; t += 2) {
            const bool last = (t == nt - 2);
            const char* a1 = cA + (size_t)(t + 1) * kstep;
            const char* a2 = last ? nA : cA + (size_t)(t + 2) * kstep; const char* b2 = last ? nB : cB + (size_t)(t + 2) * kstep;
            const char* a3 = a2 + kstep; const char* b3 = b2 + kstep;
            if (last && has_next) S.a_ready(nxt);
            if constexpr (SP2) {
            PG8_LDB(B0, 0, 0); PG8_LDB(B1, 0, 1); PG8_SCHED; PG8_LDA(At, 0, 0); PG8_STAGE(PG8_SA(1, 1), a1 + hstep, voffA);
            PG8_WAIT_V(8); PG8_WAIT_L(0); PG8_BAR; PG8_MMA(0, 0, At, B0); PG8_MMA(0, 1, At, B1); PG8_BAR; PG8_SCHED;
            PG8_LDA(At, 0, 1); PG8_STAGE(PG8_SB(0, 0), b2, voffB); PG8_STAGE(PG8_SB(0, 1), b2 + hstep, voffB); PG8_STAGE(PG8_SA(0, 0), a2, voffA);
            PG8_WAIT_V(8); PG8_WAIT_L(0); PG8_BAR; PG8_MMA(1, 0, At, B0); PG8_MMA(1, 1, At, B1); PG8_BAR; PG8_SCHED;
            PG8_LDB(B0, 1, 0); PG8_LDB(B1, 1, 1); PG8_SCHED; PG8_LDA(At, 1, 0); PG8_STAGE(PG8_SA(0, 1), a2 + hstep, voffA);
            PG8_WAIT_V(8); PG8_WAIT_L(0); PG8_BAR; PG8_MMA(0, 0, At, B0); PG8_MMA(0, 1, At, B1); PG8_BAR; PG8_SCHED;
            PG8_LDA(At, 1, 1); PG8_STAGE(PG8_SB(1, 0), b3, voffB); PG8_STAGE(PG8_SB(1, 1), b3 + hstep, voffB); PG8_STAGE(PG8_SA(1, 0), a3, voffA);
            PG8_WAIT_V(8); PG8_WAIT_L(0); PG8_BAR; PG8_MMA(1, 0, At, B0); PG8_MMA(1, 1, At, B1); PG8_BAR; PG8_SCHED;
            } else {
            PG8_LDB(B0, 0, 0); PG8_SCHED; PG8_LDA(At, 0, 0); PG8_STAGE(PG8_SA(1, 1), a1 + hstep, voffA);
            PG8_WAIT_L(8); PG8_BAR; PG8_WAIT_L(0); PG8_MMA(0, 0, At, B0); PG8_BAR; PG8_SCHED;
            PG8_LDB(B1, 0, 1); PG8_STAGE(PG8_SB(0, 0), b2, voffB);
            PG8_BAR; PG8_WAIT_L(0); PG8_MMA(0, 1, At, B1); PG8_BAR;
            PG8_LDA(At, 0, 1); PG8_STAGE(PG8_SA(0, 0), a2, voffA);
            PG8_BAR; PG8_WAIT_L(0); PG8_MMA(1, 0, At, B0); PG8_BAR; PG8_SCHED;
            PG8_STAGE(PG8_SB(0, 1), b2 + hstep, voffB);
            PG8_WAIT_V(6); PG8_BAR; PG8_MMA(1, 1, At, B1); PG8_BAR;
            PG8_LDB(B0, 1, 0); PG8_SCHED; PG8_LDA(At, 1, 0); PG8_STAGE(PG8_SA(0, 1), a2 + hstep, voffA);
            PG8_WAIT_L(8); PG8_BAR; PG8_WAIT_L(0); PG8_MMA(0, 0, At, B0); PG8_BAR; PG8_SCHED;
            PG8_LDB(B1, 1, 1); PG8_STAGE(PG8_SB(1, 0), b3, voffB);
            PG8_BAR; PG8_WAIT_L(0); PG8_MMA(0, 1, At, B1); PG8_BAR;
            PG8_LDA(At, 1, 1); PG8_STAGE(PG8_SA(1, 0), a3, voffA);
            PG8_BAR; PG8_WAIT_L(0); PG8_MMA(1, 0, At, B0); PG8_BAR; PG8_SCHED;
            PG8_STAGE(PG8_SB(1, 1), b3 + hstep, voffB);
            PG8_WAIT_V(6); PG8_BAR; PG8_MMA(1, 1, At, B1); PG8_BAR;
            }
        }
        if constexpr (ALIGN_EPI) { if (wr == 0) PG8_BAR; }
        if constexpr (!Epi::AFTER_DRAIN) { E(acc, cur, wr, wc, fr, fq); S.done(cur); }
        if (!has_next) break;
#pragma unroll
        for (int a = 0; a < 2; ++a)
#pragma unroll
            for (int b = 0; b < 2; ++b)
#pragma unroll
                for (int m = 0; m < 4; ++m)
#pragma unroll
                    for (int n = 0; n < 2; ++n) acc[a][b][m][n] = (f32x4){0.f, 0.f, 0.f, 0.f};
        cur = nxt; cA = nA; cB = nB; ++ui;
        if constexpr (ALIGN_EPI) { if (wr == 1) PG8_BAR; }
    }
    PG8_WAIT_V(0);
    if constexpr (!ALIGN_EPI) { if (wr == 0) PG8_BAR; }
    PG8_BAR;
    if constexpr (Epi::AFTER_DRAIN) { E.fused(acc, cur, wr, wc, fr, fq, lds, wid, lane); S.done(cur); }
#undef PG8_SA
#undef PG8_SB
#undef PG8_STAGE
#undef PG8_LDA
#undef PG8_LDB
#undef PG8_MMA
#undef PG8_WAIT_V
#undef PG8_WAIT_L
#undef PG8_BAR
#undef PG8_SCHED
}
}
constexpr int NWAVES = 8;
constexpr int NB = 8, T = 4096, D = 1024, NTOK = NB * T;
constexpr int DA = 512, DF = 512, NH = 8, HD = 64, GW = 64, ROWS = 64, WH = 8, WW = 16;
constexpr int NPROJ = 2048, NE = 32, DE = 256;
constexpr int MAXROWS = 73728;
constexpr float EPS = 1e-6f, LOG2E = 1.4426950408889634f, QSCALE = 0.125f * LOG2E;
constexpr size_t MiB = 1u << 20;
constexpr size_t WS_CTL = 0, CTL_ZERO_BYTES = 1 * MiB;
constexpr size_t WS_WIN = 2 * MiB, WS_WOUT = 6 * MiB, WS_WGU = 8 * MiB, WS_WD = 40 * MiB, WS_WR = 56 * MiB, WS_AB = 57 * MiB;
constexpr size_t WS_ROUTE = 58 * MiB;
constexpr size_t WS_META = 59 * MiB;
constexpr size_t WS_XN = 64 * MiB;
constexpr size_t WS_QKVU = 128 * MiB;
constexpr size_t WS_X1 = 256 * MiB;
constexpr size_t WS_MF = 384 * MiB;
constexpr size_t WS_HD = 388 * MiB;
constexpr size_t WS_END = 512 * MiB;
constexpr int CW_BAR = 4096, CW_CNT = 16384;
constexpr int RING_BYTES = 131072, RT_BYTES = 36 * 1024 * 4  , LDSCTL_OFF = 147456, LDS_BYTES = 155648;
constexpr int L_MISC = LDSCTL_OFF;
constexpr int L_PBASE = LDSCTL_OFF + 256;
constexpr int L_LCNT = LDSCTL_OFF + 512;
constexpr int L_GBASE = LDSCTL_OFF + 768;
constexpr int L_RT = LDSCTL_OFF + 1024;
constexpr int L_LGS = LDSCTL_OFF + 3072;
static_assert(L_LGS + 8 * 72 * 4 <= LDS_BYTES, "LDS map");
static_assert(RT_BYTES <= LDSCTL_OFF && L_RT + 4 * 128 * 4 <= LDS_BYTES, "LDS map");

#define LAS __attribute__((address_space(3)))
typedef unsigned short bf16;
typedef unsigned v4u __attribute__((ext_vector_type(4)));
typedef unsigned v2u __attribute__((ext_vector_type(2)));
typedef float f32x4 __attribute__((ext_vector_type(4)));
#define LDS_WAIT() asm volatile("s_waitcnt lgkmcnt(0)" ::: "memory")
#define VM_WAIT() asm volatile("s_waitcnt vmcnt(0)" ::: "memory")
__device__ __forceinline__ unsigned f2bf(float f) { unsigned u = __builtin_bit_cast(unsigned, f); return (u + 0x7fffu + ((u >> 16) & 1u)) >> 16; }
__device__ __forceinline__ unsigned pk2(float lo, float hi) { return f2bf(lo) | (f2bf(hi) << 16); }
__device__ __forceinline__ float bf2f(unsigned short b) { return __builtin_bit_cast(float, (unsigned)b << 16); }
__device__ __forceinline__ float bflo(unsigned w) { return __builtin_bit_cast(float, w << 16); }
__device__ __forceinline__ float bfhi(unsigned w) { return __builtin_bit_cast(float, w & 0xffff0000u); }
__device__ __forceinline__ float wave_sum(float v) {
#pragma unroll
    for (int o = 1; o < 64; o <<= 1) v += __shfl_xor(v, o);
    return v;
}
#define XB_TMO      128
#define XB_XCNT(j)  (256  + 64 * (j))
#define XB_XSUB(j)  (1280 + 64 * (j))
#define XB_XGEN(j)  (2304 + 64 * (j))
#define XB_TOP      3328
#define XB_TOPGEN   3392
#define XCD_BAR_WORDS 3456
#define XB_SPIN_CAP (1u << 18)

__device__ __forceinline__ unsigned xb_ld(unsigned* p)              { return __hip_atomic_load(p, __ATOMIC_RELAXED, __HIP_MEMORY_SCOPE_AGENT); }
__device__ __forceinline__ unsigned xb_add(unsigned* p, unsigned v) { return __hip_atomic_fetch_add(p, v, __ATOMIC_RELAXED, __HIP_MEMORY_SCOPE_AGENT); }
__device__ __forceinline__ unsigned xb_xcc_id() { return (unsigned)__builtin_amdgcn_s_getreg((3 << 11) | 20) & 0xFu; }
#define XB_SPIN(cond, bar) do { unsigned _sp = 0; while (cond) { __builtin_amdgcn_s_sleep(1); \
    if ((++_sp & 255u) == 0u) { if (xb_ld(&(bar)[XB_TMO])) break; if (_sp > XB_SPIN_CAP) { atomicAdd(&(bar)[XB_TMO], 1u); break; } } } } while (0)

struct XcdBarrier {
    unsigned* bar; unsigned x;
    volatile LAS unsigned* st;
};

__device__ __forceinline__ XcdBarrier xcd_barrier_post(unsigned* bar, volatile LAS unsigned* st) {
    XcdBarrier b; b.bar = bar; b.x = xb_xcc_id(); b.st = st;
    if (threadIdx.x == 0) (void)xb_add(&bar[XB_XCNT(b.x)], 1u);
    return b;
}
__device__ __forceinline__ void xcd_barrier_complete(unsigned* bar, unsigned x, unsigned& nloc, unsigned& nx) {
    const unsigned G = gridDim.x * gridDim.y * gridDim.z;
    unsigned sum, cnt, mine, sp = 0u;
    for (;;) {
        sum = 0u; cnt = 0u; mine = 0u;
#pragma unroll
        for (unsigned j = 0; j < 16; ++j) { const unsigned c = xb_ld(&bar[XB_XCNT(j)]); sum += c; cnt += (c > 0u) ? 1u : 0u; mine = (j == x) ? c : mine; }
        if (sum == G) break;
        __builtin_amdgcn_s_sleep(1);
        if ((++sp & 255u) == 0u) { if (xb_ld(&bar[XB_TMO])) break; if (sp > XB_SPIN_CAP) { atomicAdd(&bar[XB_TMO], 1u); break; } }
    }
    nloc = mine > 0u ? mine : 1u; nx = cnt > 0u ? cnt : 1u;
}

__device__ __forceinline__ void xcd_barrier(const XcdBarrier& b) {
    asm volatile("s_waitcnt vmcnt(0)" ::: "memory");
    __syncthreads();
    if (threadIdx.x == 0) {
        unsigned* bar = b.bar;
        __builtin_amdgcn_s_waitcnt(0);
        unsigned nloc = b.st[0], nx = b.st[1];
        if (nloc == 0u) { xcd_barrier_complete(bar, b.x, nloc, nx); b.st[0] = nloc; b.st[1] = nx; }
        const unsigned old = xb_add(&bar[XB_XSUB(b.x)], 1u);
        const unsigned gen = old / nloc;
        if (old + 1u == (gen + 1u) * nloc) {
            __builtin_amdgcn_fence(__ATOMIC_RELEASE, "agent");
            asm volatile("s_waitcnt vmcnt(0)" ::: "memory");
            const unsigned og = xb_add(&bar[XB_TOP], 1u);
            const unsigned tg = og / nx;
            if (og + 1u == (tg + 1u) * nx) xb_add(&bar[XB_TOPGEN], 1u);
            else XB_SPIN(xb_ld(&bar[XB_TOPGEN]) == tg, bar);
            __builtin_amdgcn_fence(__ATOMIC_ACQUIRE, "agent");
            xb_add(&bar[XB_XGEN(b.x)], 1u);
            asm volatile("s_waitcnt vmcnt(0)" ::: "memory");
        } else {
            XB_SPIN(xb_ld(&bar[XB_XGEN(b.x)]) == gen, bar);
            __builtin_amdgcn_fence(__ATOMIC_ACQUIRE, "agent");
            asm volatile("s_waitcnt vmcnt(0)" ::: "memory");
        }
    }
    __syncthreads();
}
struct Args { const float* in[18]; float* out; unsigned char* ws; };
struct Frame {
    LAS unsigned char* lds; unsigned* ctl; unsigned char* ws; float* out;
    int tid, lane, wave, vcu, G;
};
#define GW_ID(F) ((F).vcu * NWAVES + (F).wave)
#define N_GW(F) ((F).G * NWAVES)

__device__ __forceinline__ void tr_item(const float* W, int K, int N, bf16* WT, int drow, const float* kscale, LAS float* scr, int k0, int n0, int lane) {
#pragma unroll 8
    for (int i = 0; i < 32; ++i) { const int kk = 2 * i + (lane >> 5); float v = W[(size_t)(k0 + kk) * N + n0 + (lane & 31)]; if (kscale) v *= kscale[k0 + kk]; scr[kk * 33 + (lane & 31)] = v; }
    LDS_WAIT(); asm volatile("" ::: "memory");
    const int c = lane & 7;
#pragma unroll
    for (int j = 0; j < 4; ++j) { const int n = (lane >> 3) + 8 * j; const LAS float* s = scr + (8 * c) * 33 + n;
        v4u o; o.x = pk2(s[0 * 33], s[1 * 33]); o.y = pk2(s[2 * 33], s[3 * 33]); o.z = pk2(s[4 * 33], s[5 * 33]); o.w = pk2(s[6 * 33], s[7 * 33]);
        *(v4u*)(WT + (size_t)(drow + n) * K + k0 + 8 * c) = o; }
    LDS_WAIT(); asm volatile("" ::: "memory");
}
__device__ __forceinline__ void phase_prep(Frame& F, const Args& A) {
    LAS float* scr = (LAS float*)(F.lds + F.wave * 16384);
    const int gw = GW_ID(F), NGW = N_GW(F), lane = F.lane;
    bf16* WinT = (bf16*)(F.ws + WS_WIN); bf16* WoutT = (bf16*)(F.ws + WS_WOUT); bf16* Wgu = (bf16*)(F.ws + WS_WGU); bf16* Wd = (bf16*)(F.ws + WS_WD);
    constexpr int I_IN = 16 * 64, I_OUT = 16 * 32, I_G = 32 * 128, I_D = 32 * 128, NITEMS = I_IN + I_OUT + 2 * I_G + I_D;
    for (int it = gw; it < NITEMS; it += NGW) {
        int r = it;
        if (r < I_IN) { tr_item(A.in[2], 1024, 2048, WinT, 32 * (r % 64), nullptr, scr, 64 * (r / 64), 32 * (r % 64), lane); continue; } r -= I_IN;
        if (r < I_OUT) { tr_item(A.in[8], 1024, 1024, WoutT, 32 * (r % 32), nullptr, scr, 64 * (r / 32), 32 * (r % 32), lane); continue; } r -= I_OUT;
        if (r < 2 * I_G) { const int up = r >= I_G ? 1 : 0; r -= up * I_G; const int e = r / 128, q = r % 128, kb = q / 8, n0 = 32 * (q % 8);
            tr_item(A.in[14 + up] + (size_t)e * 1024 * 256, 1024, 256, Wgu, e * 512 + (n0 / 128) * 256 + up * 128 + (n0 % 128), A.in[9], scr, 64 * kb, n0, lane); continue; } r -= 2 * I_G;
        { const int e = r / 128, q = r % 128, kb = q / 32, n0 = 32 * (q % 32);
            tr_item(A.in[16] + (size_t)e * 256 * 1024, 256, 1024, Wd + (size_t)e * 1024 * 256, n0, nullptr, scr, 64 * kb, n0, lane); }
    }
    { const float* g = A.in[1]; bf16* XN = (bf16*)(F.ws + WS_XN);
      f32x4 gv[4];
#pragma unroll
      for (int j = 0; j < 4; ++j) gv[j] = ((const f32x4*)g)[64 * j + lane];
      for (int m = gw; m < NTOK; m += NGW) {
        const f32x4* xr = (const f32x4*)(A.in[0] + (size_t)m * D) + lane; f32x4 v[4]; float s = 0.f;
#pragma unroll
        for (int j = 0; j < 4; ++j) { v[j] = xr[64 * j]; s += (v[j].x * v[j].x + v[j].y * v[j].y) + (v[j].z * v[j].z + v[j].w * v[j].w); }
        const float rstd = 1.0f / sqrtf(wave_sum(s) * (1.f / D) + EPS);
        unsigned long long* o8 = (unsigned long long*)(XN + (size_t)m * D) + lane;
#pragma unroll
        for (int j = 0; j < 4; ++j) { const f32x4 w = v[j] * rstd * gv[j]; o8[64 * j] = (unsigned long long)pk2(w.x, w.y) | ((unsigned long long)pk2(w.z, w.w) << 32); }
      } }
    { float* WR = (float*)(F.ws + WS_WR); const float* nm = A.in[9];
      for (int i = gw * 64 + lane; i < 36 * 1024; i += NGW * 64) { const int j = i / 1024, k = i % 1024; WR[i] = nm[k] * (j < 4 ? A.in[10][k * 4 + j] : A.in[12][k * 32 + (j - 4)]); } }
    { float* AB = (float*)(F.ws + WS_AB); const float* wf = A.in[4];
      for (int i = gw * 64 + lane; i < 8 * 64 * 64; i += NGW * 64) { const int d = i % 64, c = (i / 64) % 64, g = i / 4096; float a = 0.f, b = 0.f;
        for (int e = 0; e < 64; ++e) { const float ph = (float)((c * e) & 63) * (1.f / 64.f); const float wv = wf[(g * 64 + e) * 64 + d]; a += __builtin_amdgcn_cosf(ph) * wv; b += __builtin_amdgcn_sinf(ph) * wv; }
        AB[(g * 64 + c) * 128 + d] = a * (1.f / 512.f); AB[(g * 64 + c) * 128 + 64 + d] = b * (1.f / 512.f); } }
}

__device__ __forceinline__ void phase_attn_naive(Frame& F, const Args& A) {
    const bf16* Q = (const bf16*)(F.ws + WS_QKVU); const bf16* Kb = Q + (size_t)NTOK * 512; const bf16* Vb = Kb + (size_t)NTOK * 512;
    float* mf = (float*)(F.ws + WS_MF); const float* rpb = A.in[3]; const int lane = F.lane;
    for (int task = GW_ID(F); task < NTOK * NH; task += N_GW(F)) {
        const int h = task % NH, tok = task / NH, b = tok / T, t = tok % T, r = t / GW, c = t % GW;
        const int rs = min(max(r - WH / 2, 0), ROWS - WH), cs = min(max(c - WW / 2, 0), GW - WW);
        const bf16* q = Q + (size_t)tok * 512 + h * HD;
        float sc[2]; int kt[2];
#pragma unroll
        for (int e = 0; e < 2; ++e) {
            const int kk = lane * 2 + e, i = kk / WW, j = kk % WW, ktok = b * T + (rs + i) * GW + cs + j; kt[e] = ktok;
            const bf16* k = Kb + (size_t)ktok * 512 + h * HD; float s = 0.f;
            for (int d = 0; d < HD; ++d) s += bf2f(q[d]) * bf2f(k[d]);
            const int dr = rs + i - r + (WH - 1), dc = cs + j - c + (WW - 1);
            sc[e] = s + LOG2E * rpb[(h * (2 * WH - 1) + dr) * (2 * WW - 1) + dc];
        }
        float m = fmaxf(sc[0], sc[1]);
#pragma unroll
        for (int o = 1; o < 64; o <<= 1) m = fmaxf(m, __shfl_xor(m, o));
        float p0 = __builtin_amdgcn_exp2f(sc[0] - m), p1 = __builtin_amdgcn_exp2f(sc[1] - m);
        const float l = wave_sum(p0 + p1); p0 /= l; p1 /= l;
        float o = 0.f;
        for (int src = 0; src < 64; ++src) { const float a0 = __shfl(p0, src), a1 = __shfl(p1, src); const int t0 = __shfl(kt[0], src), t1 = __shfl(kt[1], src);
            o += a0 * bf2f(Vb[(size_t)t0 * 512 + h * HD + lane]) + a1 * bf2f(Vb[(size_t)t1 * 512 + h * HD + lane]); }
        mf[(size_t)tok * D + h * HD + lane] = o;
    }
}
__device__ __forceinline__ void phase_fft1_naive(Frame& F, const Args& A) {
    const bf16* U = (const bf16*)(F.ws + WS_QKVU) + (size_t)3 * NTOK * 512; float2* X1 = (float2*)(F.ws + WS_X1);
    for (size_t idx = (size_t)GW_ID(F) * 64 + F.lane; idx < (size_t)NB * 64 * 64 * DF; idx += (size_t)N_GW(F) * 64) {
        const int c = idx % DF; size_t r = idx / DF; const int t2 = r % 64; r /= 64; const int k1 = r % 64, b = r / 64;
        float re = 0.f, im = 0.f;
        for (int t1 = 0; t1 < 64; ++t1) { const float v = bf2f(U[(size_t)(b * T + 64 * t1 + t2) * 512 + c]); const float ph = (float)((t1 * k1) & 63) * (1.f / 64.f);
            re += v * __builtin_amdgcn_cosf(ph); im -= v * __builtin_amdgcn_sinf(ph); }
        const float ph = (float)(t2 * k1) * (1.f / 4096.f); const float cs = __builtin_amdgcn_cosf(ph), sn = -__builtin_amdgcn_sinf(ph);
        X1[idx] = make_float2(re * cs - im * sn, re * sn + im * cs);
    }
}
__device__ __forceinline__ void phase_fft2_naive(Frame& F, const Args& A) {
    const float2* X1 = (const float2*)(F.ws + WS_X1); float2* Y = (float2*)F.out;
    for (size_t idx = (size_t)GW_ID(F) * 64 + F.lane; idx < (size_t)NB * 64 * 64 * DF; idx += (size_t)N_GW(F) * 64) {
        const int c = idx % DF; size_t r = idx / DF; const int k1 = r % 64; r /= 64; const int k2 = r % 64, b = r / 64;
        float re = 0.f, im = 0.f;
        for (int t2 = 0; t2 < 64; ++t2) { const float2 v = X1[((size_t)(b * 64 + k1) * 64 + t2) * DF + c]; const float ph = (float)((t2 * k2) & 63) * (1.f / 64.f);
            const float cs = __builtin_amdgcn_cosf(ph), sn = -__builtin_amdgcn_sinf(ph); re += v.x * cs - v.y * sn; im += v.x * sn + v.y * cs; }
        Y[idx] = make_float2(re, im);
    }
}
__device__ __forceinline__ void phase_mix_naive(Frame& F, const Args& A) {
    const float2* Y = (const float2*)F.out; const float* AB = (const float*)(F.ws + WS_AB); float* mf = (float*)(F.ws + WS_MF); const float* bf = A.in[5];
    for (size_t idx = (size_t)GW_ID(F) * 64 + F.lane; idx < (size_t)NTOK * DF; idx += (size_t)N_GW(F) * 64) {
        const int n = idx % DF; const size_t tok = idx / DF; const int g = n / 64, d = n % 64; float s = bf[n];
        for (int c = 0; c < 64; ++c) { const float2 v = Y[tok * DF + g * 64 + c]; s += v.x * AB[(g * 64 + c) * 128 + d] + v.y * AB[(g * 64 + c) * 128 + 64 + d]; }
        mf[tok * D + DA + n] = s;
    }
}
__device__ __forceinline__ void phase_merge_norm(Frame& F, const Args& A) {
    const float* mf = (const float*)(F.ws + WS_MF); bf16* mg = (bf16*)(F.ws + WS_X1); const int lane = F.lane;
    const float* g = (lane < 32) ? (A.in[6] + lane * 16) : (A.in[7] + (lane - 32) * 16);
    f32x4 gv[4];
#pragma unroll
    for (int j = 0; j < 4; ++j) gv[j] = ((const f32x4*)g)[j];
    for (int tok = GW_ID(F); tok < NTOK; tok += N_GW(F)) {
        const f32x4* src = (const f32x4*)(mf + (size_t)tok * D + lane * 16); f32x4 v[4]; float s = 0.f;
#pragma unroll
        for (int j = 0; j < 4; ++j) { v[j] = src[j]; s += (v[j].x * v[j].x + v[j].y * v[j].y) + (v[j].z * v[j].z + v[j].w * v[j].w); }
#pragma unroll
        for (int o = 1; o < 32; o <<= 1) s += __shfl_xor(s, o);
        const float rstd = 1.0f / sqrtf(s * (1.f / 512.f) + EPS);
        v4u o0, o1; f32x4 a = v[0] * rstd * gv[0], b = v[1] * rstd * gv[1], c = v[2] * rstd * gv[2], d = v[3] * rstd * gv[3];
        o0.x = pk2(a.x, a.y); o0.y = pk2(a.z, a.w); o0.z = pk2(b.x, b.y); o0.w = pk2(b.z, b.w);
        o1.x = pk2(c.x, c.y); o1.y = pk2(c.z, c.w); o1.z = pk2(d.x, d.y); o1.w = pk2(d.z, d.w);
        v4u* dst = (v4u*)(mg + (size_t)tok * D + lane * 16); dst[0] = o0; dst[1] = o1;
    }
}
__device__ __forceinline__ void phase_router(Frame& F, const Args& A) {
    LAS float* wt = (LAS float*)F.lds;
    { const f32x4* src = (const f32x4*)(F.ws + WS_WR); for (int i = F.tid; i < 36 * 256; i += NWAVES * 64) ((LAS f32x4*)wt)[i] = src[i]; }
    LAS int* lcnt = (LAS int*)(F.lds + L_LCNT); LAS int* gbase = (LAS int*)(F.lds + L_GBASE); LAS int* rt = (LAS int*)(F.lds + L_RT);
    const bf16* h = (const bf16*)(F.ws + WS_XN);
    int2* e01 = (int2*)(F.ws + WS_ROUTE); int2* rank = e01 + NTOK; float2* wgt = (float2*)(rank + NTOK); float* rstd = (float*)(wgt + NTOK);
    const float* brc = A.in[11]; const float* brf = A.in[13]; const int lane = F.lane;
    for (int batch = F.vcu; batch < NTOK / 128; batch += F.G) {
        if (F.tid < 32) lcnt[F.tid] = 0;
        __syncthreads();
#pragma unroll 1
        for (int pass = 0; pass < 8; ++pass) {
            const int tl0 = F.wave * 16 + pass * 2;
            float hv[2][16]; float rs[2];
#pragma unroll
            for (int t = 0; t < 2; ++t) { const v4u* src = (const v4u*)(h + (size_t)(batch * 128 + tl0 + t) * D + lane * 16); const v4u a = src[0], b = src[1];
                hv[t][0] = bflo(a.x); hv[t][1] = bfhi(a.x); hv[t][2] = bflo(a.y); hv[t][3] = bfhi(a.y); hv[t][4] = bflo(a.z); hv[t][5] = bfhi(a.z); hv[t][6] = bflo(a.w); hv[t][7] = bfhi(a.w);
                hv[t][8] = bflo(b.x); hv[t][9] = bfhi(b.x); hv[t][10] = bflo(b.y); hv[t][11] = bfhi(b.y); hv[t][12] = bflo(b.z); hv[t][13] = bfhi(b.z); hv[t][14] = bflo(b.w); hv[t][15] = bfhi(b.w);
                float s = 0.f;
#pragma unroll
                for (int i = 0; i < 16; ++i) s += hv[t][i] * hv[t][i];
                rs[t] = 1.0f / sqrtf(wave_sum(s) * (1.f / D) + EPS); }
            LAS float* lgs = (LAS float*)(F.lds + L_LGS) + F.wave * 72;
#pragma unroll 4
            for (int j = 0; j < 36; ++j) { const LAS f32x4* wr = (const LAS f32x4*)(wt + j * 1024 + lane * 16); const f32x4 w0 = wr[0], w1 = wr[1], w2 = wr[2], w3 = wr[3];
#pragma unroll
                for (int t = 0; t < 2; ++t) { float s = hv[t][0] * w0.x + hv[t][1] * w0.y + hv[t][2] * w0.z + hv[t][3] * w0.w + hv[t][4] * w1.x + hv[t][5] * w1.y + hv[t][6] * w1.z + hv[t][7] * w1.w
                        + hv[t][8] * w2.x + hv[t][9] * w2.y + hv[t][10] * w2.z + hv[t][11] * w2.w + hv[t][12] * w3.x + hv[t][13] * w3.y + hv[t][14] * w3.z + hv[t][15] * w3.w;
                    s = wave_sum(s) * rs[t]; if (lane == 0) lgs[t * 36 + j] = s; } }
            LDS_WAIT(); asm volatile("" ::: "memory");
#pragma unroll
            for (int t = 0; t < 2; ++t) {
                const LAS float* lg = lgs + t * 36;
                const float c0 = lg[0] + brc[0], c1 = lg[1] + brc[1], c2 = lg[2] + brc[2], c3 = lg[3] + brc[3];
                int gi = 0; float mx = c0;
                if (c1 > mx) { mx = c1; gi = 1; }
                if (c2 > mx) { mx = c2; gi = 2; }
                if (c3 > mx) { mx = c3; gi = 3; }
                const float gwt = 1.0f / (expf(c0 - mx) + expf(c1 - mx) + expf(c2 - mx) + expf(c3 - mx));
                float v0 = -1e30f, v1 = -1e30f; int i0 = 0, i1 = 0;
#pragma unroll
                for (int j = 0; j < 8; ++j) { const float f = lg[4 + gi * 8 + j] + brf[gi * 8 + j];
                    if (f > v0) { v1 = v0; i1 = i0; v0 = f; i0 = j; } else if (f > v1) { v1 = f; i1 = j; } }
                const float e1 = expf(v1 - v0), p0 = 1.f / (1.f + e1), p1 = e1 / (1.f + e1);
                if (lane == 0) { const int tl = tl0 + t, tok = batch * 128 + tl, ea = gi * 8 + i0, eb = gi * 8 + i1;
                    const int ra = __hip_atomic_fetch_add(lcnt + ea, 1, __ATOMIC_RELAXED, __HIP_MEMORY_SCOPE_WORKGROUP);
                    const int rb = __hip_atomic_fetch_add(lcnt + eb, 1, __ATOMIC_RELAXED, __HIP_MEMORY_SCOPE_WORKGROUP);
                    rt[tl] = ea; rt[128 + tl] = eb; rt[256 + tl] = ra; rt[384 + tl] = rb;
                    wgt[tok] = make_float2(p0 * gwt, p1 * gwt); rstd[tok] = rs[t]; }
            }
            LDS_WAIT(); asm volatile("" ::: "memory");
        }
        __syncthreads();
        if (F.tid < 32) gbase[F.tid] = (int)__hip_atomic_fetch_add(F.ctl + CW_CNT + 64 * F.tid, (unsigned)lcnt[F.tid], __ATOMIC_RELAXED, __HIP_MEMORY_SCOPE_AGENT);
        __syncthreads();
        if (F.tid < 128) { const int tok = batch * 128 + F.tid, ea = rt[F.tid], eb = rt[128 + F.tid];
            e01[tok] = make_int2(ea, eb); rank[tok] = make_int2(rt[256 + F.tid] + gbase[ea], rt[384 + F.tid] + gbase[eb]); }
        __syncthreads();
    }
}
__device__ __forceinline__ void phase_scatter(Frame& F, const Args& A) {
    LAS int* pbase = (LAS int*)(F.lds + L_PBASE);
    LAS int* lcnt = (LAS int*)(F.lds + L_LCNT);
    if (F.tid < 32) lcnt[F.tid] = (int)__hip_atomic_load(F.ctl + CW_CNT + 64 * F.tid, __ATOMIC_RELAXED, __HIP_MEMORY_SCOPE_AGENT);
    __syncthreads();
    if (F.tid == 0) { int acc = 0; for (int e = 0; e < 32; ++e) { pbase[e] = acc; acc += (lcnt[e] + 255) >> 8; } pbase[32] = acc; }
    __syncthreads();
    float* rstd_s = (float*)(F.ws + WS_META); float* w_s = rstd_s + MAXROWS; int* slotrow_s = (int*)(w_s + MAXROWS);
    for (int e = F.vcu; e < 32; e += F.G) { const int cnt = lcnt[e];
        for (int r = 256 * pbase[e] + cnt + F.tid; r < 256 * pbase[e + 1]; r += NWAVES * 64) { slotrow_s[r] = 2 * NTOK; w_s[r] = 0.f; rstd_s[r] = 0.f; } }
    const bf16* h = (const bf16*)(F.ws + WS_XN); bf16* hs = (bf16*)(F.ws + WS_QKVU);
    const int2* e01 = (const int2*)(F.ws + WS_ROUTE); const int2* rank = e01 + NTOK; const float2* wgt = (const float2*)(rank + NTOK); const float* rstd = (const float*)(wgt + NTOK);
    for (int tok = GW_ID(F); tok < NTOK; tok += N_GW(F)) {
        const int2 e = e01[tok], r = rank[tok]; const float2 w = wgt[tok]; const float rs = rstd[tok];
        const int pos0 = 256 * pbase[e.x] + r.x, pos1 = 256 * pbase[e.y] + r.y;
        const v4u* src = (const v4u*)(h + (size_t)tok * D) + F.lane * 2; const v4u a = src[0], b = src[1];
        v4u* d0 = (v4u*)(hs + (size_t)pos0 * D) + F.lane * 2; d0[0] = a; d0[1] = b;
        v4u* d1 = (v4u*)(hs + (size_t)pos1 * D) + F.lane * 2; d1[0] = a; d1[1] = b;
        if (F.lane == 0) { rstd_s[pos0] = rs; w_s[pos0] = w.x; slotrow_s[pos0] = 2 * tok; rstd_s[pos1] = rs; w_s[pos1] = w.y; slotrow_s[pos1] = 2 * tok + 1; }
    }
}
__device__ __forceinline__ void phase_final(Frame& F, const Args& A) {
    const bf16* h = (const bf16*)(F.ws + WS_XN); const bf16* y2 = (const bf16*)(F.ws + WS_X1); const int lane = F.lane;
    f32x4 gv[4];
#pragma unroll
    for (int j = 0; j < 4; ++j) gv[j] = ((const f32x4*)(A.in[17] + lane * 16))[j];
    for (int tok = GW_ID(F); tok < NTOK; tok += N_GW(F)) {
        const v4u* ph = (const v4u*)(h + (size_t)tok * D) + lane * 2; const v4u* p0 = (const v4u*)(y2 + (size_t)(2 * tok) * D) + lane * 2; const v4u* p1 = (const v4u*)(y2 + (size_t)(2 * tok + 1) * D) + lane * 2;
        f32x4 v[4]; float s = 0.f;
#pragma unroll
        for (int hh = 0; hh < 2; ++hh) { const v4u a = ph[hh], b = p0[hh], c = p1[hh];
            v[2 * hh] = (f32x4){bflo(a.x) + bflo(b.x) + bflo(c.x), bfhi(a.x) + bfhi(b.x) + bfhi(c.x), bflo(a.y) + bflo(b.y) + bflo(c.y), bfhi(a.y) + bfhi(b.y) + bfhi(c.y)};
            v[2 * hh + 1] = (f32x4){bflo(a.z) + bflo(b.z) + bflo(c.z), bfhi(a.z) + bfhi(b.z) + bfhi(c.z), bflo(a.w) + bflo(b.w) + bflo(c.w), bfhi(a.w) + bfhi(b.w) + bfhi(c.w)}; }
#pragma unroll
        for (int j = 0; j < 4; ++j) s += (v[j].x * v[j].x + v[j].y * v[j].y) + (v[j].z * v[j].z + v[j].w * v[j].w);
        const float rstd = 1.0f / sqrtf(wave_sum(s) * (1.f / D) + EPS);
        f32x4* dst = (f32x4*)(F.out + (size_t)tok * D + lane * 16);
#pragma unroll
        for (int j = 0; j < 4; ++j) dst[j] = v[j] * rstd * gv[j];
    }
}
__global__ void __launch_bounds__(NWAVES * 64, 2) mega_fwd(Args args) {
    extern __shared__ __attribute__((aligned(16))) unsigned char lds[];
    Frame F;
    F.lds = (LAS unsigned char*)lds;
    F.tid = threadIdx.x; F.lane = F.tid & 63; F.wave = __builtin_amdgcn_readfirstlane(F.tid >> 6);
    F.G = gridDim.x; { const int bx = blockIdx.x; F.vcu = (F.G % 8 == 0) ? (bx % 8) * (F.G / 8) + bx / 8 : bx; }
    F.ws = args.ws; F.ctl = (unsigned*)(args.ws + WS_CTL); F.out = args.out;
    for (int u = F.tid; u < (LDS_BYTES - LDSCTL_OFF) / 4; u += NWAVES * 64) ((LAS unsigned*)(F.lds + LDSCTL_OFF))[u] = 0u;
    __syncthreads();
    XcdBarrier bar = xcd_barrier_post(F.ctl + CW_BAR, (volatile LAS unsigned*)(F.lds + L_MISC) + 8);
#define GRID_BAR() xcd_barrier(bar)
    PG8_LAS unsigned char* ring = (PG8_LAS unsigned char*)lds;
    const pg8::bf16_t* XN = (const pg8::bf16_t*)(F.ws + WS_XN);

    phase_prep(F, args);
    GRID_BAR();
    {
        pg8::Gemm g{XN, (const pg8::bf16_t*)(F.ws + WS_WIN), NTOK, NPROJ, D}; pg8::StaticOrder S; S.init(NTOK, NPROJ, F.G, (int)blockIdx.x);
        pg8::EpiBf16 E{(pg8::bf16_t*)(F.ws + WS_QKVU), 512, 512, (size_t)NTOK * 512, QSCALE};
        pg8::gemm_phase<pg8::EpiBf16, pg8::StaticOrder, true, true>(ring, g, S, E);
    }
    GRID_BAR();
    phase_attn_naive(F, args);
    phase_fft1_naive(F, args);
    GRID_BAR();
    phase_fft2_naive(F, args);
    GRID_BAR();
    phase_mix_naive(F, args);
    GRID_BAR();
    phase_merge_norm(F, args);
    GRID_BAR();
    {
        pg8::Gemm g{(const pg8::bf16_t*)(F.ws + WS_X1), (const pg8::bf16_t*)(F.ws + WS_WOUT), NTOK, D, D}; pg8::StaticOrder S; S.init(NTOK, D, F.G, (int)blockIdx.x);
        pg8::EpiResH E{args.in[0], (pg8::bf16_t*)(F.ws + WS_XN)};
        pg8::gemm_phase<pg8::EpiResH, pg8::StaticOrder, true, true>(ring, g, S, E);
    }
    GRID_BAR();
    phase_router(F, args);
    GRID_BAR();
    phase_scatter(F, args);
    GRID_BAR();
    {
        pg8::Gemm g{(const pg8::bf16_t*)(F.ws + WS_QKVU), (const pg8::bf16_t*)(F.ws + WS_WGU), MAXROWS, NE * 512, D};
        pg8::MoeOrder S{(const PG8_LAS int*)(ring + L_PBASE), 2, F.G, (int)blockIdx.x};
        const float* rstd_s = (const float*)(F.ws + WS_META);
        pg8::EpiMoe1 E{rstd_s, rstd_s + MAXROWS, (pg8::bf16_t*)(F.ws + WS_HD)};
        pg8::gemm_phase<pg8::EpiMoe1, pg8::MoeOrder, true, true>(ring, g, S, E);
    }
    GRID_BAR();
    {
        pg8::Gemm g{(const pg8::bf16_t*)(F.ws + WS_HD), (const pg8::bf16_t*)(F.ws + WS_WD), MAXROWS, NE * 1024, DE};
        pg8::MoeOrder S{(const PG8_LAS int*)(ring + L_PBASE), 4, F.G, (int)blockIdx.x};
        const int* slotrow_s = (const int*)(F.ws + WS_META) + 2 * MAXROWS;
        pg8::EpiMoe2 E{slotrow_s, (pg8::bf16_t*)(F.ws + WS_X1)};
        pg8::gemm_phase<pg8::EpiMoe2, pg8::MoeOrder, true, true>(ring, g, S, E);
    }
    GRID_BAR();
    phase_final(F, args);
}

extern "C" void kernel_launch(void* const* d_in, const int* in_sizes, int n_in, void* d_out, int out_size, void* d_ws, size_t ws_size, hipStream_t stream) {
    static int grid = 0;
    if (grid == 0) {
        if (n_in != 18 || out_size != NTOK * D || ws_size < WS_END) { fprintf(stderr, "kernel_launch: unexpected problem shape (n_in %d, out %d, ws %zu)\n", n_in, out_size, ws_size); grid = -1; return; }
        int dev = 0, cus = 0;
        if (hipGetDevice(&dev) != hipSuccess || hipDeviceGetAttribute(&cus, hipDeviceAttributeMultiprocessorCount, dev) != hipSuccess) { grid = -1; return; }
        if (hipFuncSetAttribute((const void*)mega_fwd, hipFuncAttributeMaxDynamicSharedMemorySize, LDS_BYTES) != hipSuccess) { fprintf(stderr, "kernel_launch: hipFuncSetAttribute failed\n"); grid = -1; return; }
        int per_cu = 0;
        if (hipOccupancyMaxActiveBlocksPerMultiprocessor(&per_cu, (const void*)mega_fwd, NWAVES * 64, LDS_BYTES) != hipSuccess || per_cu < 1) { fprintf(stderr, "kernel_launch: occupancy query says %d blocks per CU\n", per_cu); }
        (void)hipGetLastError();
        grid = cus;
    }
    if (grid < 0) return;
    (void)hipMemsetAsync((char*)d_ws + WS_CTL, 0, CTL_ZERO_BYTES, stream);
    Args a{};
    for (int i = 0; i < 18; ++i) a.in[i] = (const float*)d_in[i];
    a.out = (float*)d_out; a.ws = (unsigned char*)d_ws;
    hipLaunchKernelGGL(mega_fwd, dim3(grid), dim3(NWAVES * 64), LDS_BYTES, stream, a);
}
```

```cpp
#include <hip/hip_runtime.h>
#include <cstdint>
#include <cstdio>
namespace pg8 {
#define PG8_LAS __attribute__((address_space(3)))
typedef unsigned short bf16_t;
typedef short bf16x8 __attribute__((ext_vector_type(8)));
typedef float f32x4 __attribute__((ext_vector_type(4)));
typedef unsigned u32x4 __attribute__((ext_vector_type(4)));
constexpr int BM = 256, BK = 64, HALF = 128, HTB = HALF * BK * 2  , STAGE_BYTES = 8 * HTB, NXCD = 8, WGM = 8;

__host__ __device__ __forceinline__ int lds_byte(int r, int c) { const int st = (r >> 4) * 2 + (c >> 5), rr = r & 15, cc = c & 31, ob = rr * 64 + cc * 2; return st * 1024 + (ob ^ (((ob >> 9) & 1) << 5)); }
__host__ __device__ __forceinline__ void stage_rc(int b, int& R, int& C) { const int st = b / 1024, sb = b % 1024, swz = sb ^ (((sb >> 9) & 1) << 5); R = (st >> 1) * 16 + swz / 64; C = (st & 1) * 32 + (swz % 64) / 2; }
__host__ __device__ __forceinline__ int perm32(int rho) { const int n = rho >> 4, i = rho & 15; return 8 * (i >> 2) + 4 * n + (i & 3); }

struct Unit { int pm, pn; };
struct Gemm { const bf16_t* A; const bf16_t* Bt; int M, N, K; };

struct StaticOrder {
    int nM, nN, nwg, G, c;
    __host__ __device__ void init(int M, int N, int G_, int c_) { nM = M / BM; nN = N / BM; nwg = nM * nN; G = G_; c = c_; }
    __host__ __device__ bool next(int i, Unit& u) const {
        const long L = (long)i * G + c; if (L >= nwg) return false;
        int wgid = (int)L; { const int q = nwg / NXCD, r = nwg % NXCD, xcd = wgid % NXCD, off = wgid / NXCD; wgid = (xcd < r ? xcd * (q + 1) : r * (q + 1) + (xcd - r) * q) + off; }
        const int nig = WGM * nN, gid = wgid / nig, fm = gid * WGM, gsz = (nM - fm) < WGM ? (nM - fm) : WGM;
        u.pm = fm + ((wgid % nig) % gsz); u.pn = (wgid % nig) / gsz; return true;
    }
    __device__ __forceinline__ void a_ready(const Unit&) const {}
    __device__ __forceinline__ void done(const Unit&) const {}
};

__device__ __forceinline__ unsigned cvt_pk_bf16(float lo, float hi) { unsigned r; asm volatile("v_cvt_pk_bf16_f32 %0, %1, %2" : "=v"(r) : "v"(lo), "v"(hi)); return r; }
typedef float f32x2 __attribute__((ext_vector_type(2)));
struct EpiBf16 {
    static constexpr bool PERM = true, AFTER_DRAIN = false;
    bf16_t* O; int ldc; int split_cols; size_t split_stride; float scale0;
    __device__ __forceinline__ void operator()(const f32x4 (&acc)[2][2][4][2], const Unit& u, int wr, int wc, int fr, int fq) const {
        const int row0 = u.pm * BM + wr * 64 + fr; int colt = u.pn * BM; bf16_t* base = O;
        float sc = 1.f; { const int t = colt / split_cols; base += (size_t)t * split_stride; colt -= t * split_cols; if (t == 0) sc = scale0; }
        const int col0 = colt + wc * 32 + 8 * fq;
#pragma unroll
        for (int ai = 0; ai < 2; ++ai)
#pragma unroll
            for (int m = 0; m < 4; ++m) { bf16_t* rowp = base + (size_t)(row0 + ai * HALF + m * 16) * ldc + col0;
#pragma unroll
                for (int bj = 0; bj < 2; ++bj) { f32x4 v0 = acc[ai][bj][m][0] * sc, v1 = acc[ai][bj][m][1] * sc;
                    u32x4 w; w.x = cvt_pk_bf16(v0[0], v0[1]); w.y = cvt_pk_bf16(v0[2], v0[3]); w.z = cvt_pk_bf16(v1[0], v1[1]); w.w = cvt_pk_bf16(v1[2], v1[3]);
                    *(u32x4*)(rowp + bj * HALF) = w; } }
    }
};
struct EpiResH {
    static constexpr bool PERM = true, AFTER_DRAIN = false;
    const float* x; bf16_t* h;
    __device__ __forceinline__ void operator()(const f32x4 (&acc)[2][2][4][2], const Unit& u, int wr, int wc, int fr, int fq) const {
        const int row0 = u.pm * BM + wr * 64 + fr, col0 = u.pn * BM + wc * 32 + 8 * fq;
#pragma unroll
        for (int ai = 0; ai < 2; ++ai)
#pragma unroll
            for (int m = 0; m < 4; ++m) { const size_t off = (size_t)(row0 + ai * HALF + m * 16) * 1024 + col0;
#pragma unroll
                for (int bj = 0; bj < 2; ++bj) { const f32x4 xa = *(const f32x4*)(x + off + bj * HALF), xb = *(const f32x4*)(x + off + bj * HALF + 4);
                    const f32x4 v0 = acc[ai][bj][m][0] + xa, v1 = acc[ai][bj][m][1] + xb;
                    u32x4 w; w.x = cvt_pk_bf16(v0[0], v0[1]); w.y = cvt_pk_bf16(v0[2], v0[3]); w.z = cvt_pk_bf16(v1[0], v1[1]); w.w = cvt_pk_bf16(v1[2], v1[3]);
                    *(u32x4*)(h + off + bj * HALF) = w; } }
    }
};
struct EpiMoe1 {
    static constexpr bool PERM = true, AFTER_DRAIN = false;
    const float* rstd_s; const float* w_s; bf16_t* hd;
    __device__ __forceinline__ void operator()(const f32x4 (&acc)[2][2][4][2], const Unit& u, int wr, int wc, int fr, int fq) const {
        const int row0 = u.pm * BM + wr * 64 + fr, col0 = (u.pn & 1) * HALF + wc * 32 + 8 * fq;
#pragma unroll
        for (int ai = 0; ai < 2; ++ai)
#pragma unroll
            for (int m = 0; m < 4; ++m) { const int row = row0 + ai * HALF + m * 16; const float rs = rstd_s[row], wv = w_s[row];
                float o[8];
#pragma unroll
                for (int n = 0; n < 2; ++n)
#pragma unroll
                    for (int j = 0; j < 4; ++j) { const float g = acc[ai][0][m][n][j] * rs, uu = acc[ai][1][m][n][j] * rs;
                        o[n * 4 + j] = g * __builtin_amdgcn_rcpf(1.0f + __builtin_amdgcn_exp2f(-1.4426950408889634f * g)) * uu * wv; }
                u32x4 w; w.x = cvt_pk_bf16(o[0], o[1]); w.y = cvt_pk_bf16(o[2], o[3]); w.z = cvt_pk_bf16(o[4], o[5]); w.w = cvt_pk_bf16(o[6], o[7]);
                *(u32x4*)(hd + (size_t)row * 256 + col0) = w; }
    }
};
struct EpiMoe2 {
    static constexpr bool PERM = true, AFTER_DRAIN = false;
    const int* slotrow_s; bf16_t* y2;
    __device__ __forceinline__ void operator()(const f32x4 (&acc)[2][2][4][2], const Unit& u, int wr, int wc, int fr, int fq) const {
        const int row0 = u.pm * BM + wr * 64 + fr, col0 = (u.pn & 3) * BM + wc * 32 + 8 * fq;
#pragma unroll
        for (int ai = 0; ai < 2; ++ai)
#pragma unroll
            for (int m = 0; m < 4; ++m) { const int sr = slotrow_s[row0 + ai * HALF + m * 16];
                bf16_t* rowp = y2 + (size_t)sr * 1024 + col0;
#pragma unroll
                for (int bj = 0; bj < 2; ++bj) { const f32x4 v0 = acc[ai][bj][m][0], v1 = acc[ai][bj][m][1];
                    u32x4 w; w.x = cvt_pk_bf16(v0[0], v0[1]); w.y = cvt_pk_bf16(v0[2], v0[3]); w.z = cvt_pk_bf16(v1[0], v1[1]); w.w = cvt_pk_bf16(v1[2], v1[3]);
                    *(u32x4*)(rowp + bj * HALF) = w; }
                asm volatile("" ::: "memory"); }
    }
};
struct MoeOrder {
    const PG8_LAS int* pbase; int ntn, G, c;
    __device__ __forceinline__ bool next(int i, Unit& u) const {
        const int L = i * G + c; const int total = pbase[32] * ntn; if (L >= total) return false;
        const int pm = L / ntn, pl = L - pm * ntn; int e = 0;
#pragma unroll 1
        for (int j = 1; j < 32; ++j) e += (pbase[j] <= pm) ? 1 : 0;
        u.pm = pm; u.pn = e * ntn + pl; return true;
    }
    __device__ __forceinline__ void a_ready(const Unit&) const {}
    __device__ __forceinline__ void done(const Unit&) const {}
};
struct BNat { static __device__ __forceinline__ int row(int v) { return v; } static __device__ __forceinline__ size_t hstep(int K) { return (size_t)HALF * K * 2; } static __device__ __forceinline__ size_t tile(int pn, int K) { return (size_t)pn * BM * K * 2; } };
struct BGridT { static __device__ __forceinline__ int row(int v) { return (v & 63) * 64 + (v >> 6); } static __device__ __forceinline__ size_t hstep(int K) { return (size_t)2 * K * 2; }
    static __device__ __forceinline__ size_t tile(int pn, int K) { return (size_t)((pn >> 4) * 4096 + (pn & 15) * 4) * K * 2; } };
template <class Epi, class Sched, bool ALIGN_EPI = false, bool SP2 = false, class BMap = BNat>
__device__ __forceinline__ void gemm_phase(PG8_LAS unsigned char* lds, const Gemm g, const Sched& S, const Epi& E) {
    int tid_ = threadIdx.x; asm volatile("" : "+v"(tid_));
    const int tid = tid_, wid = __builtin_amdgcn_readfirstlane(tid >> 6), lane = tid & 63, wr = wid >> 2, wc = wid & 3, fr = lane & 15, fq = lane >> 4;
    const int K = g.K; int nt_ = K / BK; asm volatile("" : "+s"(nt_)); const int nt = nt_;
    unsigned voffA[2], voffB[2];
#pragma unroll
    for (int i = 0; i < 2; ++i) { int R, C; stage_rc(tid * 16 + i * 8192, R, C); const int Rb = Epi::PERM ? ((R & ~31) + perm32(R & 31)) : R;
        voffA[i] = (unsigned)(R * K + C) * 2u; voffB[i] = (unsigned)(BMap::row(Rb) * K + C) * 2u; }
    const size_t kstep = (size_t)(BK * 2);
    const size_t hstep = (size_t)HALF * K * 2;
    const size_t tstep = 2 * hstep; const size_t hstepB = BMap::hstep(K);
    const unsigned ldsw = (unsigned)wid * 1024u;
    const int aoff = lds_byte(wr * 64 + fr, fq * 8), boff = lds_byte(wc * 32 + fr, fq * 8);
#define PG8_SA(b, h) (((b) * 2 + (h)) * HTB)
#define PG8_SB(b, h) ((4 + (b) * 2 + (h)) * HTB)
#define PG8_STAGE(bufoff, gbase, voff) do { _Pragma("unroll") for (int _i = 0; _i < 2; ++_i) \
        __builtin_amdgcn_global_load_lds((const unsigned*)((const char*)(gbase) + (voff)[_i]), (PG8_LAS unsigned*)(lds + (bufoff) + ldsw + _i * 8192), 16, 0, 0); } while (0)
#define PG8_LDA(dst, b, h) do { _Pragma("unroll") for (int m = 0; m < 4; ++m) _Pragma("unroll") for (int k = 0; k < 2; ++k) dst[m][k] = *(const PG8_LAS bf16x8*)(lds + PG8_SA(b, h) + aoff + m * 2048 + k * 1024); } while (0)
#define PG8_LDB(dst, b, h) do { _Pragma("unroll") for (int n = 0; n < 2; ++n) _Pragma("unroll") for (int k = 0; k < 2; ++k) dst[n][k] = *(const PG8_LAS bf16x8*)(lds + PG8_SB(b, h) + boff + n * 2048 + k * 1024); } while (0)
#define PG8_MMA(ai, bj, At, Bt) do { __builtin_amdgcn_s_setprio(1); _Pragma("unroll") for (int m = 0; m < 4; ++m) _Pragma("unroll") for (int n = 0; n < 2; ++n) _Pragma("unroll") for (int k = 0; k < 2; ++k) \
        acc[ai][bj][m][n] = __builtin_amdgcn_mfma_f32_16x16x32_bf16(Bt[n][k], At[m][k], acc[ai][bj][m][n], 0, 0, 0); __builtin_amdgcn_s_setprio(0); } while (0)
#define PG8_WAIT_V(n) asm volatile("s_waitcnt vmcnt(" #n ")" ::: "memory")
#define PG8_WAIT_L(n) asm volatile("s_waitcnt lgkmcnt(" #n ")" ::: "memory")
#define PG8_BAR __builtin_amdgcn_s_barrier()
#define PG8_SCHED __builtin_amdgcn_sched_barrier(0)
    Unit cur, nxt; int ui = 0;
    if (!S.next(0, cur)) return;
    f32x4 acc[2][2][4][2];
#pragma unroll
    for (int a = 0; a < 2; ++a)
#pragma unroll
        for (int b = 0; b < 2; ++b)
#pragma unroll
            for (int m = 0; m < 4; ++m)
#pragma unroll
                for (int n = 0; n < 2; ++n) acc[a][b][m][n] = (f32x4){0.f, 0.f, 0.f, 0.f};
    bf16x8 At[4][2], B0[2][2], B1[2][2];
    const char* cA = (const char*)g.A + (size_t)cur.pm * tstep; const char* cB = (const char*)g.Bt + BMap::tile(cur.pn, K);
    S.a_ready(cur);
    if constexpr (SP2) {
        PG8_STAGE(PG8_SB(0, 0), cB, voffB); PG8_STAGE(PG8_SB(0, 1), cB + hstepB, voffB); PG8_STAGE(PG8_SA(0, 0), cA, voffA); PG8_STAGE(PG8_SA(0, 1), cA + hstep, voffA);
        if (wr == 1) PG8_BAR;
        PG8_WAIT_V(2); PG8_BAR;
        PG8_STAGE(PG8_SB(1, 0), cB + kstep, voffB); PG8_STAGE(PG8_SA(1, 0), cA + kstep, voffA); PG8_STAGE(PG8_SB(1, 1), cB + hstepB + kstep, voffB);
        PG8_WAIT_V(6); PG8_BAR;
    } else {
        PG8_STAGE(PG8_SB(0, 0), cB, voffB); PG8_STAGE(PG8_SA(0, 0), cA, voffA); PG8_STAGE(PG8_SB(0, 1), cB + hstepB, voffB); PG8_STAGE(PG8_SA(0, 1), cA + hstep, voffA);
        if (wr == 1) PG8_BAR;
        PG8_WAIT_V(4); PG8_BAR;
        PG8_STAGE(PG8_SB(1, 0), cB + kstep, voffB); PG8_STAGE(PG8_SA(1, 0), cA + kstep, voffA); PG8_STAGE(PG8_SB(1, 1), cB + hstepB + kstep, voffB);
        PG8_WAIT_V(6); PG8_BAR;
    }
    for (;;) {
        const bool has_next = S.next(ui + 1, nxt);
        const char* nA = has_next ? (const char*)g.A + (size_t)nxt.pm * tstep : cA; const char* nB = has_next ? (const char*)g.Bt + BMap::tile(nxt.pn, K) : cB;
        for (int t = 0; t < nt; t += 2) {
            const bool last = (t == nt - 2);
            const char* a1 = cA + (size_t)(t + 1) * kstep;
            const char* a2 = last ? nA : cA + (size_t)(t + 2) * kstep; const char* b2 = last ? nB : cB + (size_t)(t + 2) * kstep;
            const char* a3 = a2 + kstep; const char* b3 = b2 + kstep;
            if (last && has_next) S.a_ready(nxt);
            if constexpr (SP2) {
            PG8_LDB(B0, 0, 0); PG8_LDB(B1, 0, 1); PG8_SCHED; PG8_LDA(At, 0, 0); PG8_STAGE(PG8_SA(1, 1), a1 + hstep, voffA);
            PG8_WAIT_V(8); PG8_WAIT_L(0); PG8_BAR; PG8_MMA(0, 0, At, B0); PG8_MMA(0, 1, At, B1); PG8_BAR; PG8_SCHED;
            PG8_LDA(At, 0, 1); PG8_STAGE(PG8_SB(0, 0), b2, voffB); PG8_STAGE(PG8_SB(0, 1), b2 + hstepB, voffB); PG8_STAGE(PG8_SA(0, 0), a2, voffA);
            PG8_WAIT_V(8); PG8_WAIT_L(0); PG8_BAR; PG8_MMA(1, 0, At, B0); PG8_MMA(1, 1, At, B1); PG8_BAR; PG8_SCHED;
            PG8_LDB(B0, 1, 0); PG8_LDB(B1, 1, 1); PG8_SCHED; PG8_LDA(At, 1, 0); PG8_STAGE(PG8_SA(0, 1), a2 + hstep, voffA);
            PG8_WAIT_V(8); PG8_WAIT_L(0); PG8_BAR; PG8_MMA(0, 0, At, B0); PG8_MMA(0, 1, At, B1); PG8_BAR; PG8_SCHED;
            PG8_LDA(At, 1, 1); PG8_STAGE(PG8_SB(1, 0), b3, voffB); PG8_STAGE(PG8_SB(1, 1), b3 + hstepB, voffB); PG8_STAGE(PG8_SA(1, 0), a3, voffA);
            PG8_WAIT_V(8); PG8_WAIT_L(0); PG8_BAR; PG8_MMA(1, 0, At, B0); PG8_MMA(1, 1, At, B1); PG8_BAR; PG8_SCHED;
            } else {
            PG8_LDB(B0, 0, 0); PG8_SCHED; PG8_LDA(At, 0, 0); PG8_STAGE(PG8_SA(1, 1), a1 + hstep, voffA);
            PG8_WAIT_L(8); PG8_BAR; PG8_WAIT_L(0); PG8_MMA(0, 0, At, B0); PG8_BAR; PG8_SCHED;
            PG8_LDB(B1, 0, 1); PG8_STAGE(PG8_SB(0, 0), b2, voffB);
            PG8_BAR; PG8_WAIT_L(0); PG8_MMA(0, 1, At, B1); PG8_BAR;
            PG8_LDA(At, 0, 1); PG8_STAGE(PG8_SA(0, 0), a2, voffA);
            PG8_BAR; PG8_WAIT_L(0); PG8_MMA(1, 0, At, B0); PG8_BAR; PG8_SCHED;
            PG8_STAGE(PG8_SB(0, 1), b2 + hstepB, voffB);
            PG8_WAIT_V(6); PG8_BAR; PG8_MMA(1, 1, At, B1); PG8_BAR;
            PG8_LDB(B0, 1, 0); PG8_SCHED; PG8_LDA(At, 1, 0); PG8_STAGE(PG8_SA(0, 1), a2 + hstep, voffA);
            PG8_WAIT_L(8); PG8_BAR; PG8_WAIT_L(0); PG8_MMA(0, 0, At, B0); PG8_BAR; PG8_SCHED;
            PG8_LDB(B1, 1, 1); PG8_STAGE(PG8_SB(1, 0), b3, voffB);
            PG8_BAR; PG8_WAIT_L(0); PG8_MMA(0, 1, At, B1); PG8_BAR;
            PG8_LDA(At, 1, 1); PG8_STAGE(PG8_SA(1, 0), a3, voffA);
            PG8_BAR; PG8_WAIT_L(0); PG8_MMA(1, 0, At, B0); PG8_BAR; PG8_SCHED;
            PG8_STAGE(PG8_SB(1, 1), b3 + hstepB, voffB);
            PG8_WAIT_V(6); PG8_BAR; PG8_MMA(1, 1, At, B1); PG8_BAR;
            }
        }
        if constexpr (ALIGN_EPI) { if (wr == 0) PG8_BAR; }
        if constexpr (!Epi::AFTER_DRAIN) { E(acc, cur, wr, wc, fr, fq); S.done(cur); }
        if (!has_next) break;
#pragma unroll
        for (int a = 0; a < 2; ++a)
#pragma unroll
            for (int b = 0; b < 2; ++b)
#pragma unroll
                for (int m = 0; m < 4; ++m)
#pragma unroll
                    for (int n = 0; n < 2; ++n) acc[a][b][m][n] = (f32x4){0.f, 0.f, 0.f, 0.f};
        cur = nxt; cA = nA; cB = nB; ++ui;
        if constexpr (ALIGN_EPI) { if (wr == 1) PG8_BAR; }
    }
    PG8_WAIT_V(0);
    if constexpr (!ALIGN_EPI) { if (wr == 0) PG8_BAR; }
    PG8_BAR;
    if constexpr (Epi::AFTER_DRAIN) { E.fused(acc, cur, wr, wc, fr, fq, lds, wid, lane); S.done(cur); }
#undef PG8_SA
#undef PG8_SB
#undef PG8_STAGE
#undef PG8_LDA
#undef PG8_LDB
#undef PG8_MMA
#undef PG8_WAIT_V
#undef PG8_WAIT_L
#undef PG8_BAR
#undef PG8_SCHED
}
}
constexpr int NWAVES = 8;
constexpr int NB = 8, T = 4096, D = 1024, NTOK = NB * T;
constexpr int DA = 512, DF = 512, NH = 8, HD = 64, GW = 64, ROWS = 64, WH = 8, WW = 16;
constexpr int NPROJ = 2048, NE = 32, DE = 256;
constexpr int MAXROWS = 73728;
constexpr float EPS = 1e-6f, LOG2E = 1.4426950408889634f, QSCALE = 0.125f * LOG2E;
constexpr size_t MiB = 1u << 20;
constexpr size_t WS_CTL = 0, CTL_ZERO_BYTES = 1 * MiB;
constexpr size_t WS_WIN = 2 * MiB, WS_WOUT = 6 * MiB, WS_WGU = 8 * MiB, WS_WD = 40 * MiB, WS_WR = 56 * MiB, WS_MIXT = 57 * MiB  , WS_DFT1 = WS_MIXT + 256 * 1024  ,
                 WS_T2 = WS_MIXT + 320 * 1024  , WS_TW = WS_MIXT + 384 * 1024  ;
constexpr size_t WS_ROUTE = 58 * MiB;
constexpr size_t WS_META = 59 * MiB;
constexpr size_t WS_XN = 64 * MiB;
constexpr size_t WS_QKVU = 128 * MiB;
constexpr size_t WS_X1 = 256 * MiB;
constexpr size_t WS_MF = 384 * MiB;
constexpr size_t WS_HD = 388 * MiB;
constexpr size_t WS_END = 512 * MiB;
constexpr int CW_BAR = 4096, CW_CNT = 16384;
constexpr int RING_BYTES = 131072, RT_BYTES = 36 * 1024 * 4  , LDSCTL_OFF = 147456, LDS_BYTES = 155648;
constexpr int L_MISC = LDSCTL_OFF;
constexpr int L_PBASE = LDSCTL_OFF + 256;
constexpr int L_LCNT = LDSCTL_OFF + 512;
constexpr int L_GBASE = LDSCTL_OFF + 768;
constexpr int L_RT = LDSCTL_OFF + 1024;
constexpr int L_LGS = LDSCTL_OFF + 3072;
static_assert(L_LGS + 8 * 72 * 4 <= LDS_BYTES, "LDS map");
static_assert(RT_BYTES <= LDSCTL_OFF && L_RT + 4 * 128 * 4 <= LDS_BYTES, "LDS map");

#define LAS __attribute__((address_space(3)))
typedef unsigned short bf16;
typedef unsigned v4u __attribute__((ext_vector_type(4)));
typedef unsigned v2u __attribute__((ext_vector_type(2)));
typedef float f32x4 __attribute__((ext_vector_type(4)));
#define LDS_WAIT() asm volatile("s_waitcnt lgkmcnt(0)" ::: "memory")
#define VM_WAIT() asm volatile("s_waitcnt vmcnt(0)" ::: "memory")
__device__ __forceinline__ unsigned f2bf(float f) { unsigned u = __builtin_bit_cast(unsigned, f); return (u + 0x7fffu + ((u >> 16) & 1u)) >> 16; }
__device__ __forceinline__ unsigned pk2(float lo, float hi) { return f2bf(lo) | (f2bf(hi) << 16); }
typedef float f32x2_t __attribute__((ext_vector_type(2))); typedef __bf16 bf16x2_t __attribute__((ext_vector_type(2)));
__device__ __forceinline__ unsigned cvtpk(float lo, float hi) { f32x2_t v = {lo, hi}; bf16x2_t b = __builtin_convertvector(v, bf16x2_t); return __builtin_bit_cast(unsigned, b); }
__device__ __forceinline__ float bf2f(unsigned short b) { return __builtin_bit_cast(float, (unsigned)b << 16); }
__device__ __forceinline__ float bflo(unsigned w) { return __builtin_bit_cast(float, w << 16); }
__device__ __forceinline__ float bfhi(unsigned w) { return __builtin_bit_cast(float, w & 0xffff0000u); }
__device__ __forceinline__ float wave_sum(float v) {
#pragma unroll
    for (int o = 1; o < 64; o <<= 1) v += __shfl_xor(v, o);
    return v;
}
#define XB_TMO      128
#define XB_XCNT(j)  (256  + 64 * (j))
#define XB_XSUB(j)  (1280 + 64 * (j))
#define XB_XGEN(j)  (2304 + 64 * (j))
#define XB_TOP      3328
#define XB_TOPGEN   3392
#define XCD_BAR_WORDS 3456
#define XB_SPIN_CAP (1u << 18)

__device__ __forceinline__ unsigned xb_ld(unsigned* p)              { return __hip_atomic_load(p, __ATOMIC_RELAXED, __HIP_MEMORY_SCOPE_AGENT); }
__device__ __forceinline__ unsigned xb_add(unsigned* p, unsigned v) { return __hip_atomic_fetch_add(p, v, __ATOMIC_RELAXED, __HIP_MEMORY_SCOPE_AGENT); }
__device__ __forceinline__ unsigned xb_xcc_id() { return (unsigned)__builtin_amdgcn_s_getreg((3 << 11) | 20) & 0xFu; }
#define XB_SPIN(cond, bar) do { unsigned _sp = 0; while (cond) { __builtin_amdgcn_s_sleep(1); \
    if ((++_sp & 255u) == 0u) { if (xb_ld(&(bar)[XB_TMO])) break; if (_sp > XB_SPIN_CAP) { atomicAdd(&(bar)[XB_TMO], 1u); break; } } } } while (0)

struct XcdBarrier {
    unsigned* bar; unsigned x;
    volatile LAS unsigned* st;
};

__device__ __forceinline__ XcdBarrier xcd_barrier_post(unsigned* bar, volatile LAS unsigned* st) {
    XcdBarrier b; b.bar = bar; b.x = xb_xcc_id(); b.st = st;
    if (threadIdx.x == 0) (void)xb_add(&bar[XB_XCNT(b.x)], 1u);
    return b;
}
__device__ __forceinline__ void xcd_barrier_complete(unsigned* bar, unsigned x, unsigned& nloc, unsigned& nx) {
    const unsigned G = gridDim.x * gridDim.y * gridDim.z;
    unsigned sum, cnt, mine, sp = 0u;
    for (;;) {
        sum = 0u; cnt = 0u; mine = 0u;
#pragma unroll
        for (unsigned j = 0; j < 16; ++j) { const unsigned c = xb_ld(&bar[XB_XCNT(j)]); sum += c; cnt += (c > 0u) ? 1u : 0u; mine = (j == x) ? c : mine; }
        if (sum == G) break;
        __builtin_amdgcn_s_sleep(1);
        if ((++sp & 255u) == 0u) { if (xb_ld(&bar[XB_TMO])) break; if (sp > XB_SPIN_CAP) { atomicAdd(&bar[XB_TMO], 1u); break; } }
    }
    nloc = mine > 0u ? mine : 1u; nx = cnt > 0u ? cnt : 1u;
}

__device__ __forceinline__ void xcd_barrier(const XcdBarrier& b) {
    asm volatile("s_waitcnt vmcnt(0)" ::: "memory");
    __syncthreads();
    if (threadIdx.x == 0) {
        unsigned* bar = b.bar;
        __builtin_amdgcn_s_waitcnt(0);
        unsigned nloc = b.st[0], nx = b.st[1];
        if (nloc == 0u) { xcd_barrier_complete(bar, b.x, nloc, nx); b.st[0] = nloc; b.st[1] = nx; }
        const unsigned old = xb_add(&bar[XB_XSUB(b.x)], 1u);
        const unsigned gen = old / nloc;
        if (old + 1u == (gen + 1u) * nloc) {
            __builtin_amdgcn_fence(__ATOMIC_RELEASE, "agent");
            asm volatile("s_waitcnt vmcnt(0)" ::: "memory");
            const unsigned og = xb_add(&bar[XB_TOP], 1u);
            const unsigned tg = og / nx;
            if (og + 1u == (tg + 1u) * nx) xb_add(&bar[XB_TOPGEN], 1u);
            else XB_SPIN(xb_ld(&bar[XB_TOPGEN]) == tg, bar);
            __builtin_amdgcn_fence(__ATOMIC_ACQUIRE, "agent");
            xb_add(&bar[XB_XGEN(b.x)], 1u);
            asm volatile("s_waitcnt vmcnt(0)" ::: "memory");
        } else {
            XB_SPIN(xb_ld(&bar[XB_XGEN(b.x)]) == gen, bar);
            __builtin_amdgcn_fence(__ATOMIC_ACQUIRE, "agent");
            asm volatile("s_waitcnt vmcnt(0)" ::: "memory");
        }
    }
    __syncthreads();
}
struct Args { const float* in[18]; float* out; unsigned char* ws; };
struct Frame {
    LAS unsigned char* lds; unsigned* ctl; unsigned char* ws; float* out;
    int tid, lane, wave, vcu, G;
};
#define GW_ID(F) ((F).vcu * NWAVES + (F).wave)
#define N_GW(F) ((F).G * NWAVES)

__device__ __forceinline__ void tr_item(const float* W, int K, int N, bf16* WT, int drow, const float* kscale, LAS float* scr, int k0, int n0, int lane) {
#pragma unroll 8
    for (int i = 0; i < 32; ++i) { const int kk = 2 * i + (lane >> 5); float v = W[(size_t)(k0 + kk) * N + n0 + (lane & 31)]; if (kscale) v *= kscale[k0 + kk]; scr[kk * 33 + (lane & 31)] = v; }
    LDS_WAIT(); asm volatile("" ::: "memory");
    const int c = lane & 7;
#pragma unroll
    for (int j = 0; j < 4; ++j) { const int n = (lane >> 3) + 8 * j; const LAS float* s = scr + (8 * c) * 33 + n;
        v4u o; o.x = pk2(s[0 * 33], s[1 * 33]); o.y = pk2(s[2 * 33], s[3 * 33]); o.z = pk2(s[4 * 33], s[5 * 33]); o.w = pk2(s[6 * 33], s[7 * 33]);
        *(v4u*)(WT + (size_t)(drow + n) * K + k0 + 8 * c) = o; }
    LDS_WAIT(); asm volatile("" ::: "memory");
}
__device__ __forceinline__ void phase_prep(Frame& F, const Args& A) {
    LAS float* scr = (LAS float*)(F.lds + F.wave * 16384);
    const int gw = GW_ID(F), NGW = N_GW(F), lane = F.lane;
    bf16* WinT = (bf16*)(F.ws + WS_WIN); bf16* WoutT = (bf16*)(F.ws + WS_WOUT); bf16* Wgu = (bf16*)(F.ws + WS_WGU); bf16* Wd = (bf16*)(F.ws + WS_WD);
    constexpr int I_IN = 16 * 64, I_OUT = 16 * 32, I_G = 32 * 128, I_D = 32 * 128, NITEMS = I_IN + I_OUT + 2 * I_G + I_D;
    for (int it = gw; it < NITEMS; it += NGW) {
        int r = it;
        if (r < I_IN) { const int n0 = 32 * (r % 64), seg = n0 >> 9; const int drow = seg == 2 ? n0 + 512 : seg == 3 ? n0 - 512 : n0;
            tr_item(A.in[2], 1024, 2048, WinT, drow, nullptr, scr, 64 * (r / 64), n0, lane); continue; } r -= I_IN;
        if (r < I_OUT) { tr_item(A.in[8], 1024, 1024, WoutT, 32 * (r % 32), nullptr, scr, 64 * (r / 32), 32 * (r % 32), lane); continue; } r -= I_OUT;
        if (r < 2 * I_G) { const int up = r >= I_G ? 1 : 0; r -= up * I_G; const int e = r / 128, q = r % 128, kb = q / 8, n0 = 32 * (q % 8);
            tr_item(A.in[14 + up] + (size_t)e * 1024 * 256, 1024, 256, Wgu, e * 512 + (n0 / 128) * 256 + up * 128 + (n0 % 128), A.in[9], scr, 64 * kb, n0, lane); continue; } r -= 2 * I_G;
        { const int e = r / 128, q = r % 128, kb = q / 32, n0 = 32 * (q % 32);
            tr_item(A.in[16] + (size_t)e * 256 * 1024, 256, 1024, Wd + (size_t)e * 1024 * 256, n0, nullptr, scr, 64 * kb, n0, lane); }
    }
    { const float* g = A.in[1]; bf16* XN = (bf16*)(F.ws + WS_XN);
      f32x4 gv[4];
#pragma unroll
      for (int j = 0; j < 4; ++j) gv[j] = ((const f32x4*)g)[64 * j + lane];
      for (int m = gw; m < NTOK; m += NGW) {
        const f32x4* xr = (const f32x4*)(A.in[0] + (size_t)m * D) + lane; f32x4 v[4]; float s = 0.f;
#pragma unroll
        for (int j = 0; j < 4; ++j) { v[j] = xr[64 * j]; s += (v[j].x * v[j].x + v[j].y * v[j].y) + (v[j].z * v[j].z + v[j].w * v[j].w); }
        const float rstd = 1.0f / sqrtf(wave_sum(s) * (1.f / D) + EPS);
        unsigned long long* o8 = (unsigned long long*)(XN + (size_t)m * D) + lane;
#pragma unroll
        for (int j = 0; j < 4; ++j) { const f32x4 w = v[j] * rstd * gv[j]; o8[64 * j] = (unsigned long long)pk2(w.x, w.y) | ((unsigned long long)pk2(w.z, w.w) << 32); }
      } }
    { float* WR = (float*)(F.ws + WS_WR); const float* nm = A.in[9];
      for (int i = gw * 64 + lane; i < 36 * 1024; i += NGW * 64) { const int j = i / 1024, k = i % 1024; WR[i] = nm[k] * (j < 4 ? A.in[10][k * 4 + j] : A.in[12][k * 32 + (j - 4)]); } }
    { bf16* DFT1 = (bf16*)(F.ws + WS_DFT1); bf16* T2 = (bf16*)(F.ws + WS_T2); float* TW = (float*)(F.ws + WS_TW); bf16* MIXT = (bf16*)(F.ws + WS_MIXT); const float* wf = A.in[4];
      for (int i = gw * 64 + lane; i < 128 * 64; i += NGW * 64) { const int m = i >> 6, t1 = i & 63; const float ph = (float)(((m & 63) * t1) & 63) * (1.f / 64.f);
          DFT1[i] = (bf16)f2bf(m < 64 ? __builtin_amdgcn_cosf(ph) : -__builtin_amdgcn_sinf(ph)); }
      for (int i = gw * 64 + lane; i < 2 * 64 * 128; i += NGW * 64) { const int part = i >> 13, k2 = (i >> 7) & 63, k = i & 127, t2 = k & 63; const float ph = (float)((k2 * t2) & 63) * (1.f / 64.f);
          const float cs = __builtin_amdgcn_cosf(ph), sn = __builtin_amdgcn_sinf(ph); T2[i] = (bf16)f2bf(part == 0 ? (k < 64 ? cs : sn) : (k < 64 ? -sn : cs)); }
      for (int i = gw * 64 + lane; i < 64 * 64; i += NGW * 64) { const int t2 = i >> 6, k1 = i & 63; const float ph = (float)(t2 * k1) * (1.f / 4096.f); TW[2 * i] = __builtin_amdgcn_cosf(ph); TW[2 * i + 1] = -__builtin_amdgcn_sinf(ph); }
      for (int i = gw * 64 + lane; i < 8 * 64 * 128; i += NGW * 64) { const int grp = i >> 13, d = (i >> 7) & 63, k = i & 127, s = k >> 5, gg = (k >> 3) & 3, jj = k & 7;
          const int c = 32 * (s & 1) + (jj < 4 ? 4 * gg + jj : 16 + 4 * gg + jj - 4); float a = 0.f;
          for (int e = 0; e < 64; ++e) { const float ph = (float)((c * e) & 63) * (1.f / 64.f); a += ((s >> 1) ? __builtin_amdgcn_sinf(ph) : __builtin_amdgcn_cosf(ph)) * wf[(grp * 64 + e) * 64 + d]; }
          MIXT[i] = (bf16)f2bf(a * (1.f / 512.f)); } }
}

__device__ __forceinline__ void phase_attn(Frame& F, const Args& A) {
    typedef short bf16x8 __attribute__((ext_vector_type(8)));
    LAS float* bt = (LAS float*)F.lds;
    for (int i = F.tid; i < 8 * 15 * 32; i += NWAVES * 64) { const int dc = i & 31, hd = i >> 5; bt[i] = (dc < 31) ? LOG2E * A.in[3][hd * 31 + dc] : -1e30f; }
    __syncthreads();
    const bf16* Q = (const bf16*)(F.ws + WS_QKVU); const bf16* Kb = Q + (size_t)NTOK * 512; const bf16* VT = Q + (size_t)3 * NTOK * 512;
    float* mf = (float*)F.out;
    const int lane = F.lane, q16 = lane & 15, g = lane >> 4, h = F.wave;
    for (int unit = F.vcu; unit < NB * ROWS; unit += F.G) {
        const int b = unit / ROWS, r = unit % ROWS, rs = min(max(r - WH / 2, 0), ROWS - WH);
#pragma unroll 1
        for (int j = 0; j < 4; ++j) {
            const int cb = (j == 0) ? 0 : (j == 1) ? 8 : (j == 2) ? 24 : 32;
            const int c = 16 * j + q16, cs = min(max(c - WW / 2, 0), GW - WW);
            const size_t qtok = (size_t)b * T + r * GW + c;
            bf16x8 qf[2];
#pragma unroll
            for (int ks = 0; ks < 2; ++ks) qf[ks] = *(const bf16x8*)(Q + qtok * 512 + h * HD + 32 * ks + 8 * g);
            unsigned boff[2][4];
#pragma unroll
            for (int t = 0; t < 2; ++t)
#pragma unroll
                for (int e = 0; e < 4; ++e) { const int kc = cb + 8 * g + 4 * t + e; const bool ok = (kc >= cs) && (kc <= cs + WW - 1); const int dc = ok ? (kc - c + WW - 1) : 31;
                    boff[t][e] = (unsigned)(((h * 15 + (rs - r + WH - 1)) * 32 + dc) * 4); }
            float sc[8][2][4]; float mx = -1e30f;
            const int krow_l = 8 * (q16 >> 2) + (q16 & 3);
#pragma unroll
            for (int i = 0; i < 8; ++i) {
                const size_t ktok0 = (size_t)b * T + (rs + i) * GW + cb;
#pragma unroll
                for (int t = 0; t < 2; ++t) {
                    const bf16* kp = Kb + (ktok0 + krow_l + 4 * t) * 512 + h * HD + 8 * g;
                    const bf16x8 k0 = *(const bf16x8*)kp, k1 = *(const bf16x8*)(kp + 32);
                    f32x4 a = {0.f, 0.f, 0.f, 0.f};
                    a = __builtin_amdgcn_mfma_f32_16x16x32_bf16(k0, qf[0], a, 0, 0, 0);
                    a = __builtin_amdgcn_mfma_f32_16x16x32_bf16(k1, qf[1], a, 0, 0, 0);
#pragma unroll
                    for (int e = 0; e < 4; ++e) { const float s = a[e] + *(const LAS float*)((const LAS char*)bt + boff[t][e] + i * 128); sc[i][t][e] = s; mx = fmaxf(mx, s); }
                }
            }
            mx = fmaxf(mx, __shfl_xor(mx, 16)); mx = fmaxf(mx, __shfl_xor(mx, 32));
            float lsum = 0.f; bf16x8 pf[8];
#pragma unroll
            for (int i = 0; i < 8; ++i) {
                float p[2][4];
#pragma unroll
                for (int t = 0; t < 2; ++t)
#pragma unroll
                    for (int e = 0; e < 4; ++e) { p[t][e] = __builtin_amdgcn_exp2f(sc[i][t][e] - mx); lsum += p[t][e]; }
                v4u w; w.x = cvtpk(p[0][0], p[0][1]); w.y = cvtpk(p[0][2], p[0][3]); w.z = cvtpk(p[1][0], p[1][1]); w.w = cvtpk(p[1][2], p[1][3]);
                pf[i] = __builtin_bit_cast(bf16x8, w);
            }
            lsum += __shfl_xor(lsum, 16); lsum += __shfl_xor(lsum, 32);
            f32x4 o[4];
#pragma unroll
            for (int dt = 0; dt < 4; ++dt) o[dt] = (f32x4){0.f, 0.f, 0.f, 0.f};
#pragma unroll
            for (int i = 0; i < 8; ++i) {
                const bf16* vp = VT + (size_t)(h * HD + q16) * NTOK + (size_t)b * T + (rs + i) * GW + cb + 8 * g;
#pragma unroll
                for (int dt = 0; dt < 4; ++dt) { const bf16x8 vf = *(const bf16x8*)(vp + (size_t)dt * 16 * NTOK); o[dt] = __builtin_amdgcn_mfma_f32_16x16x32_bf16(vf, pf[i], o[dt], 0, 0, 0); }
            }
            const float inv = 1.0f / lsum;
#pragma unroll
            for (int dt = 0; dt < 4; ++dt) *(f32x4*)(mf + qtok * D + h * HD + 16 * dt + 4 * g) = o[dt] * inv;
        }
    }
    __syncthreads();
}
__device__ __forceinline__ void phase_fft1(Frame& F, const Args& A) {
    typedef short bf16x8 __attribute__((ext_vector_type(8)));
    const bf16* UT = (const bf16*)(F.ws + WS_QKVU) + (size_t)2 * NTOK * 512; const bf16* DFT1 = (const bf16*)(F.ws + WS_DFT1); const float2* TW = (const float2*)(F.ws + WS_TW);
    bf16* X1T = (bf16*)(F.ws + WS_MF);
    const int lane = F.lane, q16 = lane & 15, g = lane >> 4;
    for (int u = GW_ID(F); u < NB * 8 * 32; u += N_GW(F)) {
        const int ct = u & 31, t2b = (u >> 5) & 7, b = u >> 8, ch = 16 * ct + q16;
        bf16x8 bfr[8][2];
#pragma unroll
        for (int t2 = 0; t2 < 8; ++t2)
#pragma unroll
            for (int ks = 0; ks < 2; ++ks) bfr[t2][ks] = *(const bf16x8*)(UT + (size_t)ch * NTOK + (size_t)b * T + (8 * t2b + t2) * 64 + 32 * ks + 8 * g);
#pragma unroll 1
        for (int kt = 0; kt < 4; ++kt) {
            bf16x8 are[2], aim[2];
#pragma unroll
            for (int ks = 0; ks < 2; ++ks) { are[ks] = *(const bf16x8*)(DFT1 + (16 * kt + q16) * 64 + 32 * ks + 8 * g); aim[ks] = *(const bf16x8*)(DFT1 + (64 + 16 * kt + q16) * 64 + 32 * ks + 8 * g); }
            float xr[8][4], xi[8][4];
#pragma unroll
            for (int t2 = 0; t2 < 8; ++t2) {
                f32x4 ar = {0.f, 0.f, 0.f, 0.f}, ai = {0.f, 0.f, 0.f, 0.f};
                ar = __builtin_amdgcn_mfma_f32_16x16x32_bf16(are[0], bfr[t2][0], ar, 0, 0, 0); ar = __builtin_amdgcn_mfma_f32_16x16x32_bf16(are[1], bfr[t2][1], ar, 0, 0, 0);
                ai = __builtin_amdgcn_mfma_f32_16x16x32_bf16(aim[0], bfr[t2][0], ai, 0, 0, 0); ai = __builtin_amdgcn_mfma_f32_16x16x32_bf16(aim[1], bfr[t2][1], ai, 0, 0, 0);
#pragma unroll
                for (int e = 0; e < 4; ++e) { const float2 w = TW[(8 * t2b + t2) * 64 + 16 * kt + 4 * g + e]; xr[t2][e] = ar[e] * w.x - ai[e] * w.y; xi[t2][e] = ar[e] * w.y + ai[e] * w.x; }
            }
#pragma unroll
            for (int e = 0; e < 4; ++e) { const int k1 = 16 * kt + 4 * g + e;
                v4u wr, wi; wr.x = cvtpk(xr[0][e], xr[1][e]); wr.y = cvtpk(xr[2][e], xr[3][e]); wr.z = cvtpk(xr[4][e], xr[5][e]); wr.w = cvtpk(xr[6][e], xr[7][e]);
                wi.x = cvtpk(xi[0][e], xi[1][e]); wi.y = cvtpk(xi[2][e], xi[3][e]); wi.z = cvtpk(xi[4][e], xi[5][e]); wi.w = cvtpk(xi[6][e], xi[7][e]);
                v4u* dst = (v4u*)(X1T + ((((size_t)(b * 64 + k1) * 8 + t2b) * 512 + ch) << 4)); dst[0] = wr; dst[1] = wi; }
        }
    }
}
__device__ __forceinline__ void phase_fft2(Frame& F, const Args& A) {
    typedef short bf16x8 __attribute__((ext_vector_type(8)));
    const bf16* X1T = (const bf16*)(F.ws + WS_MF); const bf16* T2 = (const bf16*)(F.ws + WS_T2); const bf16* MIXT = (const bf16*)(F.ws + WS_MIXT);
    bf16* mg = (bf16*)(F.ws + WS_X1); const float* bfour = A.in[5]; const float* gfour = A.in[7];
    const int lane = F.lane, q16 = lane & 15, g = lane >> 4;
    LAS unsigned char* slab = F.lds + F.wave * 16512;
    for (int u = GW_ID(F); u < NB * 64 * 4; u += N_GW(F)) {
        const int k2t = u & 3, k1 = (u >> 2) & 63, b = u >> 8;
        bf16x8 wb[2][4];
#pragma unroll
        for (int part = 0; part < 2; ++part)
#pragma unroll
            for (int ks = 0; ks < 4; ++ks) wb[part][ks] = *(const bf16x8*)(T2 + (part * 64 + 16 * k2t + q16) * 128 + 32 * ks + 8 * g);
        float ssq = 0.f;
#pragma unroll 1
        for (int grp = 0; grp < 8; ++grp) {
            f32x4 yr[4], yi[4];
#pragma unroll
            for (int ctile = 0; ctile < 4; ++ctile) {
                const int c = grp * 64 + 16 * ctile + q16; bf16x8 af[4];
#pragma unroll
                for (int ks = 0; ks < 4; ++ks) af[ks] = *(const bf16x8*)(X1T + ((((size_t)(b * 64 + k1) * 8 + 4 * (ks & 1) + g) * 512 + c) << 4) + (ks >> 1) * 8);
                f32x4 r = {0.f, 0.f, 0.f, 0.f}, im = {0.f, 0.f, 0.f, 0.f};
#pragma unroll
                for (int ks = 0; ks < 4; ++ks) { r = __builtin_amdgcn_mfma_f32_16x16x32_bf16(af[ks], wb[0][ks], r, 0, 0, 0); im = __builtin_amdgcn_mfma_f32_16x16x32_bf16(af[ks], wb[1][ks], im, 0, 0, 0); }
                yr[ctile] = r; yi[ctile] = im;
            }
            bf16x8 yb[4];
#pragma unroll
            for (int s = 0; s < 4; ++s) { const f32x4 lo = (s < 2) ? yr[2 * (s & 1)] : yi[2 * (s & 1)], hi = (s < 2) ? yr[2 * (s & 1) + 1] : yi[2 * (s & 1) + 1];
                v4u w; w.x = cvtpk(lo[0], lo[1]); w.y = cvtpk(lo[2], lo[3]); w.z = cvtpk(hi[0], hi[1]); w.w = cvtpk(hi[2], hi[3]); yb[s] = __builtin_bit_cast(bf16x8, w); }
#pragma unroll
            for (int dt = 0; dt < 4; ++dt) {
                f32x4 acc = {0.f, 0.f, 0.f, 0.f};
#pragma unroll
                for (int s = 0; s < 4; ++s) { const bf16x8 ma = *(const bf16x8*)(MIXT + ((size_t)(grp * 64 + 16 * dt + q16) << 7) + 32 * s + 8 * g); acc = __builtin_amdgcn_mfma_f32_16x16x32_bf16(ma, yb[s], acc, 0, 0, 0); }
                const f32x4 bv = *(const f32x4*)(bfour + grp * 64 + 16 * dt + 4 * g); acc += bv;
                ssq += (acc[0] * acc[0] + acc[1] * acc[1]) + (acc[2] * acc[2] + acc[3] * acc[3]);
                v2u w; w.x = cvtpk(acc[0], acc[1]); w.y = cvtpk(acc[2], acc[3]);
                *(LAS v2u*)(slab + q16 * 1032 + (grp * 64 + 16 * dt + 4 * g) * 2) = w;
            }
        }
        ssq += __shfl_xor(ssq, 16); ssq += __shfl_xor(ssq, 32);
        const float rstd = 1.0f / sqrtf(ssq * (1.f / 512.f) + EPS);
        LDS_WAIT(); asm volatile("" ::: "memory");
        const f32x4 g0 = *(const f32x4*)(gfour + lane * 8), g1 = *(const f32x4*)(gfour + lane * 8 + 4);
#pragma unroll 4
        for (int row = 0; row < 16; ++row) {
            const float rs = __shfl(rstd, row);
            const v2u a = *(const LAS v2u*)(slab + row * 1032 + lane * 16), c2 = *(const LAS v2u*)(slab + row * 1032 + lane * 16 + 8);
            v4u o; o.x = cvtpk(bflo(a.x) * rs * g0[0], bfhi(a.x) * rs * g0[1]); o.y = cvtpk(bflo(a.y) * rs * g0[2], bfhi(a.y) * rs * g0[3]);
            o.z = cvtpk(bflo(c2.x) * rs * g1[0], bfhi(c2.x) * rs * g1[1]); o.w = cvtpk(bflo(c2.y) * rs * g1[2], bfhi(c2.y) * rs * g1[3]);
            *(v4u*)(mg + ((size_t)b * T + k1 + 64 * (16 * k2t + row)) * D + DA + lane * 8) = o;
        }
        LDS_WAIT(); asm volatile("" ::: "memory");
    }
}
__device__ __forceinline__ void phase_attn_norm(Frame& F, const Args& A) {
    const float* mf = (const float*)F.out; bf16* mg = (bf16*)(F.ws + WS_X1); const int lane = F.lane;
    const f32x4 g0 = *(const f32x4*)(A.in[6] + lane * 8), g1 = *(const f32x4*)(A.in[6] + lane * 8 + 4);
    for (int tok = GW_ID(F); tok < NTOK; tok += N_GW(F)) {
        const f32x4* src = (const f32x4*)(mf + (size_t)tok * D + lane * 8); const f32x4 a = src[0], c = src[1];
        float s = (a.x * a.x + a.y * a.y) + (a.z * a.z + a.w * a.w) + (c.x * c.x + c.y * c.y) + (c.z * c.z + c.w * c.w);
        const float rstd = 1.0f / sqrtf(wave_sum(s) * (1.f / 512.f) + EPS);
        const f32x4 x = a * rstd * g0, y = c * rstd * g1;
        v4u o; o.x = pk2(x.x, x.y); o.y = pk2(x.z, x.w); o.z = pk2(y.x, y.y); o.w = pk2(y.z, y.w);
        *(v4u*)(mg + (size_t)tok * D + lane * 8) = o;
    }
}
__device__ __forceinline__ void phase_router(Frame& F, const Args& A) {
    LAS float* wt = (LAS float*)F.lds;
    { const f32x4* src = (const f32x4*)(F.ws + WS_WR); for (int i = F.tid; i < 36 * 256; i += NWAVES * 64) ((LAS f32x4*)wt)[i] = src[i]; }
    LAS int* lcnt = (LAS int*)(F.lds + L_LCNT); LAS int* gbase = (LAS int*)(F.lds + L_GBASE); LAS int* rt = (LAS int*)(F.lds + L_RT);
    const bf16* h = (const bf16*)(F.ws + WS_XN);
    int2* e01 = (int2*)(F.ws + WS_ROUTE); int2* rank = e01 + NTOK; float2* wgt = (float2*)(rank + NTOK); float* rstd = (float*)(wgt + NTOK);
    const float* brc = A.in[11]; const float* brf = A.in[13]; const int lane = F.lane;
    for (int batch = F.vcu; batch < NTOK / 128; batch += F.G) {
        if (F.tid < 32) lcnt[F.tid] = 0;
        __syncthreads();
#pragma unroll 1
        for (int pass = 0; pass < 8; ++pass) {
            const int tl0 = F.wave * 16 + pass * 2;
            float hv[2][16]; float rs[2];
#pragma unroll
            for (int t = 0; t < 2; ++t) { const v4u* src = (const v4u*)(h + (size_t)(batch * 128 + tl0 + t) * D + lane * 16); const v4u a = src[0], b = src[1];
                hv[t][0] = bflo(a.x); hv[t][1] = bfhi(a.x); hv[t][2] = bflo(a.y); hv[t][3] = bfhi(a.y); hv[t][4] = bflo(a.z); hv[t][5] = bfhi(a.z); hv[t][6] = bflo(a.w); hv[t][7] = bfhi(a.w);
                hv[t][8] = bflo(b.x); hv[t][9] = bfhi(b.x); hv[t][10] = bflo(b.y); hv[t][11] = bfhi(b.y); hv[t][12] = bflo(b.z); hv[t][13] = bfhi(b.z); hv[t][14] = bflo(b.w); hv[t][15] = bfhi(b.w);
                float s = 0.f;
#pragma unroll
                for (int i = 0; i < 16; ++i) s += hv[t][i] * hv[t][i];
                rs[t] = 1.0f / sqrtf(wave_sum(s) * (1.f / D) + EPS); }
            LAS float* lgs = (LAS float*)(F.lds + L_LGS) + F.wave * 72;
#pragma unroll 4
            for (int j = 0; j < 36; ++j) { const LAS f32x4* wr = (const LAS f32x4*)(wt + j * 1024 + lane * 16); const f32x4 w0 = wr[0], w1 = wr[1], w2 = wr[2], w3 = wr[3];
#pragma unroll
                for (int t = 0; t < 2; ++t) { float s = hv[t][0] * w0.x + hv[t][1] * w0.y + hv[t][2] * w0.z + hv[t][3] * w0.w + hv[t][4] * w1.x + hv[t][5] * w1.y + hv[t][6] * w1.z + hv[t][7] * w1.w
                        + hv[t][8] * w2.x + hv[t][9] * w2.y + hv[t][10] * w2.z + hv[t][11] * w2.w + hv[t][12] * w3.x + hv[t][13] * w3.y + hv[t][14] * w3.z + hv[t][15] * w3.w;
                    s = wave_sum(s) * rs[t]; if (lane == 0) lgs[t * 36 + j] = s; } }
            LDS_WAIT(); asm volatile("" ::: "memory");
#pragma unroll
            for (int t = 0; t < 2; ++t) {
                const LAS float* lg = lgs + t * 36;
                const float c0 = lg[0] + brc[0], c1 = lg[1] + brc[1], c2 = lg[2] + brc[2], c3 = lg[3] + brc[3];
                int gi = 0; float mx = c0;
                if (c1 > mx) { mx = c1; gi = 1; }
                if (c2 > mx) { mx = c2; gi = 2; }
                if (c3 > mx) { mx = c3; gi = 3; }
                const float gwt = 1.0f / (expf(c0 - mx) + expf(c1 - mx) + expf(c2 - mx) + expf(c3 - mx));
                float v0 = -1e30f, v1 = -1e30f; int i0 = 0, i1 = 0;
#pragma unroll
                for (int j = 0; j < 8; ++j) { const float f = lg[4 + gi * 8 + j] + brf[gi * 8 + j];
                    if (f > v0) { v1 = v0; i1 = i0; v0 = f; i0 = j; } else if (f > v1) { v1 = f; i1 = j; } }
                const float e1 = expf(v1 - v0), p0 = 1.f / (1.f + e1), p1 = e1 / (1.f + e1);
                if (lane == 0) { const int tl = tl0 + t, tok = batch * 128 + tl, ea = gi * 8 + i0, eb = gi * 8 + i1;
                    const int ra = __hip_atomic_fetch_add(lcnt + ea, 1, __ATOMIC_RELAXED, __HIP_MEMORY_SCOPE_WORKGROUP);
                    const int rb = __hip_atomic_fetch_add(lcnt + eb, 1, __ATOMIC_RELAXED, __HIP_MEMORY_SCOPE_WORKGROUP);
                    rt[tl] = ea; rt[128 + tl] = eb; rt[256 + tl] = ra; rt[384 + tl] = rb;
                    wgt[tok] = make_float2(p0 * gwt, p1 * gwt); rstd[tok] = rs[t]; }
            }
            LDS_WAIT(); asm volatile("" ::: "memory");
        }
        __syncthreads();
        if (F.tid < 32) gbase[F.tid] = (int)__hip_atomic_fetch_add(F.ctl + CW_CNT + 64 * F.tid, (unsigned)lcnt[F.tid], __ATOMIC_RELAXED, __HIP_MEMORY_SCOPE_AGENT);
        __syncthreads();
        if (F.tid < 128) { const int tok = batch * 128 + F.tid, ea = rt[F.tid], eb = rt[128 + F.tid];
            e01[tok] = make_int2(ea, eb); rank[tok] = make_int2(rt[256 + F.tid] + gbase[ea], rt[384 + F.tid] + gbase[eb]); }
        __syncthreads();
    }
}
__device__ __forceinline__ void phase_scatter(Frame& F, const Args& A) {
    LAS int* pbase = (LAS int*)(F.lds + L_PBASE);
    LAS int* lcnt = (LAS int*)(F.lds + L_LCNT);
    if (F.tid < 32) lcnt[F.tid] = (int)__hip_atomic_load(F.ctl + CW_CNT + 64 * F.tid, __ATOMIC_RELAXED, __HIP_MEMORY_SCOPE_AGENT);
    __syncthreads();
    if (F.tid == 0) { int acc = 0; for (int e = 0; e < 32; ++e) { pbase[e] = acc; acc += (lcnt[e] + 255) >> 8; } pbase[32] = acc; }
    __syncthreads();
    float* rstd_s = (float*)(F.ws + WS_META); float* w_s = rstd_s + MAXROWS; int* slotrow_s = (int*)(w_s + MAXROWS);
    for (int e = F.vcu; e < 32; e += F.G) { const int cnt = lcnt[e];
        for (int r = 256 * pbase[e] + cnt + F.tid; r < 256 * pbase[e + 1]; r += NWAVES * 64) { slotrow_s[r] = 2 * NTOK; w_s[r] = 0.f; rstd_s[r] = 0.f; } }
    const bf16* h = (const bf16*)(F.ws + WS_XN); bf16* hs = (bf16*)(F.ws + WS_QKVU);
    const int2* e01 = (const int2*)(F.ws + WS_ROUTE); const int2* rank = e01 + NTOK; const float2* wgt = (const float2*)(rank + NTOK); const float* rstd = (const float*)(wgt + NTOK);
    for (int tok = GW_ID(F); tok < NTOK; tok += N_GW(F)) {
        const int2 e = e01[tok], r = rank[tok]; const float2 w = wgt[tok]; const float rs = rstd[tok];
        const int pos0 = 256 * pbase[e.x] + r.x, pos1 = 256 * pbase[e.y] + r.y;
        const v4u* src = (const v4u*)(h + (size_t)tok * D) + F.lane * 2; const v4u a = src[0], b = src[1];
        v4u* d0 = (v4u*)(hs + (size_t)pos0 * D) + F.lane * 2; d0[0] = a; d0[1] = b;
        v4u* d1 = (v4u*)(hs + (size_t)pos1 * D) + F.lane * 2; d1[0] = a; d1[1] = b;
        if (F.lane == 0) { rstd_s[pos0] = rs; w_s[pos0] = w.x; slotrow_s[pos0] = 2 * tok; rstd_s[pos1] = rs; w_s[pos1] = w.y; slotrow_s[pos1] = 2 * tok + 1; }
    }
}
__device__ __forceinline__ void phase_final(Frame& F, const Args& A) {
    const bf16* h = (const bf16*)(F.ws + WS_XN); const bf16* y2 = (const bf16*)(F.ws + WS_X1); const int lane = F.lane;
    f32x4 gv[4];
#pragma unroll
    for (int j = 0; j < 4; ++j) gv[j] = ((const f32x4*)(A.in[17] + lane * 16))[j];
    for (int tok = GW_ID(F); tok < NTOK; tok += N_GW(F)) {
        const v4u* ph = (const v4u*)(h + (size_t)tok * D) + lane * 2; const v4u* p0 = (const v4u*)(y2 + (size_t)(2 * tok) * D) + lane * 2; const v4u* p1 = (const v4u*)(y2 + (size_t)(2 * tok + 1) * D) + lane * 2;
        f32x4 v[4]; float s = 0.f;
#pragma unroll
        for (int hh = 0; hh < 2; ++hh) { const v4u a = ph[hh], b = p0[hh], c = p1[hh];
            v[2 * hh] = (f32x4){bflo(a.x) + bflo(b.x) + bflo(c.x), bfhi(a.x) + bfhi(b.x) + bfhi(c.x), bflo(a.y) + bflo(b.y) + bflo(c.y), bfhi(a.y) + bfhi(b.y) + bfhi(c.y)};
            v[2 * hh + 1] = (f32x4){bflo(a.z) + bflo(b.z) + bflo(c.z), bfhi(a.z) + bfhi(b.z) + bfhi(c.z), bflo(a.w) + bflo(b.w) + bflo(c.w), bfhi(a.w) + bfhi(b.w) + bfhi(c.w)}; }
#pragma unroll
        for (int j = 0; j < 4; ++j) s += (v[j].x * v[j].x + v[j].y * v[j].y) + (v[j].z * v[j].z + v[j].w * v[j].w);
        const float rstd = 1.0f / sqrtf(wave_sum(s) * (1.f / D) + EPS);
        f32x4* dst = (f32x4*)(F.out + (size_t)tok * D + lane * 16);
#pragma unroll
        for (int j = 0; j < 4; ++j) dst[j] = v[j] * rstd * gv[j];
    }
}
__global__ void __launch_bounds__(NWAVES * 64, 2) mega_fwd(Args args) {
    extern __shared__ __attribute__((aligned(16))) unsigned char lds[];
    Frame F;
    F.lds = (LAS unsigned char*)lds;
    F.tid = threadIdx.x; F.lane = F.tid & 63; F.wave = __builtin_amdgcn_readfirstlane(F.tid >> 6);
    F.G = gridDim.x; { const int bx = blockIdx.x; F.vcu = (F.G % 8 == 0) ? (bx % 8) * (F.G / 8) + bx / 8 : bx; }
    F.ws = args.ws; F.ctl = (unsigned*)(args.ws + WS_CTL); F.out = args.out;
    for (int u = F.tid; u < (LDS_BYTES - LDSCTL_OFF) / 4; u += NWAVES * 64) ((LAS unsigned*)(F.lds + LDSCTL_OFF))[u] = 0u;
    __syncthreads();
    XcdBarrier bar = xcd_barrier_post(F.ctl + CW_BAR, (volatile LAS unsigned*)(F.lds + L_MISC) + 8);
#define GRID_BAR() xcd_barrier(bar)
    PG8_LAS unsigned char* ring = (PG8_LAS unsigned char*)lds;
    const pg8::bf16_t* XN = (const pg8::bf16_t*)(F.ws + WS_XN);

    phase_prep(F, args);
    GRID_BAR();
    {
        pg8::Gemm g{XN, (const pg8::bf16_t*)(F.ws + WS_WIN), NTOK, 1024, D}; pg8::StaticOrder S; S.init(NTOK, 1024, F.G, (int)blockIdx.x);
        pg8::EpiBf16 E{(pg8::bf16_t*)(F.ws + WS_QKVU), 512, 512, (size_t)NTOK * 512, QSCALE};
        pg8::gemm_phase<pg8::EpiBf16, pg8::StaticOrder, true, true>(ring, g, S, E);
    }
    {
        pg8::Gemm g{(const pg8::bf16_t*)(F.ws + WS_WIN) + (size_t)1536 * D, XN, 512, NTOK, D}; pg8::StaticOrder S; S.init(512, NTOK, F.G, (int)blockIdx.x);
        pg8::EpiBf16 E{(pg8::bf16_t*)(F.ws + WS_QKVU) + (size_t)3 * NTOK * 512, NTOK, NTOK, 0, 1.0f};
        pg8::gemm_phase<pg8::EpiBf16, pg8::StaticOrder, true, true>(ring, g, S, E);
    }
    {
        pg8::Gemm g{(const pg8::bf16_t*)(F.ws + WS_WIN) + (size_t)1024 * D, XN, 512, NTOK, D}; pg8::StaticOrder S; S.init(512, NTOK, F.G, (int)blockIdx.x);
        pg8::EpiBf16 E{(pg8::bf16_t*)(F.ws + WS_QKVU) + (size_t)2 * NTOK * 512, NTOK, NTOK, 0, 1.0f};
        pg8::gemm_phase<pg8::EpiBf16, pg8::StaticOrder, true, true, pg8::BGridT>(ring, g, S, E);
    }
    GRID_BAR();
    phase_attn(F, args);
    phase_fft1(F, args);
    GRID_BAR();
    phase_fft2(F, args);
    phase_attn_norm(F, args);
    GRID_BAR();
    {
        pg8::Gemm g{(const pg8::bf16_t*)(F.ws + WS_X1), (const pg8::bf16_t*)(F.ws + WS_WOUT), NTOK, D, D}; pg8::StaticOrder S; S.init(NTOK, D, F.G, (int)blockIdx.x);
        pg8::EpiResH E{args.in[0], (pg8::bf16_t*)(F.ws + WS_XN)};
        pg8::gemm_phase<pg8::EpiResH, pg8::StaticOrder, true, true>(ring, g, S, E);
    }
    GRID_BAR();
    phase_router(F, args);
    GRID_BAR();
    phase_scatter(F, args);
    GRID_BAR();
    {
        pg8::Gemm g{(const pg8::bf16_t*)(F.ws + WS_QKVU), (const pg8::bf16_t*)(F.ws + WS_WGU), MAXROWS, NE * 512, D};
        pg8::MoeOrder S{(const PG8_LAS int*)(ring + L_PBASE), 2, F.G, (int)blockIdx.x};
        const float* rstd_s = (const float*)(F.ws + WS_META);
        pg8::EpiMoe1 E{rstd_s, rstd_s + MAXROWS, (pg8::bf16_t*)(F.ws + WS_HD)};
        pg8::gemm_phase<pg8::EpiMoe1, pg8::MoeOrder, true, true>(ring, g, S, E);
    }
    GRID_BAR();
    {
        pg8::Gemm g{(const pg8::bf16_t*)(F.ws + WS_HD), (const pg8::bf16_t*)(F.ws + WS_WD), MAXROWS, NE * 1024, DE};
        pg8::MoeOrder S{(const PG8_LAS int*)(ring + L_PBASE), 4, F.G, (int)blockIdx.x};
        const int* slotrow_s = (const int*)(F.ws + WS_META) + 2 * MAXROWS;
        pg8::EpiMoe2 E{slotrow_s, (pg8::bf16_t*)(F.ws + WS_X1)};
        pg8::gemm_phase<pg8::EpiMoe2, pg8::MoeOrder, true, true>(ring, g, S, E);
    }
    GRID_BAR();
    phase_final(F, args);
}

extern "C" void kernel_launch(void* const* d_in, const int* in_sizes, int n_in, void* d_out, int out_size, void* d_ws, size_t ws_size, hipStream_t stream) {
    static int grid = 0;
    if (grid == 0) {
        if (n_in != 18 || out_size != NTOK * D || ws_size < WS_END) { fprintf(stderr, "kernel_launch: unexpected problem shape (n_in %d, out %d, ws %zu)\n", n_in, out_size, ws_size); grid = -1; return; }
        int dev = 0, cus = 0;
        if (hipGetDevice(&dev) != hipSuccess || hipDeviceGetAttribute(&cus, hipDeviceAttributeMultiprocessorCount, dev) != hipSuccess) { grid = -1; return; }
        if (hipFuncSetAttribute((const void*)mega_fwd, hipFuncAttributeMaxDynamicSharedMemorySize, LDS_BYTES) != hipSuccess) { fprintf(stderr, "kernel_launch: hipFuncSetAttribute failed\n"); grid = -1; return; }
        int per_cu = 0;
        if (hipOccupancyMaxActiveBlocksPerMultiprocessor(&per_cu, (const void*)mega_fwd, NWAVES * 64, LDS_BYTES) != hipSuccess || per_cu < 1) { fprintf(stderr, "kernel_launch: occupancy query says %d blocks per CU\n", per_cu); }
        (void)hipGetLastError();
        grid = cus;
    }
    if (grid < 0) return;
    (void)hipMemsetAsync((char*)d_ws + WS_CTL, 0, CTL_ZERO_BYTES, stream);
    Args a{};
    for (int i = 0; i < 18; ++i) a.in[i] = (const float*)d_in[i];
    a.out = (float*)d_out; a.ws = (unsigned char*)d_ws;
    hipLaunchKernelGGL(mega_fwd, dim3(grid), dim3(NWAVES * 64), LDS_BYTES, stream, a);
}
```

```cpp
#include <hip/hip_runtime.h>
#include <cstdint>
#include <cstdio>
namespace pg8 {
#define PG8_LAS __attribute__((address_space(3)))
typedef unsigned short bf16_t;
typedef short bf16x8 __attribute__((ext_vector_type(8)));
typedef float f32x4 __attribute__((ext_vector_type(4)));
typedef unsigned u32x4 __attribute__((ext_vector_type(4)));
constexpr int BM = 256, BK = 64, HALF = 128, HTB = HALF * BK * 2  , STAGE_BYTES = 8 * HTB, NXCD = 8, WGM = 8;

__host__ __device__ __forceinline__ int lds_byte(int r, int c) { const int st = (r >> 4) * 2 + (c >> 5), rr = r & 15, cc = c & 31, ob = rr * 64 + cc * 2; return st * 1024 + (ob ^ (((ob >> 9) & 1) << 5)); }
__host__ __device__ __forceinline__ void stage_rc(int b, int& R, int& C) { const int st = b / 1024, sb = b % 1024, swz = sb ^ (((sb >> 9) & 1) << 5); R = (st >> 1) * 16 + swz / 64; C = (st & 1) * 32 + (swz % 64) / 2; }
__host__ __device__ __forceinline__ int perm32(int rho) { const int n = rho >> 4, i = rho & 15; return 8 * (i >> 2) + 4 * n + (i & 3); }

struct Unit { int pm, pn; };
struct Gemm { const bf16_t* A; const bf16_t* Bt; int M, N, K; };

struct StaticOrder {
    int nM, nN, nwg, G, c;
    __host__ __device__ void init(int M, int N, int G_, int c_) { nM = M / BM; nN = N / BM; nwg = nM * nN; G = G_; c = c_; }
    __host__ __device__ bool next(int i, Unit& u) const {
        const long L = (long)i * G + c; if (L >= nwg) return false;
        int wgid = (int)L; { const int q = nwg / NXCD, r = nwg % NXCD, xcd = wgid % NXCD, off = wgid / NXCD; wgid = (xcd < r ? xcd * (q + 1) : r * (q + 1) + (xcd - r) * q) + off; }
        const int nig = WGM * nN, gid = wgid / nig, fm = gid * WGM, gsz = (nM - fm) < WGM ? (nM - fm) : WGM;
        u.pm = fm + ((wgid % nig) % gsz); u.pn = (wgid % nig) / gsz; return true;
    }
    __device__ __forceinline__ void a_ready(const Unit&) const {}
    __device__ __forceinline__ void done(const Unit&) const {}
};

typedef float f32x2c __attribute__((ext_vector_type(2))); typedef __bf16 bf16x2c __attribute__((ext_vector_type(2)));
__device__ __forceinline__ unsigned cvt_pk_bf16(float lo, float hi) { f32x2c v = {lo, hi}; bf16x2c b = __builtin_convertvector(v, bf16x2c); return __builtin_bit_cast(unsigned, b); }
typedef float f32x2 __attribute__((ext_vector_type(2)));
struct EpiBf16 {
    static constexpr bool PERM = true, AFTER_DRAIN = false;
    bf16_t* O; int ldc; int split_cols; size_t split_stride; float scale0;
    __device__ __forceinline__ void operator()(const f32x4 (&acc)[2][2][4][2], const Unit& u, int wr, int wc, int fr, int fq) const {
        const int row0 = u.pm * BM + wr * 64 + fr; int colt = u.pn * BM; bf16_t* base = O;
        float sc = 1.f; { const int t = colt / split_cols; base += (size_t)t * split_stride; colt -= t * split_cols; if (t == 0) sc = scale0; }
        const int col0 = colt + wc * 32 + 8 * fq;
#pragma unroll
        for (int ai = 0; ai < 2; ++ai)
#pragma unroll
            for (int m = 0; m < 4; ++m) { bf16_t* rowp = base + (size_t)(row0 + ai * HALF + m * 16) * ldc + col0;
#pragma unroll
                for (int bj = 0; bj < 2; ++bj) { f32x4 v0 = acc[ai][bj][m][0] * sc, v1 = acc[ai][bj][m][1] * sc;
                    u32x4 w; w.x = cvt_pk_bf16(v0[0], v0[1]); w.y = cvt_pk_bf16(v0[2], v0[3]); w.z = cvt_pk_bf16(v1[0], v1[1]); w.w = cvt_pk_bf16(v1[2], v1[3]);
                    *(u32x4*)(rowp + bj * HALF) = w; } }
    }
};
struct EpiResH {
    static constexpr bool PERM = true, AFTER_DRAIN = false;
    const float* x; bf16_t* h;
    __device__ __forceinline__ void operator()(const f32x4 (&acc)[2][2][4][2], const Unit& u, int wr, int wc, int fr, int fq) const {
        const int row0 = u.pm * BM + wr * 64 + fr, col0 = u.pn * BM + wc * 32 + 8 * fq;
#pragma unroll
        for (int ai = 0; ai < 2; ++ai)
#pragma unroll
            for (int m = 0; m < 4; ++m) { const size_t off = (size_t)(row0 + ai * HALF + m * 16) * 1024 + col0;
#pragma unroll
                for (int bj = 0; bj < 2; ++bj) { const f32x4 xa = *(const f32x4*)(x + off + bj * HALF), xb = *(const f32x4*)(x + off + bj * HALF + 4);
                    const f32x4 v0 = acc[ai][bj][m][0] + xa, v1 = acc[ai][bj][m][1] + xb;
                    u32x4 w; w.x = cvt_pk_bf16(v0[0], v0[1]); w.y = cvt_pk_bf16(v0[2], v0[3]); w.z = cvt_pk_bf16(v1[0], v1[1]); w.w = cvt_pk_bf16(v1[2], v1[3]);
                    *(u32x4*)(h + off + bj * HALF) = w; } }
    }
};
struct EpiMoe1 {
    static constexpr bool PERM = true, AFTER_DRAIN = false;
    const float* rstd_s; const float* w_s; bf16_t* hd;
    __device__ __forceinline__ void operator()(const f32x4 (&acc)[2][2][4][2], const Unit& u, int wr, int wc, int fr, int fq) const {
        const int row0 = u.pm * BM + wr * 64 + fr, col0 = (u.pn & 1) * HALF + wc * 32 + 8 * fq;
#pragma unroll
        for (int ai = 0; ai < 2; ++ai)
#pragma unroll
            for (int m = 0; m < 4; ++m) { const int row = row0 + ai * HALF + m * 16; const float rs = rstd_s[row], wv = w_s[row];
                float o[8];
#pragma unroll
                for (int n = 0; n < 2; ++n)
#pragma unroll
                    for (int j = 0; j < 4; ++j) { const float g = acc[ai][0][m][n][j] * rs, uu = acc[ai][1][m][n][j] * rs;
                        o[n * 4 + j] = g * __builtin_amdgcn_rcpf(1.0f + __builtin_amdgcn_exp2f(-1.4426950408889634f * g)) * uu * wv; }
                u32x4 w; w.x = cvt_pk_bf16(o[0], o[1]); w.y = cvt_pk_bf16(o[2], o[3]); w.z = cvt_pk_bf16(o[4], o[5]); w.w = cvt_pk_bf16(o[6], o[7]);
                *(u32x4*)(hd + (size_t)row * 256 + col0) = w; }
    }
};
struct EpiMoe2 {
    static constexpr bool PERM = true, AFTER_DRAIN = false;
    const int* slotrow_s; bf16_t* y2;
    __device__ __forceinline__ void operator()(const f32x4 (&acc)[2][2][4][2], const Unit& u, int wr, int wc, int fr, int fq) const {
        const int row0 = u.pm * BM + wr * 64 + fr, col0 = (u.pn & 3) * BM + wc * 32 + 8 * fq;
#pragma unroll
        for (int ai = 0; ai < 2; ++ai)
#pragma unroll
            for (int m = 0; m < 4; ++m) { const int sr = slotrow_s[row0 + ai * HALF + m * 16];
                bf16_t* rowp = y2 + (size_t)sr * 1024 + col0;
#pragma unroll
                for (int bj = 0; bj < 2; ++bj) { const f32x4 v0 = acc[ai][bj][m][0], v1 = acc[ai][bj][m][1];
                    u32x4 w; w.x = cvt_pk_bf16(v0[0], v0[1]); w.y = cvt_pk_bf16(v0[2], v0[3]); w.z = cvt_pk_bf16(v1[0], v1[1]); w.w = cvt_pk_bf16(v1[2], v1[3]);
                    *(u32x4*)(rowp + bj * HALF) = w; }
                asm volatile("" ::: "memory"); }
    }
};
struct MoeOrder {
    const PG8_LAS int* pbase; int ntn, G, c;
    __device__ __forceinline__ bool next(int i, Unit& u) const {
        const int L = i * G + c; const int total = pbase[32] * ntn; if (L >= total) return false;
        const int pm = L / ntn, pl = L - pm * ntn; int e = 0;
#pragma unroll 1
        for (int j = 1; j < 32; ++j) e += (pbase[j] <= pm) ? 1 : 0;
        u.pm = pm; u.pn = e * ntn + pl; return true;
    }
    __device__ __forceinline__ void a_ready(const Unit&) const {}
    __device__ __forceinline__ void done(const Unit&) const {}
};
struct BNat { static __device__ __forceinline__ int row(int v) { return v; } static __device__ __forceinline__ size_t hstep(int K) { return (size_t)HALF * K * 2; } static __device__ __forceinline__ size_t tile(int pn, int K) { return (size_t)pn * BM * K * 2; } };
struct BGridT { static __device__ __forceinline__ int row(int v) { return (v & 63) * 64 + (v >> 6); } static __device__ __forceinline__ size_t hstep(int K) { return (size_t)2 * K * 2; }
    static __device__ __forceinline__ size_t tile(int pn, int K) { return (size_t)((pn >> 4) * 4096 + (pn & 15) * 4) * K * 2; } };
template <class Epi, class Sched, bool ALIGN_EPI = false, bool SP2 = false, class BMap = BNat>
__device__ __forceinline__ void gemm_phase(PG8_LAS unsigned char* lds, const Gemm g, const Sched& S, const Epi& E) {
    int tid_ = threadIdx.x; asm volatile("" : "+v"(tid_));
    const int tid = tid_, wid = __builtin_amdgcn_readfirstlane(tid >> 6), lane = tid & 63, wr = wid >> 2, wc = wid & 3, fr = lane & 15, fq = lane >> 4;
    const int K = g.K; int nt_ = K / BK; asm volatile("" : "+s"(nt_)); const int nt = nt_;
    unsigned voffA[2], voffB[2];
#pragma unroll
    for (int i = 0; i < 2; ++i) { int R, C; stage_rc(tid * 16 + i * 8192, R, C); const int Rb = Epi::PERM ? ((R & ~31) + perm32(R & 31)) : R;
        voffA[i] = (unsigned)(R * K + C) * 2u; voffB[i] = (unsigned)(BMap::row(Rb) * K + C) * 2u; }
    const size_t kstep = (size_t)(BK * 2);
    const size_t hstep = (size_t)HALF * K * 2;
    const size_t tstep = 2 * hstep; const size_t hstepB = BMap::hstep(K);
    const unsigned ldsw = (unsigned)wid * 1024u;
    const int aoff = lds_byte(wr * 64 + fr, fq * 8), boff = lds_byte(wc * 32 + fr, fq * 8);
#define PG8_SA(b, h) (((b) * 2 + (h)) * HTB)
#define PG8_SB(b, h) ((4 + (b) * 2 + (h)) * HTB)
#define PG8_STAGE(bufoff, gbase, voff) do { _Pragma("unroll") for (int _i = 0; _i < 2; ++_i) \
        __builtin_amdgcn_global_load_lds((const unsigned*)((const char*)(gbase) + (voff)[_i]), (PG8_LAS unsigned*)(lds + (bufoff) + ldsw + _i * 8192), 16, 0, 0); } while (0)
#define PG8_LDA(dst, b, h) do { _Pragma("unroll") for (int m = 0; m < 4; ++m) _Pragma("unroll") for (int k = 0; k < 2; ++k) dst[m][k] = *(const PG8_LAS bf16x8*)(lds + PG8_SA(b, h) + aoff + m * 2048 + k * 1024); } while (0)
#define PG8_LDB(dst, b, h) do { _Pragma("unroll") for (int n = 0; n < 2; ++n) _Pragma("unroll") for (int k = 0; k < 2; ++k) dst[n][k] = *(const PG8_LAS bf16x8*)(lds + PG8_SB(b, h) + boff + n * 2048 + k * 1024); } while (0)
#define PG8_MMA(ai, bj, At, Bt) do { __builtin_amdgcn_s_setprio(1); _Pragma("unroll") for (int m = 0; m < 4; ++m) _Pragma("unroll") for (int n = 0; n < 2; ++n) _Pragma("unroll") for (int k = 0; k < 2; ++k) \
        acc[ai][bj][m][n] = __builtin_amdgcn_mfma_f32_16x16x32_bf16(Bt[n][k], At[m][k], acc[ai][bj][m][n], 0, 0, 0); __builtin_amdgcn_s_setprio(0); } while (0)
#define PG8_WAIT_V(n) asm volatile("s_waitcnt vmcnt(" #n ")" ::: "memory")
#define PG8_WAIT_L(n) asm volatile("s_waitcnt lgkmcnt(" #n ")" ::: "memory")
#define PG8_BAR __builtin_amdgcn_s_barrier()
#define PG8_SCHED __builtin_amdgcn_sched_barrier(0)
    Unit cur, nxt; int ui = 0;
    if (!S.next(0, cur)) return;
    f32x4 acc[2][2][4][2];
#pragma unroll
    for (int a = 0; a < 2; ++a)
#pragma unroll
        for (int b = 0; b < 2; ++b)
#pragma unroll
            for (int m = 0; m < 4; ++m)
#pragma unroll
                for (int n = 0; n < 2; ++n) acc[a][b][m][n] = (f32x4){0.f, 0.f, 0.f, 0.f};
    bf16x8 At[4][2], B0[2][2], B1[2][2];
    const char* cA = (const char*)g.A + (size_t)cur.pm * tstep; const char* cB = (const char*)g.Bt + BMap::tile(cur.pn, K);
    S.a_ready(cur);
    if constexpr (SP2) {
        PG8_STAGE(PG8_SB(0, 0), cB, voffB); PG8_STAGE(PG8_SB(0, 1), cB + hstepB, voffB); PG8_STAGE(PG8_SA(0, 0), cA, voffA); PG8_STAGE(PG8_SA(0, 1), cA + hstep, voffA);
        if (wr == 1) PG8_BAR;
        PG8_WAIT_V(2); PG8_BAR;
        PG8_STAGE(PG8_SB(1, 0), cB + kstep, voffB); PG8_STAGE(PG8_SA(1, 0), cA + kstep, voffA); PG8_STAGE(PG8_SB(1, 1), cB + hstepB + kstep, voffB);
        PG8_WAIT_V(6); PG8_BAR;
    } else {
        PG8_STAGE(PG8_SB(0, 0), cB, voffB); PG8_STAGE(PG8_SA(0, 0), cA, voffA); PG8_STAGE(PG8_SB(0, 1), cB + hstepB, voffB); PG8_STAGE(PG8_SA(0, 1), cA + hstep, voffA);
        if (wr == 1) PG8_BAR;
        PG8_WAIT_V(4); PG8_BAR;
        PG8_STAGE(PG8_SB(1, 0), cB + kstep, voffB); PG8_STAGE(PG8_SA(1, 0), cA + kstep, voffA); PG8_STAGE(PG8_SB(1, 1), cB + hstepB + kstep, voffB);
        PG8_WAIT_V(6); PG8_BAR;
    }
    for (;;) {
        const bool has_next = S.next(ui + 1, nxt);
        const char* nA = has_next ? (const char*)g.A + (size_t)nxt.pm * tstep : cA; const char* nB = has_next ? (const char*)g.Bt + BMap::tile(nxt.pn, K) : cB;
        for (int t = 0; t < nt; t += 2) {
            const bool last = (t == nt - 2);
            const char* a1 = cA + (size_t)(t + 1) * kstep;
            const char* a2 = last ? nA : cA + (size_t)(t + 2) * kstep; const char* b2 = last ? nB : cB + (size_t)(t + 2) * kstep;
            const char* a3 = a2 + kstep; const char* b3 = b2 + kstep;
            if (last && has_next) S.a_ready(nxt);
            if constexpr (SP2) {
            PG8_LDB(B0, 0, 0); PG8_LDB(B1, 0, 1); PG8_SCHED; PG8_LDA(At, 0, 0); PG8_STAGE(PG8_SA(1, 1), a1 + hstep, voffA);
            PG8_WAIT_V(8); PG8_WAIT_L(0); PG8_BAR; PG8_MMA(0, 0, At, B0); PG8_MMA(0, 1, At, B1); PG8_BAR; PG8_SCHED;
            PG8_LDA(At, 0, 1); PG8_STAGE(PG8_SB(0, 0), b2, voffB); PG8_STAGE(PG8_SB(0, 1), b2 + hstepB, voffB); PG8_STAGE(PG8_SA(0, 0), a2, voffA);
            PG8_WAIT_V(8); PG8_WAIT_L(0); PG8_BAR; PG8_MMA(1, 0, At, B0); PG8_MMA(1, 1, At, B1); PG8_BAR; PG8_SCHED;
            PG8_LDB(B0, 1, 0); PG8_LDB(B1, 1, 1); PG8_SCHED; PG8_LDA(At, 1, 0); PG8_STAGE(PG8_SA(0, 1), a2 + hstep, voffA);
            PG8_WAIT_V(8); PG8_WAIT_L(0); PG8_BAR; PG8_MMA(0, 0, At, B0); PG8_MMA(0, 1, At, B1); PG8_BAR; PG8_SCHED;
            PG8_LDA(At, 1, 1); PG8_STAGE(PG8_SB(1, 0), b3, voffB); PG8_STAGE(PG8_SB(1, 1), b3 + hstepB, voffB); PG8_STAGE(PG8_SA(1, 0), a3, voffA);
            PG8_WAIT_V(8); PG8_WAIT_L(0); PG8_BAR; PG8_MMA(1, 0, At, B0); PG8_MMA(1, 1, At, B1); PG8_BAR; PG8_SCHED;
            } else {
            PG8_LDB(B0, 0, 0); PG8_SCHED; PG8_LDA(At, 0, 0); PG8_STAGE(PG8_SA(1, 1), a1 + hstep, voffA);
            PG8_WAIT_L(8); PG8_BAR; PG8_WAIT_L(0); PG8_MMA(0, 0, At, B0); PG8_BAR; PG8_SCHED;
            PG8_LDB(B1, 0, 1); PG8_STAGE(PG8_SB(0, 0), b2, voffB);
            PG8_BAR; PG8_WAIT_L(0); PG8_MMA(0, 1, At, B1); PG8_BAR;
            PG8_LDA(At, 0, 1); PG8_STAGE(PG8_SA(0, 0), a2, voffA);
            PG8_BAR; PG8_WAIT_L(0); PG8_MMA(1, 0, At, B0); PG8_BAR; PG8_SCHED;
            PG8_STAGE(PG8_SB(0, 1), b2 + hstepB, voffB);
            PG8_WAIT_V(6); PG8_BAR; PG8_MMA(1, 1, At, B1); PG8_BAR;
            PG8_LDB(B0, 1, 0); PG8_SCHED; PG8_LDA(At, 1, 0); PG8_STAGE(PG8_SA(0, 1), a2 + hstep, voffA);
            PG8_WAIT_L(8); PG8_BAR; PG8_WAIT_L(0); PG8_MMA(0, 0, At, B0); PG8_BAR; PG8_SCHED;
            PG8_LDB(B1, 1, 1); PG8_STAGE(PG8_SB(1, 0), b3, voffB);
            PG8_BAR; PG8_WAIT_L(0); PG8_MMA(0, 1, At, B1); PG8_BAR;
            PG8_LDA(At, 1, 1); PG8_STAGE(PG8_SA(1, 0), a3, voffA);
            PG8_BAR; PG8_WAIT_L(0); PG8_MMA(1, 0, At, B0); PG8_BAR; PG8_SCHED;
            PG8_STAGE(PG8_SB(1, 1), b3 + hstepB, voffB);
            PG8_WAIT_V(6); PG8_BAR; PG8_MMA(1, 1, At, B1); PG8_BAR;
            }
        }
        if constexpr (ALIGN_EPI) { if (wr == 0) PG8_BAR; }
        if constexpr (!Epi::AFTER_DRAIN) { E(acc, cur, wr, wc, fr, fq); S.done(cur); }
        if (!has_next) break;
#pragma unroll
        for (int a = 0; a < 2; ++a)
#pragma unroll
            for (int b = 0; b < 2; ++b)
#pragma unroll
                for (int m = 0; m < 4; ++m)
#pragma unroll
                    for (int n = 0; n < 2; ++n) acc[a][b][m][n] = (f32x4){0.f, 0.f, 0.f, 0.f};
        cur = nxt; cA = nA; cB = nB; ++ui;
        if constexpr (ALIGN_EPI) { if (wr == 1) PG8_BAR; }
    }
    PG8_WAIT_V(0);
    if constexpr (!ALIGN_EPI) { if (wr == 0) PG8_BAR; }
    PG8_BAR;
    if constexpr (Epi::AFTER_DRAIN) { E.fused(acc, cur, wr, wc, fr, fq, lds, wid, lane); S.done(cur); }
#undef PG8_SA
#undef PG8_SB
#undef PG8_STAGE
#undef PG8_LDA
#undef PG8_LDB
#undef PG8_MMA
#undef PG8_WAIT_V
#undef PG8_WAIT_L
#undef PG8_BAR
#undef PG8_SCHED
}
}
constexpr int NWAVES = 8;
constexpr int NB = 8, T = 4096, D = 1024, NTOK = NB * T;
constexpr int DA = 512, DF = 512, NH = 8, HD = 64, GW = 64, ROWS = 64, WH = 8, WW = 16;
constexpr int NPROJ = 2048, NE = 32, DE = 256;
constexpr int MAXROWS = 73728;
constexpr float EPS = 1e-6f, LOG2E = 1.4426950408889634f, QSCALE = 0.125f * LOG2E;
constexpr size_t MiB = 1u << 20;
constexpr size_t WS_CTL = 0, CTL_ZERO_BYTES = 1 * MiB;
constexpr size_t WS_WIN = 2 * MiB, WS_WOUT = 6 * MiB, WS_WGU = 8 * MiB, WS_WD = 40 * MiB, WS_WR = 56 * MiB  , WS_MIXT = 57 * MiB  , WS_DFT1 = WS_MIXT + 256 * 1024  ,
                 WS_T2 = WS_MIXT + 320 * 1024  , WS_TW = WS_MIXT + 384 * 1024  ;
constexpr size_t WS_ROUTE = 58 * MiB;
constexpr size_t WS_META = 59 * MiB;
constexpr size_t WS_XN = 64 * MiB;
constexpr size_t WS_QKVU = 128 * MiB;
constexpr size_t WS_X1 = 256 * MiB;
constexpr size_t WS_MF = 384 * MiB;
constexpr size_t WS_HD = 388 * MiB;
constexpr size_t WS_END = 512 * MiB;
constexpr int CW_BAR = 4096, CW_CNT = 16384;
constexpr int RING_BYTES = 131072, RT_STRIDE = 2064  , RT_BYTES = 72 * RT_STRIDE, LDSCTL_OFF = 149504, LDS_BYTES = 153600;
constexpr int L_MISC = LDSCTL_OFF;
constexpr int L_PBASE = LDSCTL_OFF + 256;
constexpr int L_LCNT = LDSCTL_OFF + 512;
constexpr int L_GBASE = LDSCTL_OFF + 768;
constexpr int L_RT = LDSCTL_OFF + 1024;
static_assert(RT_BYTES <= LDSCTL_OFF && 8 * 16512 <= LDSCTL_OFF && RING_BYTES <= LDSCTL_OFF && L_RT + 4 * 128 * 4 <= LDS_BYTES, "LDS map");

#define LAS __attribute__((address_space(3)))
typedef unsigned short bf16;
typedef unsigned v4u __attribute__((ext_vector_type(4)));
typedef unsigned v2u __attribute__((ext_vector_type(2)));
typedef float f32x4 __attribute__((ext_vector_type(4)));
#define LDS_WAIT() asm volatile("s_waitcnt lgkmcnt(0)" ::: "memory")
#define VM_WAIT() asm volatile("s_waitcnt vmcnt(0)" ::: "memory")
__device__ __forceinline__ unsigned f2bf(float f) { unsigned u = __builtin_bit_cast(unsigned, f); return (u + 0x7fffu + ((u >> 16) & 1u)) >> 16; }
__device__ __forceinline__ unsigned pk2(float lo, float hi) { return f2bf(lo) | (f2bf(hi) << 16); }
typedef float f32x2_t __attribute__((ext_vector_type(2))); typedef __bf16 bf16x2_t __attribute__((ext_vector_type(2)));
__device__ __forceinline__ unsigned cvtpk(float lo, float hi) { f32x2_t v = {lo, hi}; bf16x2_t b = __builtin_convertvector(v, bf16x2_t); return __builtin_bit_cast(unsigned, b); }
__device__ __forceinline__ float bf2f(unsigned short b) { return __builtin_bit_cast(float, (unsigned)b << 16); }
__device__ __forceinline__ float bflo(unsigned w) { return __builtin_bit_cast(float, w << 16); }
__device__ __forceinline__ float bfhi(unsigned w) { return __builtin_bit_cast(float, w & 0xffff0000u); }
__device__ __forceinline__ float wave_sum(float v) {
#pragma unroll
    for (int o = 1; o < 64; o <<= 1) v += __shfl_xor(v, o);
    return v;
}
#define XB_TMO      128
#define XB_XCNT(j)  (256  + 64 * (j))
#define XB_XSUB(j)  (1280 + 64 * (j))
#define XB_XGEN(j)  (2304 + 64 * (j))
#define XB_TOP      3328
#define XB_TOPGEN   3392
#define XCD_BAR_WORDS 3456
#define XB_SPIN_CAP (1u << 18)

__device__ __forceinline__ unsigned xb_ld(unsigned* p)              { return __hip_atomic_load(p, __ATOMIC_RELAXED, __HIP_MEMORY_SCOPE_AGENT); }
__device__ __forceinline__ unsigned xb_add(unsigned* p, unsigned v) { return __hip_atomic_fetch_add(p, v, __ATOMIC_RELAXED, __HIP_MEMORY_SCOPE_AGENT); }
__device__ __forceinline__ unsigned xb_xcc_id() { return (unsigned)__builtin_amdgcn_s_getreg((3 << 11) | 20) & 0xFu; }
#define XB_SPIN(cond, bar) do { unsigned _sp = 0; while (cond) { __builtin_amdgcn_s_sleep(1); \
    if ((++_sp & 255u) == 0u) { if (xb_ld(&(bar)[XB_TMO])) break; if (_sp > XB_SPIN_CAP) { atomicAdd(&(bar)[XB_TMO], 1u); break; } } } } while (0)

struct XcdBarrier {
    unsigned* bar; unsigned x;
    volatile LAS unsigned* st;
};

__device__ __forceinline__ XcdBarrier xcd_barrier_post(unsigned* bar, volatile LAS unsigned* st) {
    XcdBarrier b; b.bar = bar; b.x = xb_xcc_id(); b.st = st;
    if (threadIdx.x == 0) (void)xb_add(&bar[XB_XCNT(b.x)], 1u);
    return b;
}
__device__ __forceinline__ void xcd_barrier_complete(unsigned* bar, unsigned x, unsigned& nloc, unsigned& nx) {
    const unsigned G = gridDim.x * gridDim.y * gridDim.z;
    unsigned sum, cnt, mine, sp = 0u;
    for (;;) {
        sum = 0u; cnt = 0u; mine = 0u;
#pragma unroll
        for (unsigned j = 0; j < 16; ++j) { const unsigned c = xb_ld(&bar[XB_XCNT(j)]); sum += c; cnt += (c > 0u) ? 1u : 0u; mine = (j == x) ? c : mine; }
        if (sum == G) break;
        __builtin_amdgcn_s_sleep(1);
        if ((++sp & 255u) == 0u) { if (xb_ld(&bar[XB_TMO])) break; if (sp > XB_SPIN_CAP) { atomicAdd(&bar[XB_TMO], 1u); break; } }
    }
    nloc = mine > 0u ? mine : 1u; nx = cnt > 0u ? cnt : 1u;
}

__device__ __forceinline__ void xcd_barrier(const XcdBarrier& b) {
    asm volatile("s_waitcnt vmcnt(0)" ::: "memory");
    __syncthreads();
    if (threadIdx.x == 0) {
        unsigned* bar = b.bar;
        __builtin_amdgcn_s_waitcnt(0);
        unsigned nloc = b.st[0], nx = b.st[1];
        if (nloc == 0u) { xcd_barrier_complete(bar, b.x, nloc, nx); b.st[0] = nloc; b.st[1] = nx; }
        const unsigned old = xb_add(&bar[XB_XSUB(b.x)], 1u);
        const unsigned gen = old / nloc;
        if (old + 1u == (gen + 1u) * nloc) {
            __builtin_amdgcn_fence(__ATOMIC_RELEASE, "agent");
            asm volatile("s_waitcnt vmcnt(0)" ::: "memory");
            const unsigned og = xb_add(&bar[XB_TOP], 1u);
            const unsigned tg = og / nx;
            if (og + 1u == (tg + 1u) * nx) xb_add(&bar[XB_TOPGEN], 1u);
            else XB_SPIN(xb_ld(&bar[XB_TOPGEN]) == tg, bar);
            __builtin_amdgcn_fence(__ATOMIC_ACQUIRE, "agent");
            xb_add(&bar[XB_XGEN(b.x)], 1u);
            asm volatile("s_waitcnt vmcnt(0)" ::: "memory");
        } else {
            XB_SPIN(xb_ld(&bar[XB_XGEN(b.x)]) == gen, bar);
            __builtin_amdgcn_fence(__ATOMIC_ACQUIRE, "agent");
            asm volatile("s_waitcnt vmcnt(0)" ::: "memory");
        }
    }
    __syncthreads();
}
struct Args { const float* in[18]; float* out; unsigned char* ws; };
struct Frame {
    LAS unsigned char* lds; unsigned* ctl; unsigned char* ws; float* out;
    int tid, lane, wave, vcu, G;
};
#define GW_ID(F) ((F).vcu * NWAVES + (F).wave)
#define N_GW(F) ((F).G * NWAVES)

__device__ __forceinline__ void tr_item(const float* W, int K, int N, bf16* WT, int drow, const float* kscale, LAS float* scr, int k0, int n0, int lane) {
#pragma unroll 8
    for (int i = 0; i < 32; ++i) { const int kk = 2 * i + (lane >> 5); float v = W[(size_t)(k0 + kk) * N + n0 + (lane & 31)]; if (kscale) v *= kscale[k0 + kk]; scr[kk * 33 + (lane & 31)] = v; }
    LDS_WAIT(); asm volatile("" ::: "memory");
    const int c = lane & 7;
#pragma unroll
    for (int j = 0; j < 4; ++j) { const int n = (lane >> 3) + 8 * j; const LAS float* s = scr + (8 * c) * 33 + n;
        v4u o; o.x = pk2(s[0 * 33], s[1 * 33]); o.y = pk2(s[2 * 33], s[3 * 33]); o.z = pk2(s[4 * 33], s[5 * 33]); o.w = pk2(s[6 * 33], s[7 * 33]);
        *(v4u*)(WT + (size_t)(drow + n) * K + k0 + 8 * c) = o; }
    LDS_WAIT(); asm volatile("" ::: "memory");
}
__device__ __forceinline__ void phase_prep(Frame& F, const Args& A) {
    LAS float* scr = (LAS float*)(F.lds + F.wave * 16384);
    const int gw = GW_ID(F), NGW = N_GW(F), lane = F.lane;
    bf16* WinT = (bf16*)(F.ws + WS_WIN); bf16* WoutT = (bf16*)(F.ws + WS_WOUT); bf16* Wgu = (bf16*)(F.ws + WS_WGU); bf16* Wd = (bf16*)(F.ws + WS_WD);
    constexpr int I_IN = 16 * 64, I_OUT = 16 * 32, I_G = 32 * 128, I_D = 32 * 128, NITEMS = I_IN + I_OUT + 2 * I_G + I_D;
    for (int it = gw; it < NITEMS; it += NGW) {
        int r = it;
        if (r < I_IN) { const int n0 = 32 * (r % 64), seg = n0 >> 9; const int drow = seg == 2 ? n0 + 512 : seg == 3 ? n0 - 512 : n0;
            tr_item(A.in[2], 1024, 2048, WinT, drow, nullptr, scr, 64 * (r / 64), n0, lane); continue; } r -= I_IN;
        if (r < I_OUT) { tr_item(A.in[8], 1024, 1024, WoutT, 32 * (r % 32), nullptr, scr, 64 * (r / 32), 32 * (r % 32), lane); continue; } r -= I_OUT;
        if (r < 2 * I_G) { const int up = r >= I_G ? 1 : 0; r -= up * I_G; const int e = r / 128, q = r % 128, kb = q / 8, n0 = 32 * (q % 8);
            tr_item(A.in[14 + up] + (size_t)e * 1024 * 256, 1024, 256, Wgu, e * 512 + (n0 / 128) * 256 + up * 128 + (n0 % 128), A.in[9], scr, 64 * kb, n0, lane); continue; } r -= 2 * I_G;
        { const int e = r / 128, q = r % 128, kb = q / 32, n0 = 32 * (q % 32);
            tr_item(A.in[16] + (size_t)e * 256 * 1024, 256, 1024, Wd + (size_t)e * 1024 * 256, n0, nullptr, scr, 64 * kb, n0, lane); }
    }
    { const float* g = A.in[1]; bf16* XN = (bf16*)(F.ws + WS_XN);
      f32x4 gv[4];
#pragma unroll
      for (int j = 0; j < 4; ++j) gv[j] = ((const f32x4*)g)[64 * j + lane];
      for (int m = gw; m < NTOK; m += NGW) {
        const f32x4* xr = (const f32x4*)(A.in[0] + (size_t)m * D) + lane; f32x4 v[4]; float s = 0.f;
#pragma unroll
        for (int j = 0; j < 4; ++j) { v[j] = xr[64 * j]; s += (v[j].x * v[j].x + v[j].y * v[j].y) + (v[j].z * v[j].z + v[j].w * v[j].w); }
        const float rstd = 1.0f / sqrtf(wave_sum(s) * (1.f / D) + EPS);
        unsigned long long* o8 = (unsigned long long*)(XN + (size_t)m * D) + lane;
#pragma unroll
        for (int j = 0; j < 4; ++j) { const f32x4 w = v[j] * rstd * gv[j]; o8[64 * j] = (unsigned long long)pk2(w.x, w.y) | ((unsigned long long)pk2(w.z, w.w) << 32); }
      } }
    { bf16* WRH = (bf16*)(F.ws + WS_WR); bf16* WRL = WRH + 36 * 1024; const float* nm = A.in[9];
      for (int i = gw * 64 + lane; i < 36 * 1024; i += NGW * 64) { const int j = i / 1024, k = i % 1024; const float w = nm[k] * (j < 4 ? A.in[10][k * 4 + j] : A.in[12][k * 32 + (j - 4)]);
          const unsigned hi = f2bf(w); WRH[i] = (bf16)hi; WRL[i] = (bf16)f2bf(w - __builtin_bit_cast(float, hi << 16)); } }
    { bf16* DFT1 = (bf16*)(F.ws + WS_DFT1); bf16* T2 = (bf16*)(F.ws + WS_T2); float* TW = (float*)(F.ws + WS_TW); bf16* MIXT = (bf16*)(F.ws + WS_MIXT); const float* wf = A.in[4];
      for (int i = gw * 64 + lane; i < 128 * 64; i += NGW * 64) { const int m = i >> 6, t1 = i & 63; const float ph = (float)(((m & 63) * t1) & 63) * (1.f / 64.f);
          DFT1[i] = (bf16)f2bf(m < 64 ? __builtin_amdgcn_cosf(ph) : -__builtin_amdgcn_sinf(ph)); }
      for (int i = gw * 64 + lane; i < 2 * 64 * 128; i += NGW * 64) { const int part = i >> 13, k2 = (i >> 7) & 63, k = i & 127, t2 = k & 63; const float ph = (float)((k2 * t2) & 63) * (1.f / 64.f);
          const float cs = __builtin_amdgcn_cosf(ph), sn = __builtin_amdgcn_sinf(ph); T2[i] = (bf16)f2bf(part == 0 ? (k < 64 ? cs : sn) : (k < 64 ? -sn : cs)); }
      for (int i = gw * 64 + lane; i < 64 * 64; i += NGW * 64) { const int t2 = i >> 6, k1 = i & 63; const float ph = (float)(t2 * k1) * (1.f / 4096.f); TW[2 * i] = __builtin_amdgcn_cosf(ph); TW[2 * i + 1] = -__builtin_amdgcn_sinf(ph); }
      for (int i = gw * 64 + lane; i < 8 * 64 * 128; i += NGW * 64) { const int grp = i >> 13, d = (i >> 7) & 63, k = i & 127, s = k >> 5, gg = (k >> 3) & 3, jj = k & 7;
          const int c = 32 * (s & 1) + (jj < 4 ? 4 * gg + jj : 16 + 4 * gg + jj - 4); float a = 0.f;
          for (int e = 0; e < 64; ++e) { const float ph = (float)((c * e) & 63) * (1.f / 64.f); a += ((s >> 1) ? __builtin_amdgcn_sinf(ph) : __builtin_amdgcn_cosf(ph)) * wf[(grp * 64 + e) * 64 + d]; }
          MIXT[i] = (bf16)f2bf(a * (1.f / 512.f)); } }
}

__device__ __forceinline__ void phase_attn(Frame& F, const Args& A) {
    typedef short bf16x8 __attribute__((ext_vector_type(8)));
    LAS float* bt = (LAS float*)F.lds;
    for (int i = F.tid; i < 8 * 15 * 32; i += NWAVES * 64) { const int dc = i & 31, hd = i >> 5; bt[i] = (dc < 31) ? LOG2E * A.in[3][hd * 31 + dc] : -1e30f; }
    __syncthreads();
    const bf16* Q = (const bf16*)(F.ws + WS_QKVU); const bf16* Kb = Q + (size_t)NTOK * 512; const bf16* VT = Q + (size_t)3 * NTOK * 512;
    float* mf = (float*)F.out;
    const int lane = F.lane, q16 = lane & 15, g = lane >> 4, h = F.wave;
    for (int unit = F.vcu; unit < NB * ROWS; unit += F.G) {
        const int b = unit / ROWS, r = unit % ROWS, rs = min(max(r - WH / 2, 0), ROWS - WH);
#pragma unroll 1
        for (int j = 0; j < 4; ++j) {
            const int cb = (j == 0) ? 0 : (j == 1) ? 8 : (j == 2) ? 24 : 32;
            const int c = 16 * j + q16, cs = min(max(c - WW / 2, 0), GW - WW);
            const size_t qtok = (size_t)b * T + r * GW + c;
            bf16x8 qf[2];
#pragma unroll
            for (int ks = 0; ks < 2; ++ks) qf[ks] = *(const bf16x8*)(Q + qtok * 512 + h * HD + 32 * ks + 8 * g);
            unsigned boff[2][4];
#pragma unroll
            for (int t = 0; t < 2; ++t)
#pragma unroll
                for (int e = 0; e < 4; ++e) { const int kc = cb + 8 * g + 4 * t + e; const bool ok = (kc >= cs) && (kc <= cs + WW - 1); const int dc = ok ? (kc - c + WW - 1) : 31;
                    boff[t][e] = (unsigned)(((h * 15 + (rs - r + WH - 1)) * 32 + dc) * 4); }
            float sc[8][2][4]; float mx = -1e30f;
            const int krow_l = 8 * (q16 >> 2) + (q16 & 3);
            const bf16* kbase = Kb + ((size_t)b * T + rs * GW + cb + krow_l) * 512 + h * HD + 8 * g;
            const bf16* vbase = VT + (size_t)(h * HD + q16) * NTOK + (size_t)b * T + rs * GW + cb + 8 * g;
#define ATT_LOADK(dst, i0) do { _Pragma("unroll") for (int ii = 0; ii < 4; ++ii) _Pragma("unroll") for (int t = 0; t < 2; ++t) { const bf16* kp = kbase + (size_t)(((i0) + ii) * GW + 4 * t) * 512; \
                dst[ii][t][0] = *(const bf16x8*)kp; dst[ii][t][1] = *(const bf16x8*)(kp + 32); } } while (0)
#define ATT_LOADV(dst, i0) do { _Pragma("unroll") for (int ii = 0; ii < 4; ++ii) _Pragma("unroll") for (int dt = 0; dt < 4; ++dt) dst[ii][dt] = *(const bf16x8*)(vbase + (size_t)dt * 16 * NTOK + ((i0) + ii) * GW); } while (0)
#define ATT_SCORE(src, i0) do { _Pragma("unroll") for (int ii = 0; ii < 4; ++ii) _Pragma("unroll") for (int t = 0; t < 2; ++t) { f32x4 a = {0.f, 0.f, 0.f, 0.f}; \
                a = __builtin_amdgcn_mfma_f32_16x16x32_bf16(src[ii][t][0], qf[0], a, 0, 0, 0); a = __builtin_amdgcn_mfma_f32_16x16x32_bf16(src[ii][t][1], qf[1], a, 0, 0, 0); \
                _Pragma("unroll") for (int e = 0; e < 4; ++e) { const float s = a[e] + *(const LAS float*)((const LAS char*)bt + boff[t][e] + ((i0) + ii) * 128); sc[(i0) + ii][t][e] = s; mx = fmaxf(mx, s); } } } while (0)
            bf16x8 kA[4][2][2], kB[4][2][2];
            ATT_LOADK(kA, 0); __builtin_amdgcn_sched_barrier(0);
            ATT_LOADK(kB, 4); __builtin_amdgcn_sched_barrier(0);
            ATT_SCORE(kA, 0); __builtin_amdgcn_sched_barrier(0);
            bf16x8 vA[4][4], vB[4][4];
            ATT_LOADV(vA, 0); __builtin_amdgcn_sched_barrier(0);
            ATT_SCORE(kB, 4); __builtin_amdgcn_sched_barrier(0);
            ATT_LOADV(vB, 4); __builtin_amdgcn_sched_barrier(0);
            mx = fmaxf(mx, __shfl_xor(mx, 16)); mx = fmaxf(mx, __shfl_xor(mx, 32));
            float lsum = 0.f; bf16x8 pf[8];
#pragma unroll
            for (int i = 0; i < 8; ++i) {
                float p[2][4];
#pragma unroll
                for (int t = 0; t < 2; ++t)
#pragma unroll
                    for (int e = 0; e < 4; ++e) { p[t][e] = __builtin_amdgcn_exp2f(sc[i][t][e] - mx); lsum += p[t][e]; }
                v4u w; w.x = cvtpk(p[0][0], p[0][1]); w.y = cvtpk(p[0][2], p[0][3]); w.z = cvtpk(p[1][0], p[1][1]); w.w = cvtpk(p[1][2], p[1][3]);
                pf[i] = __builtin_bit_cast(bf16x8, w);
            }
            lsum += __shfl_xor(lsum, 16); lsum += __shfl_xor(lsum, 32);
            f32x4 o[4];
#pragma unroll
            for (int dt = 0; dt < 4; ++dt) o[dt] = (f32x4){0.f, 0.f, 0.f, 0.f};
#pragma unroll
            for (int ii = 0; ii < 4; ++ii)
#pragma unroll
                for (int dt = 0; dt < 4; ++dt) o[dt] = __builtin_amdgcn_mfma_f32_16x16x32_bf16(vA[ii][dt], pf[ii], o[dt], 0, 0, 0);
#pragma unroll
            for (int ii = 0; ii < 4; ++ii)
#pragma unroll
                for (int dt = 0; dt < 4; ++dt) o[dt] = __builtin_amdgcn_mfma_f32_16x16x32_bf16(vB[ii][dt], pf[4 + ii], o[dt], 0, 0, 0);
#undef ATT_LOADK
#undef ATT_LOADV
#undef ATT_SCORE
            const float inv = 1.0f / lsum;
#pragma unroll
            for (int dt = 0; dt < 4; ++dt) *(f32x4*)(mf + qtok * D + h * HD + 16 * dt + 4 * g) = o[dt] * inv;
        }
    }
    __syncthreads();
}
__device__ __forceinline__ void phase_fft1(Frame& F, const Args& A) {
    typedef short bf16x8 __attribute__((ext_vector_type(8)));
    const bf16* UT = (const bf16*)(F.ws + WS_QKVU) + (size_t)2 * NTOK * 512; const bf16* DFT1 = (const bf16*)(F.ws + WS_DFT1); const float2* TW = (const float2*)(F.ws + WS_TW);
    bf16* X1T = (bf16*)(F.ws + WS_MF);
    const int lane = F.lane, q16 = lane & 15, g = lane >> 4;
    for (int u = GW_ID(F); u < NB * 8 * 32; u += N_GW(F)) {
        const int ct = u & 31, t2b = (u >> 5) & 7, b = u >> 8, ch = 16 * ct + q16;
        bf16x8 bfr[8][2];
#pragma unroll
        for (int t2 = 0; t2 < 8; ++t2)
#pragma unroll
            for (int ks = 0; ks < 2; ++ks) bfr[t2][ks] = *(const bf16x8*)(UT + (size_t)ch * NTOK + (size_t)b * T + (8 * t2b + t2) * 64 + 32 * ks + 8 * g);
#pragma unroll 1
        for (int kt = 0; kt < 4; ++kt) {
            bf16x8 are[2], aim[2];
#pragma unroll
            for (int ks = 0; ks < 2; ++ks) { are[ks] = *(const bf16x8*)(DFT1 + (16 * kt + q16) * 64 + 32 * ks + 8 * g); aim[ks] = *(const bf16x8*)(DFT1 + (64 + 16 * kt + q16) * 64 + 32 * ks + 8 * g); }
            float xr[8][4], xi[8][4];
#pragma unroll
            for (int t2 = 0; t2 < 8; ++t2) {
                f32x4 ar = {0.f, 0.f, 0.f, 0.f}, ai = {0.f, 0.f, 0.f, 0.f};
                ar = __builtin_amdgcn_mfma_f32_16x16x32_bf16(are[0], bfr[t2][0], ar, 0, 0, 0); ar = __builtin_amdgcn_mfma_f32_16x16x32_bf16(are[1], bfr[t2][1], ar, 0, 0, 0);
                ai = __builtin_amdgcn_mfma_f32_16x16x32_bf16(aim[0], bfr[t2][0], ai, 0, 0, 0); ai = __builtin_amdgcn_mfma_f32_16x16x32_bf16(aim[1], bfr[t2][1], ai, 0, 0, 0);
#pragma unroll
                for (int e = 0; e < 4; ++e) { const float2 w = TW[(8 * t2b + t2) * 64 + 16 * kt + 4 * g + e]; xr[t2][e] = ar[e] * w.x - ai[e] * w.y; xi[t2][e] = ar[e] * w.y + ai[e] * w.x; }
            }
#pragma unroll
            for (int e = 0; e < 4; ++e) { const int k1 = 16 * kt + 4 * g + e;
                v4u wr, wi; wr.x = cvtpk(xr[0][e], xr[1][e]); wr.y = cvtpk(xr[2][e], xr[3][e]); wr.z = cvtpk(xr[4][e], xr[5][e]); wr.w = cvtpk(xr[6][e], xr[7][e]);
                wi.x = cvtpk(xi[0][e], xi[1][e]); wi.y = cvtpk(xi[2][e], xi[3][e]); wi.z = cvtpk(xi[4][e], xi[5][e]); wi.w = cvtpk(xi[6][e], xi[7][e]);
                v4u* dst = (v4u*)(X1T + ((((size_t)(b * 64 + k1) * 8 + t2b) * 512 + ch) << 4)); dst[0] = wr; dst[1] = wi; }
        }
    }
}
__device__ __forceinline__ void phase_fft2(Frame& F, const Args& A) {
    typedef short bf16x8 __attribute__((ext_vector_type(8)));
    const bf16* X1T = (const bf16*)(F.ws + WS_MF); const bf16* T2 = (const bf16*)(F.ws + WS_T2); const bf16* MIXT = (const bf16*)(F.ws + WS_MIXT);
    bf16* mg = (bf16*)(F.ws + WS_X1); const float* bfour = A.in[5]; const float* gfour = A.in[7];
    const int lane = F.lane, q16 = lane & 15, g = lane >> 4;
    LAS unsigned char* slab = F.lds + F.wave * 16512;
    for (int u = GW_ID(F); u < NB * 64 * 4; u += N_GW(F)) {
        const int k2t = u & 3, k1 = (u >> 2) & 63, b = u >> 8;
        bf16x8 wb[2][4];
#pragma unroll
        for (int part = 0; part < 2; ++part)
#pragma unroll
            for (int ks = 0; ks < 4; ++ks) wb[part][ks] = *(const bf16x8*)(T2 + (part * 64 + 16 * k2t + q16) * 128 + 32 * ks + 8 * g);
        float ssq = 0.f;
#pragma unroll 1
        for (int grp = 0; grp < 8; ++grp) {
            f32x4 yr[4], yi[4];
#pragma unroll
            for (int ctile = 0; ctile < 4; ++ctile) {
                const int c = grp * 64 + 16 * ctile + q16; bf16x8 af[4];
#pragma unroll
                for (int ks = 0; ks < 4; ++ks) af[ks] = *(const bf16x8*)(X1T + ((((size_t)(b * 64 + k1) * 8 + 4 * (ks & 1) + g) * 512 + c) << 4) + (ks >> 1) * 8);
                f32x4 r = {0.f, 0.f, 0.f, 0.f}, im = {0.f, 0.f, 0.f, 0.f};
#pragma unroll
                for (int ks = 0; ks < 4; ++ks) { r = __builtin_amdgcn_mfma_f32_16x16x32_bf16(af[ks], wb[0][ks], r, 0, 0, 0); im = __builtin_amdgcn_mfma_f32_16x16x32_bf16(af[ks], wb[1][ks], im, 0, 0, 0); }
                yr[ctile] = r; yi[ctile] = im;
            }
            bf16x8 yb[4];
#pragma unroll
            for (int s = 0; s < 4; ++s) { const f32x4 lo = (s < 2) ? yr[2 * (s & 1)] : yi[2 * (s & 1)], hi = (s < 2) ? yr[2 * (s & 1) + 1] : yi[2 * (s & 1) + 1];
                v4u w; w.x = cvtpk(lo[0], lo[1]); w.y = cvtpk(lo[2], lo[3]); w.z = cvtpk(hi[0], hi[1]); w.w = cvtpk(hi[2], hi[3]); yb[s] = __builtin_bit_cast(bf16x8, w); }
#pragma unroll
            for (int dt = 0; dt < 4; ++dt) {
                f32x4 acc = {0.f, 0.f, 0.f, 0.f};
#pragma unroll
                for (int s = 0; s < 4; ++s) { const bf16x8 ma = *(const bf16x8*)(MIXT + ((size_t)(grp * 64 + 16 * dt + q16) << 7) + 32 * s + 8 * g); acc = __builtin_amdgcn_mfma_f32_16x16x32_bf16(ma, yb[s], acc, 0, 0, 0); }
                const f32x4 bv = *(const f32x4*)(bfour + grp * 64 + 16 * dt + 4 * g); acc += bv;
                ssq += (acc[0] * acc[0] + acc[1] * acc[1]) + (acc[2] * acc[2] + acc[3] * acc[3]);
                v2u w; w.x = cvtpk(acc[0], acc[1]); w.y = cvtpk(acc[2], acc[3]);
                *(LAS v2u*)(slab + q16 * 1032 + (grp * 64 + 16 * dt + 4 * g) * 2) = w;
            }
        }
        ssq += __shfl_xor(ssq, 16); ssq += __shfl_xor(ssq, 32);
        const float rstd = 1.0f / sqrtf(ssq * (1.f / 512.f) + EPS);
        LDS_WAIT(); asm volatile("" ::: "memory");
        const f32x4 g0 = *(const f32x4*)(gfour + lane * 8), g1 = *(const f32x4*)(gfour + lane * 8 + 4);
#pragma unroll 4
        for (int row = 0; row < 16; ++row) {
            const float rs = __shfl(rstd, row);
            const v2u a = *(const LAS v2u*)(slab + row * 1032 + lane * 16), c2 = *(const LAS v2u*)(slab + row * 1032 + lane * 16 + 8);
            v4u o; o.x = cvtpk(bflo(a.x) * rs * g0[0], bfhi(a.x) * rs * g0[1]); o.y = cvtpk(bflo(a.y) * rs * g0[2], bfhi(a.y) * rs * g0[3]);
            o.z = cvtpk(bflo(c2.x) * rs * g1[0], bfhi(c2.x) * rs * g1[1]); o.w = cvtpk(bflo(c2.y) * rs * g1[2], bfhi(c2.y) * rs * g1[3]);
            *(v4u*)(mg + ((size_t)b * T + k1 + 64 * (16 * k2t + row)) * D + DA + lane * 8) = o;
        }
        LDS_WAIT(); asm volatile("" ::: "memory");
    }
}
__device__ __forceinline__ void phase_attn_norm(Frame& F, const Args& A) {
    const float* mf = (const float*)F.out; bf16* mg = (bf16*)(F.ws + WS_X1); const int lane = F.lane;
    const f32x4 g0 = *(const f32x4*)(A.in[6] + lane * 8), g1 = *(const f32x4*)(A.in[6] + lane * 8 + 4);
    for (int tok = GW_ID(F); tok < NTOK; tok += N_GW(F)) {
        const f32x4* src = (const f32x4*)(mf + (size_t)tok * D + lane * 8); const f32x4 a = src[0], c = src[1];
        float s = (a.x * a.x + a.y * a.y) + (a.z * a.z + a.w * a.w) + (c.x * c.x + c.y * c.y) + (c.z * c.z + c.w * c.w);
        const float rstd = 1.0f / sqrtf(wave_sum(s) * (1.f / 512.f) + EPS);
        const f32x4 x = a * rstd * g0, y = c * rstd * g1;
        v4u o; o.x = pk2(x.x, x.y); o.y = pk2(x.z, x.w); o.z = pk2(y.x, y.y); o.w = pk2(y.z, y.w);
        *(v4u*)(mg + (size_t)tok * D + lane * 8) = o;
    }
}
__device__ __forceinline__ void phase_router(Frame& F, const Args& A) {
    typedef short bf16x8 __attribute__((ext_vector_type(8)));
    LAS int* lcnt = (LAS int*)(F.lds + L_LCNT); LAS int* gbase = (LAS int*)(F.lds + L_GBASE); LAS int* rt = (LAS int*)(F.lds + L_RT);
    const bf16* h = (const bf16*)(F.ws + WS_XN);
    int2* e01 = (int2*)(F.ws + WS_ROUTE); int2* rank = e01 + NTOK; float2* wgt = (float2*)(rank + NTOK); float* rstd = (float*)(wgt + NTOK);
    const float* brc = A.in[11]; const float* brf = A.in[13]; const int lane = F.lane, q16 = lane & 15, g = lane >> 4;
    for (int batch = F.vcu; batch < NTOK / 128; batch += F.G) {
        { const v4u* src = (const v4u*)(F.ws + WS_WR); for (int i = F.tid; i < 72 * 128; i += NWAVES * 64) *(LAS v4u*)(F.lds + (i >> 7) * RT_STRIDE + (i & 127) * 16) = src[i]; }
        if (F.tid < 32) lcnt[F.tid] = 0;
        __syncthreads();
        const int tok0 = batch * 128 + F.wave * 16;
        f32x4 acc[3]; float ssq = 0.f;
#pragma unroll
        for (int nt = 0; nt < 3; ++nt) acc[nt] = (f32x4){0.f, 0.f, 0.f, 0.f};
        const bf16* hp = h + (size_t)(tok0 + q16) * D + 8 * g;
        const LAS unsigned char* w0 = F.lds + q16 * RT_STRIDE + 16 * g; const LAS unsigned char* w1 = w0 + 16 * RT_STRIDE; const LAS unsigned char* w2 = F.lds + min(32 + q16, 35) * RT_STRIDE + 16 * g;
#pragma unroll 4
        for (int ks = 0; ks < 32; ++ks) {
            const bf16x8 hf = *(const bf16x8*)(hp + 32 * ks);
#pragma unroll
            for (int i = 0; i < 8; ++i) { const float v = __builtin_bit_cast(float, (unsigned)(unsigned short)hf[i] << 16); ssq += v * v; }
            acc[0] = __builtin_amdgcn_mfma_f32_16x16x32_bf16(*(const LAS bf16x8*)(w0 + 64 * ks), hf, acc[0], 0, 0, 0);
            acc[0] = __builtin_amdgcn_mfma_f32_16x16x32_bf16(*(const LAS bf16x8*)(w0 + 36 * RT_STRIDE + 64 * ks), hf, acc[0], 0, 0, 0);
            acc[1] = __builtin_amdgcn_mfma_f32_16x16x32_bf16(*(const LAS bf16x8*)(w1 + 64 * ks), hf, acc[1], 0, 0, 0);
            acc[1] = __builtin_amdgcn_mfma_f32_16x16x32_bf16(*(const LAS bf16x8*)(w1 + 36 * RT_STRIDE + 64 * ks), hf, acc[1], 0, 0, 0);
            acc[2] = __builtin_amdgcn_mfma_f32_16x16x32_bf16(*(const LAS bf16x8*)(w2 + 64 * ks), hf, acc[2], 0, 0, 0);
            acc[2] = __builtin_amdgcn_mfma_f32_16x16x32_bf16(*(const LAS bf16x8*)(w2 + 36 * RT_STRIDE + 64 * ks), hf, acc[2], 0, 0, 0);
        }
        ssq += __shfl_xor(ssq, 16); ssq += __shfl_xor(ssq, 32);
        __syncthreads();
        LAS float* lg = (LAS float*)F.lds + (F.wave * 16) * 37;
#pragma unroll
        for (int nt = 0; nt < 3; ++nt)
#pragma unroll
            for (int e = 0; e < 4; ++e) { const int j = 16 * nt + 4 * g + e; if (j < 36) lg[q16 * 37 + j] = acc[nt][e]; }
        LDS_WAIT(); asm volatile("" ::: "memory");
        if (lane < 16) {
            const int tl = F.wave * 16 + lane, tok = batch * 128 + tl; const float rs = 1.0f / sqrtf(ssq * (1.f / D) + EPS); const LAS float* L = lg + lane * 37;
            const float c0 = L[0] * rs + brc[0], c1 = L[1] * rs + brc[1], c2 = L[2] * rs + brc[2], c3 = L[3] * rs + brc[3];
            int gi = 0; float mx = c0;
            if (c1 > mx) { mx = c1; gi = 1; }
            if (c2 > mx) { mx = c2; gi = 2; }
            if (c3 > mx) { mx = c3; gi = 3; }
            const float gwt = 1.0f / (expf(c0 - mx) + expf(c1 - mx) + expf(c2 - mx) + expf(c3 - mx));
            float v0 = -1e30f, v1 = -1e30f; int i0 = 0, i1 = 0;
#pragma unroll
            for (int j = 0; j < 8; ++j) { const float fv = L[4 + gi * 8 + j] * rs + brf[gi * 8 + j];
                if (fv > v0) { v1 = v0; i1 = i0; v0 = fv; i0 = j; } else if (fv > v1) { v1 = fv; i1 = j; } }
            const float e1 = expf(v1 - v0), p0 = 1.f / (1.f + e1), p1 = e1 / (1.f + e1);
            const int ea = gi * 8 + i0, eb = gi * 8 + i1;
            const int ra = __hip_atomic_fetch_add(lcnt + ea, 1, __ATOMIC_RELAXED, __HIP_MEMORY_SCOPE_WORKGROUP);
            const int rb = __hip_atomic_fetch_add(lcnt + eb, 1, __ATOMIC_RELAXED, __HIP_MEMORY_SCOPE_WORKGROUP);
            rt[tl] = ea; rt[128 + tl] = eb; rt[256 + tl] = ra; rt[384 + tl] = rb;
            wgt[tok] = make_float2(p0 * gwt, p1 * gwt); rstd[tok] = rs;
        }
        __syncthreads();
        if (F.tid < 32) gbase[F.tid] = (int)__hip_atomic_fetch_add(F.ctl + CW_CNT + 64 * F.tid, (unsigned)lcnt[F.tid], __ATOMIC_RELAXED, __HIP_MEMORY_SCOPE_AGENT);
        __syncthreads();
        if (F.tid < 128) { const int tok = batch * 128 + F.tid, ea = rt[F.tid], eb = rt[128 + F.tid];
            e01[tok] = make_int2(ea, eb); rank[tok] = make_int2(rt[256 + F.tid] + gbase[ea], rt[384 + F.tid] + gbase[eb]); }
        __syncthreads();
    }
}
__device__ __forceinline__ void phase_scatter(Frame& F, const Args& A) {
    LAS int* pbase = (LAS int*)(F.lds + L_PBASE);
    LAS int* lcnt = (LAS int*)(F.lds + L_LCNT);
    if (F.tid < 32) lcnt[F.tid] = (int)__hip_atomic_load(F.ctl + CW_CNT + 64 * F.tid, __ATOMIC_RELAXED, __HIP_MEMORY_SCOPE_AGENT);
    __syncthreads();
    if (F.tid == 0) { int acc = 0; for (int e = 0; e < 32; ++e) { pbase[e] = acc; acc += (lcnt[e] + 255) >> 8; } pbase[32] = acc; }
    __syncthreads();
    float* rstd_s = (float*)(F.ws + WS_META); float* w_s = rstd_s + MAXROWS; int* slotrow_s = (int*)(w_s + MAXROWS);
    for (int e = F.vcu; e < 32; e += F.G) { const int cnt = lcnt[e];
        for (int r = 256 * pbase[e] + cnt + F.tid; r < 256 * pbase[e + 1]; r += NWAVES * 64) { slotrow_s[r] = 2 * NTOK; w_s[r] = 0.f; rstd_s[r] = 0.f; } }
    const bf16* h = (const bf16*)(F.ws + WS_XN); bf16* hs = (bf16*)(F.ws + WS_QKVU);
    const int2* e01 = (const int2*)(F.ws + WS_ROUTE); const int2* rank = e01 + NTOK; const float2* wgt = (const float2*)(rank + NTOK); const float* rstd = (const float*)(wgt + NTOK);
    for (int tok = GW_ID(F); tok < NTOK; tok += N_GW(F)) {
        const int2 e = e01[tok], r = rank[tok]; const float2 w = wgt[tok]; const float rs = rstd[tok];
        const int pos0 = 256 * pbase[e.x] + r.x, pos1 = 256 * pbase[e.y] + r.y;
        const v4u* src = (const v4u*)(h + (size_t)tok * D) + F.lane * 2; const v4u a = src[0], b = src[1];
        v4u* d0 = (v4u*)(hs + (size_t)pos0 * D) + F.lane * 2; d0[0] = a; d0[1] = b;
        v4u* d1 = (v4u*)(hs + (size_t)pos1 * D) + F.lane * 2; d1[0] = a; d1[1] = b;
        if (F.lane == 0) { rstd_s[pos0] = rs; w_s[pos0] = w.x; slotrow_s[pos0] = 2 * tok; rstd_s[pos1] = rs; w_s[pos1] = w.y; slotrow_s[pos1] = 2 * tok + 1; }
    }
}
__device__ __forceinline__ void phase_final(Frame& F, const Args& A) {
    const bf16* h = (const bf16*)(F.ws + WS_XN); const bf16* y2 = (const bf16*)(F.ws + WS_X1); const int lane = F.lane;
    f32x4 gv[4];
#pragma unroll
    for (int j = 0; j < 4; ++j) gv[j] = ((const f32x4*)(A.in[17] + lane * 16))[j];
    for (int tok = GW_ID(F); tok < NTOK; tok += N_GW(F)) {
        const v4u* ph = (const v4u*)(h + (size_t)tok * D) + lane * 2; const v4u* p0 = (const v4u*)(y2 + (size_t)(2 * tok) * D) + lane * 2; const v4u* p1 = (const v4u*)(y2 + (size_t)(2 * tok + 1) * D) + lane * 2;
        f32x4 v[4]; float s = 0.f;
#pragma unroll
        for (int hh = 0; hh < 2; ++hh) { const v4u a = ph[hh], b = p0[hh], c = p1[hh];
            v[2 * hh] = (f32x4){bflo(a.x) + bflo(b.x) + bflo(c.x), bfhi(a.x) + bfhi(b.x) + bfhi(c.x), bflo(a.y) + bflo(b.y) + bflo(c.y), bfhi(a.y) + bfhi(b.y) + bfhi(c.y)};
            v[2 * hh + 1] = (f32x4){bflo(a.z) + bflo(b.z) + bflo(c.z), bfhi(a.z) + bfhi(b.z) + bfhi(c.z), bflo(a.w) + bflo(b.w) + bflo(c.w), bfhi(a.w) + bfhi(b.w) + bfhi(c.w)}; }
#pragma unroll
        for (int j = 0; j < 4; ++j) s += (v[j].x * v[j].x + v[j].y * v[j].y) + (v[j].z * v[j].z + v[j].w * v[j].w);
        const float rstd = 1.0f / sqrtf(wave_sum(s) * (1.f / D) + EPS);
        f32x4* dst = (f32x4*)(F.out + (size_t)tok * D + lane * 16);
#pragma unroll
        for (int j = 0; j < 4; ++j) dst[j] = v[j] * rstd * gv[j];
    }
}
__global__ void __launch_bounds__(NWAVES * 64, 2) mega_fwd(Args args) {
    extern __shared__ __attribute__((aligned(16))) unsigned char lds[];
    Frame F;
    F.lds = (LAS unsigned char*)lds;
    F.tid = threadIdx.x; F.lane = F.tid & 63; F.wave = __builtin_amdgcn_readfirstlane(F.tid >> 6);
    F.G = gridDim.x; { const int bx = blockIdx.x; F.vcu = (F.G % 8 == 0) ? (bx % 8) * (F.G / 8) + bx / 8 : bx; }
    F.ws = args.ws; F.ctl = (unsigned*)(args.ws + WS_CTL); F.out = args.out;
    for (int u = F.tid; u < (LDS_BYTES - LDSCTL_OFF) / 4; u += NWAVES * 64) ((LAS unsigned*)(F.lds + LDSCTL_OFF))[u] = 0u;
    __syncthreads();
    XcdBarrier bar = xcd_barrier_post(F.ctl + CW_BAR, (volatile LAS unsigned*)(F.lds + L_MISC) + 8);
#define GRID_BAR() xcd_barrier(bar)
    PG8_LAS unsigned char* ring = (PG8_LAS unsigned char*)lds;
    const pg8::bf16_t* XN = (const pg8::bf16_t*)(F.ws + WS_XN);

    phase_prep(F, args);
    GRID_BAR();
    {
        pg8::Gemm g{XN, (const pg8::bf16_t*)(F.ws + WS_WIN), NTOK, 1024, D}; pg8::StaticOrder S; S.init(NTOK, 1024, F.G, (int)blockIdx.x);
        pg8::EpiBf16 E{(pg8::bf16_t*)(F.ws + WS_QKVU), 512, 512, (size_t)NTOK * 512, QSCALE};
        pg8::gemm_phase<pg8::EpiBf16, pg8::StaticOrder, true, true>(ring, g, S, E);
    }
    {
        pg8::Gemm g{(const pg8::bf16_t*)(F.ws + WS_WIN) + (size_t)1536 * D, XN, 512, NTOK, D}; pg8::StaticOrder S; S.init(512, NTOK, F.G, (int)blockIdx.x);
        pg8::EpiBf16 E{(pg8::bf16_t*)(F.ws + WS_QKVU) + (size_t)3 * NTOK * 512, NTOK, NTOK, 0, 1.0f};
        pg8::gemm_phase<pg8::EpiBf16, pg8::StaticOrder, true, true>(ring, g, S, E);
    }
    {
        pg8::Gemm g{(const pg8::bf16_t*)(F.ws + WS_WIN) + (size_t)1024 * D, XN, 512, NTOK, D}; pg8::StaticOrder S; S.init(512, NTOK, F.G, (int)blockIdx.x);
        pg8::EpiBf16 E{(pg8::bf16_t*)(F.ws + WS_QKVU) + (size_t)2 * NTOK * 512, NTOK, NTOK, 0, 1.0f};
        pg8::gemm_phase<pg8::EpiBf16, pg8::StaticOrder, true, true, pg8::BGridT>(ring, g, S, E);
    }
    GRID_BAR();
    phase_attn(F, args);
    phase_fft1(F, args);
    GRID_BAR();
    phase_fft2(F, args);
    phase_attn_norm(F, args);
    GRID_BAR();
    {
        pg8::Gemm g{(const pg8::bf16_t*)(F.ws + WS_X1), (const pg8::bf16_t*)(F.ws + WS_WOUT), NTOK, D, D}; pg8::StaticOrder S; S.init(NTOK, D, F.G, (int)blockIdx.x);
        pg8::EpiResH E{args.in[0], (pg8::bf16_t*)(F.ws + WS_XN)};
        pg8::gemm_phase<pg8::EpiResH, pg8::StaticOrder, true, true>(ring, g, S, E);
    }
    GRID_BAR();
    phase_router(F, args);
    GRID_BAR();
    phase_scatter(F, args);
    GRID_BAR();
    {
        pg8::Gemm g{(const pg8::bf16_t*)(F.ws + WS_QKVU), (const pg8::bf16_t*)(F.ws + WS_WGU), MAXROWS, NE * 512, D};
        pg8::MoeOrder S{(const PG8_LAS int*)(ring + L_PBASE), 2, F.G, (int)blockIdx.x};
        const float* rstd_s = (const float*)(F.ws + WS_META);
        pg8::EpiMoe1 E{rstd_s, rstd_s + MAXROWS, (pg8::bf16_t*)(F.ws + WS_HD)};
        pg8::gemm_phase<pg8::EpiMoe1, pg8::MoeOrder, true, true>(ring, g, S, E);
    }
    GRID_BAR();
    {
        pg8::Gemm g{(const pg8::bf16_t*)(F.ws + WS_HD), (const pg8::bf16_t*)(F.ws + WS_WD), MAXROWS, NE * 1024, DE};
        pg8::MoeOrder S{(const PG8_LAS int*)(ring + L_PBASE), 4, F.G, (int)blockIdx.x};
        const int* slotrow_s = (const int*)(F.ws + WS_META) + 2 * MAXROWS;
        pg8::EpiMoe2 E{slotrow_s, (pg8::bf16_t*)(F.ws + WS_X1)};
        pg8::gemm_phase<pg8::EpiMoe2, pg8::MoeOrder, true, true>(ring, g, S, E);
    }
    GRID_BAR();
    phase_final(F, args);
}

extern "C" void kernel_launch(void* const* d_in, const int* in_sizes, int n_in, void* d_out, int out_size, void* d_ws, size_t ws_size, hipStream_t stream) {
    static int grid = 0;
    if (grid == 0) {
        if (n_in != 18 || out_size != NTOK * D || ws_size < WS_END) { fprintf(stderr, "kernel_launch: unexpected problem shape (n_in %d, out %d, ws %zu)\n", n_in, out_size, ws_size); grid = -1; return; }
        int dev = 0, cus = 0;
        if (hipGetDevice(&dev) != hipSuccess || hipDeviceGetAttribute(&cus, hipDeviceAttributeMultiprocessorCount, dev) != hipSuccess) { grid = -1; return; }
        if (hipFuncSetAttribute((const void*)mega_fwd, hipFuncAttributeMaxDynamicSharedMemorySize, LDS_BYTES) != hipSuccess) { fprintf(stderr, "kernel_launch: hipFuncSetAttribute failed\n"); grid = -1; return; }
        int per_cu = 0;
        if (hipOccupancyMaxActiveBlocksPerMultiprocessor(&per_cu, (const void*)mega_fwd, NWAVES * 64, LDS_BYTES) != hipSuccess || per_cu < 1) { fprintf(stderr, "kernel_launch: occupancy query says %d blocks per CU\n", per_cu); }
        (void)hipGetLastError();
        grid = cus;
    }
    if (grid < 0) return;
    (void)hipMemsetAsync((char*)d_ws + WS_CTL, 0, CTL_ZERO_BYTES, stream);
    Args a{};
    for (int i = 0; i < 18; ++i) a.in[i] = (const float*)d_in[i];
    a.out = (float*)d_out; a.ws = (unsigned char*)d_ws;
    hipLaunchKernelGGL(mega_fwd, dim3(grid), dim3(NWAVES * 64), LDS_BYTES, stream, a);
}
```

```cpp
#include <hip/hip_runtime.h>
#include <cstdint>
#include <cstdio>
namespace pg8 {
#define PG8_LAS __attribute__((address_space(3)))
typedef unsigned short bf16_t;
typedef short bf16x8 __attribute__((ext_vector_type(8)));
typedef float f32x4 __attribute__((ext_vector_type(4)));
typedef unsigned u32x4 __attribute__((ext_vector_type(4)));
constexpr int BM = 256, BK = 64, HALF = 128, HTB = HALF * BK * 2  , STAGE_BYTES = 8 * HTB, NXCD = 8, WGM = 8;

__host__ __device__ __forceinline__ int lds_byte(int r, int c) { const int st = (r >> 4) * 2 + (c >> 5), rr = r & 15, cc = c & 31, ob = rr * 64 + cc * 2; return st * 1024 + (ob ^ (((ob >> 9) & 1) << 5)); }
__host__ __device__ __forceinline__ void stage_rc(int b, int& R, int& C) { const int st = b / 1024, sb = b % 1024, swz = sb ^ (((sb >> 9) & 1) << 5); R = (st >> 1) * 16 + swz / 64; C = (st & 1) * 32 + (swz % 64) / 2; }
__host__ __device__ __forceinline__ int perm32(int rho) { const int n = rho >> 4, i = rho & 15; return 8 * (i >> 2) + 4 * n + (i & 3); }

struct Unit { int pm, pn; };
struct Gemm { const bf16_t* A; const bf16_t* Bt; int M, N, K; };

struct StaticOrder {
    int nM, nN, nwg, G, c;
    __host__ __device__ void init(int M, int N, int G_, int c_) { nM = M / BM; nN = N / BM; nwg = nM * nN; G = G_; c = c_; }
    __host__ __device__ bool next(int i, Unit& u) const {
        const long L = (long)i * G + c; if (L >= nwg) return false;
        int wgid = (int)L; { const int q = nwg / NXCD, r = nwg % NXCD, xcd = wgid % NXCD, off = wgid / NXCD; wgid = (xcd < r ? xcd * (q + 1) : r * (q + 1) + (xcd - r) * q) + off; }
        const int nig = WGM * nN, gid = wgid / nig, fm = gid * WGM, gsz = (nM - fm) < WGM ? (nM - fm) : WGM;
        u.pm = fm + ((wgid % nig) % gsz); u.pn = (wgid % nig) / gsz; return true;
    }
    __device__ __forceinline__ void a_ready(const Unit&) const {}
    __device__ __forceinline__ void done(const Unit&) const {}
};

typedef float f32x2c __attribute__((ext_vector_type(2))); typedef __bf16 bf16x2c __attribute__((ext_vector_type(2)));
__device__ __forceinline__ unsigned cvt_pk_bf16(float lo, float hi) { f32x2c v = {lo, hi}; bf16x2c b = __builtin_convertvector(v, bf16x2c); return __builtin_bit_cast(unsigned, b); }
typedef float f32x2 __attribute__((ext_vector_type(2)));
struct EpiBf16 {
    static constexpr bool PERM = true, AFTER_DRAIN = false;
    bf16_t* O; int ldc; int split_cols; size_t split_stride; float scale0;
    __device__ __forceinline__ void operator()(const f32x4 (&acc)[2][2][4][2], const Unit& u, int wr, int wc, int fr, int fq) const {
        const int row0 = u.pm * BM + wr * 64 + fr; int colt = u.pn * BM; bf16_t* base = O;
        float sc = 1.f; { const int t = colt / split_cols; base += (size_t)t * split_stride; colt -= t * split_cols; if (t == 0) sc = scale0; }
        const int col0 = colt + wc * 32 + 8 * fq;
#pragma unroll
        for (int ai = 0; ai < 2; ++ai)
#pragma unroll
            for (int m = 0; m < 4; ++m) { bf16_t* rowp = base + (size_t)(row0 + ai * HALF + m * 16) * ldc + col0;
#pragma unroll
                for (int bj = 0; bj < 2; ++bj) { f32x4 v0 = acc[ai][bj][m][0] * sc, v1 = acc[ai][bj][m][1] * sc;
                    u32x4 w; w.x = cvt_pk_bf16(v0[0], v0[1]); w.y = cvt_pk_bf16(v0[2], v0[3]); w.z = cvt_pk_bf16(v1[0], v1[1]); w.w = cvt_pk_bf16(v1[2], v1[3]);
                    *(u32x4*)(rowp + bj * HALF) = w; } }
    }
};
struct EpiResH {
    static constexpr bool PERM = true, AFTER_DRAIN = false;
    const float* x; bf16_t* h;
    __device__ __forceinline__ void operator()(const f32x4 (&acc)[2][2][4][2], const Unit& u, int wr, int wc, int fr, int fq) const {
        const int row0 = u.pm * BM + wr * 64 + fr, col0 = u.pn * BM + wc * 32 + 8 * fq;
#pragma unroll
        for (int ai = 0; ai < 2; ++ai)
#pragma unroll
            for (int m = 0; m < 4; ++m) { const size_t off = (size_t)(row0 + ai * HALF + m * 16) * 1024 + col0;
#pragma unroll
                for (int bj = 0; bj < 2; ++bj) { const f32x4 xa = *(const f32x4*)(x + off + bj * HALF), xb = *(const f32x4*)(x + off + bj * HALF + 4);
                    const f32x4 v0 = acc[ai][bj][m][0] + xa, v1 = acc[ai][bj][m][1] + xb;
                    u32x4 w; w.x = cvt_pk_bf16(v0[0], v0[1]); w.y = cvt_pk_bf16(v0[2], v0[3]); w.z = cvt_pk_bf16(v1[0], v1[1]); w.w = cvt_pk_bf16(v1[2], v1[3]);
                    *(u32x4*)(h + off + bj * HALF) = w; } }
    }
};
struct EpiMoe1 {
    static constexpr bool PERM = true, AFTER_DRAIN = false;
    const float* rstd_s; const float* w_s; bf16_t* hd;
    __device__ __forceinline__ void operator()(const f32x4 (&acc)[2][2][4][2], const Unit& u, int wr, int wc, int fr, int fq) const {
        const int row0 = u.pm * BM + wr * 64 + fr, col0 = (u.pn & 1) * HALF + wc * 32 + 8 * fq;
#pragma unroll
        for (int ai = 0; ai < 2; ++ai)
#pragma unroll
            for (int m = 0; m < 4; ++m) { const int row = row0 + ai * HALF + m * 16; const float rs = rstd_s[row], wv = w_s[row];
                float o[8];
#pragma unroll
                for (int n = 0; n < 2; ++n)
#pragma unroll
                    for (int j = 0; j < 4; ++j) { const float g = acc[ai][0][m][n][j] * rs, uu = acc[ai][1][m][n][j] * rs;
                        o[n * 4 + j] = g * __builtin_amdgcn_rcpf(1.0f + __builtin_amdgcn_exp2f(-1.4426950408889634f * g)) * uu * wv; }
                u32x4 w; w.x = cvt_pk_bf16(o[0], o[1]); w.y = cvt_pk_bf16(o[2], o[3]); w.z = cvt_pk_bf16(o[4], o[5]); w.w = cvt_pk_bf16(o[6], o[7]);
                *(u32x4*)(hd + (size_t)row * 256 + col0) = w; }
    }
};
struct EpiMoe2 {
    static constexpr bool PERM = true, AFTER_DRAIN = false;
    const int* slotrow_s; bf16_t* y2;
    __device__ __forceinline__ void operator()(const f32x4 (&acc)[2][2][4][2], const Unit& u, int wr, int wc, int fr, int fq) const {
        const int row0 = u.pm * BM + wr * 64 + fr, col0 = (u.pn & 3) * BM + wc * 32 + 8 * fq;
#pragma unroll
        for (int ai = 0; ai < 2; ++ai)
#pragma unroll
            for (int m = 0; m < 4; ++m) { const int sr = slotrow_s[row0 + ai * HALF + m * 16];
                bf16_t* rowp = y2 + (size_t)sr * 1024 + col0;
#pragma unroll
                for (int bj = 0; bj < 2; ++bj) { const f32x4 v0 = acc[ai][bj][m][0], v1 = acc[ai][bj][m][1];
                    u32x4 w; w.x = cvt_pk_bf16(v0[0], v0[1]); w.y = cvt_pk_bf16(v0[2], v0[3]); w.z = cvt_pk_bf16(v1[0], v1[1]); w.w = cvt_pk_bf16(v1[2], v1[3]);
                    *(u32x4*)(rowp + bj * HALF) = w; }
                asm volatile("" ::: "memory"); }
    }
};
struct MoeOrder {
    const PG8_LAS int* pbase; int ntn, G, c;
    __device__ __forceinline__ bool next(int i, Unit& u) const {
        const int L = i * G + c; const int total = pbase[32] * ntn; if (L >= total) return false;
        const int pm = L / ntn, pl = L - pm * ntn; int e = 0;
#pragma unroll 1
        for (int j = 1; j < 32; ++j) e += (pbase[j] <= pm) ? 1 : 0;
        u.pm = pm; u.pn = e * ntn + pl; return true;
    }
    __device__ __forceinline__ void a_ready(const Unit&) const {}
    __device__ __forceinline__ void done(const Unit&) const {}
};
struct BNat { static __device__ __forceinline__ int row(int v) { return v; } static __device__ __forceinline__ size_t hstep(int K) { return (size_t)HALF * K * 2; } static __device__ __forceinline__ size_t tile(int pn, int K) { return (size_t)pn * BM * K * 2; } };
struct BGridT { static __device__ __forceinline__ int row(int v) { return (v & 63) * 64 + (v >> 6); } static __device__ __forceinline__ size_t hstep(int K) { return (size_t)2 * K * 2; }
    static __device__ __forceinline__ size_t tile(int pn, int K) { return (size_t)((pn >> 4) * 4096 + (pn & 15) * 4) * K * 2; } };
template <class Epi, class Sched, bool ALIGN_EPI = false, bool SP2 = false, class BMap = BNat>
__device__ __forceinline__ void gemm_phase(PG8_LAS unsigned char* lds, const Gemm g, const Sched& S, const Epi& E) {
    int tid_ = threadIdx.x; asm volatile("" : "+v"(tid_));
    const int tid = tid_, wid = __builtin_amdgcn_readfirstlane(tid >> 6), lane = tid & 63, wr = wid >> 2, wc = wid & 3, fr = lane & 15, fq = lane >> 4;
    const int K = g.K; int nt_ = K / BK; asm volatile("" : "+s"(nt_)); const int nt = nt_;
    unsigned voffA[2], voffB[2];
#pragma unroll
    for (int i = 0; i < 2; ++i) { int R, C; stage_rc(tid * 16 + i * 8192, R, C); const int Rb = Epi::PERM ? ((R & ~31) + perm32(R & 31)) : R;
        voffA[i] = (unsigned)(R * K + C) * 2u; voffB[i] = (unsigned)(BMap::row(Rb) * K + C) * 2u; }
    const size_t kstep = (size_t)(BK * 2);
    const size_t hstep = (size_t)HALF * K * 2;
    const size_t tstep = 2 * hstep; const size_t hstepB = BMap::hstep(K);
    const unsigned ldsw = (unsigned)wid * 1024u;
    const int aoff = lds_byte(wr * 64 + fr, fq * 8), boff = lds_byte(wc * 32 + fr, fq * 8);
#define PG8_SA(b, h) (((b) * 2 + (h)) * HTB)
#define PG8_SB(b, h) ((4 + (b) * 2 + (h)) * HTB)
#define PG8_STAGE(bufoff, gbase, voff) do { _Pragma("unroll") for (int _i = 0; _i < 2; ++_i) \
        __builtin_amdgcn_global_load_lds((const unsigned*)((const char*)(gbase) + (voff)[_i]), (PG8_LAS unsigned*)(lds + (bufoff) + ldsw + _i * 8192), 16, 0, 0); } while (0)
#define PG8_LDA(dst, b, h) do { _Pragma("unroll") for (int m = 0; m < 4; ++m) _Pragma("unroll") for (int k = 0; k < 2; ++k) dst[m][k] = *(const PG8_LAS bf16x8*)(lds + PG8_SA(b, h) + aoff + m * 2048 + k * 1024); } while (0)
#define PG8_LDB(dst, b, h) do { _Pragma("unroll") for (int n = 0; n < 2; ++n) _Pragma("unroll") for (int k = 0; k < 2; ++k) dst[n][k] = *(const PG8_LAS bf16x8*)(lds + PG8_SB(b, h) + boff + n * 2048 + k * 1024); } while (0)
#define PG8_MMA(ai, bj, At, Bt) do { __builtin_amdgcn_s_setprio(1); _Pragma("unroll") for (int m = 0; m < 4; ++m) _Pragma("unroll") for (int n = 0; n < 2; ++n) _Pragma("unroll") for (int k = 0; k < 2; ++k) \
        acc[ai][bj][m][n] = __builtin_amdgcn_mfma_f32_16x16x32_bf16(Bt[n][k], At[m][k], acc[ai][bj][m][n], 0, 0, 0); __builtin_amdgcn_s_setprio(0); } while (0)
#define PG8_WAIT_V(n) asm volatile("s_waitcnt vmcnt(" #n ")" ::: "memory")
#define PG8_WAIT_L(n) asm volatile("s_waitcnt lgkmcnt(" #n ")" ::: "memory")
#define PG8_BAR __builtin_amdgcn_s_barrier()
#define PG8_SCHED __builtin_amdgcn_sched_barrier(0)
    Unit cur, nxt; int ui = 0;
    if (!S.next(0, cur)) return;
    f32x4 acc[2][2][4][2];
#pragma unroll
    for (int a = 0; a < 2; ++a)
#pragma unroll
        for (int b = 0; b < 2; ++b)
#pragma unroll
            for (int m = 0; m < 4; ++m)
#pragma unroll
                for (int n = 0; n < 2; ++n) acc[a][b][m][n] = (f32x4){0.f, 0.f, 0.f, 0.f};
    bf16x8 At[4][2], B0[2][2], B1[2][2];
    const char* cA = (const char*)g.A + (size_t)cur.pm * tstep; const char* cB = (const char*)g.Bt + BMap::tile(cur.pn, K);
    S.a_ready(cur);
    if constexpr (SP2) {
        PG8_STAGE(PG8_SB(0, 0), cB, voffB); PG8_STAGE(PG8_SB(0, 1), cB + hstepB, voffB); PG8_STAGE(PG8_SA(0, 0), cA, voffA); PG8_STAGE(PG8_SA(0, 1), cA + hstep, voffA);
        if (wr == 1) PG8_BAR;
        PG8_WAIT_V(2); PG8_BAR;
        PG8_STAGE(PG8_SB(1, 0), cB + kstep, voffB); PG8_STAGE(PG8_SA(1, 0), cA + kstep, voffA); PG8_STAGE(PG8_SB(1, 1), cB + hstepB + kstep, voffB);
        PG8_WAIT_V(6); PG8_BAR;
    } else {
        PG8_STAGE(PG8_SB(0, 0), cB, voffB); PG8_STAGE(PG8_SA(0, 0), cA, voffA); PG8_STAGE(PG8_SB(0, 1), cB + hstepB, voffB); PG8_STAGE(PG8_SA(0, 1), cA + hstep, voffA);
        if (wr == 1) PG8_BAR;
        PG8_WAIT_V(4); PG8_BAR;
        PG8_STAGE(PG8_SB(1, 0), cB + kstep, voffB); PG8_STAGE(PG8_SA(1, 0), cA + kstep, voffA); PG8_STAGE(PG8_SB(1, 1), cB + hstepB + kstep, voffB);
        PG8_WAIT_V(6); PG8_BAR;
    }
    for (;;) {
        const bool has_next = S.next(ui + 1, nxt);
        const char* nA = has_next ? (const char*)g.A + (size_t)nxt.pm * tstep : cA; const char* nB = has_next ? (const char*)g.Bt + BMap::tile(nxt.pn, K) : cB;
        for (int t = 0; t < nt; t += 2) {
            const bool last = (t == nt - 2);
            const char* a1 = cA + (size_t)(t + 1) * kstep;
            const char* a2 = last ? nA : cA + (size_t)(t + 2) * kstep; const char* b2 = last ? nB : cB + (size_t)(t + 2) * kstep;
            const char* a3 = a2 + kstep; const char* b3 = b2 + kstep;
            if (last && has_next) S.a_ready(nxt);
            if constexpr (SP2) {
            PG8_LDB(B0, 0, 0); PG8_LDB(B1, 0, 1); PG8_SCHED; PG8_LDA(At, 0, 0); PG8_STAGE(PG8_SA(1, 1), a1 + hstep, voffA);
            PG8_WAIT_V(8); PG8_WAIT_L(0); PG8_BAR; PG8_MMA(0, 0, At, B0); PG8_MMA(0, 1, At, B1); PG8_BAR; PG8_SCHED;
            PG8_LDA(At, 0, 1); PG8_STAGE(PG8_SB(0, 0), b2, voffB); PG8_STAGE(PG8_SB(0, 1), b2 + hstepB, voffB); PG8_STAGE(PG8_SA(0, 0), a2, voffA);
            PG8_WAIT_V(8); PG8_WAIT_L(0); PG8_BAR; PG8_MMA(1, 0, At, B0); PG8_MMA(1, 1, At, B1); PG8_BAR; PG8_SCHED;
            PG8_LDB(B0, 1, 0); PG8_LDB(B1, 1, 1); PG8_SCHED; PG8_LDA(At, 1, 0); PG8_STAGE(PG8_SA(0, 1), a2 + hstep, voffA);
            PG8_WAIT_V(8); PG8_WAIT_L(0); PG8_BAR; PG8_MMA(0, 0, At, B0); PG8_MMA(0, 1, At, B1); PG8_BAR; PG8_SCHED;
            PG8_LDA(At, 1, 1); PG8_STAGE(PG8_SB(1, 0), b3, voffB); PG8_STAGE(PG8_SB(1, 1), b3 + hstepB, voffB); PG8_STAGE(PG8_SA(1, 0), a3, voffA);
            PG8_WAIT_V(8); PG8_WAIT_L(0); PG8_BAR; PG8_MMA(1, 0, At, B0); PG8_MMA(1, 1, At, B1); PG8_BAR; PG8_SCHED;
            } else {
            PG8_LDB(B0, 0, 0); PG8_SCHED; PG8_LDA(At, 0, 0); PG8_STAGE(PG8_SA(1, 1), a1 + hstep, voffA);
            PG8_WAIT_L(8); PG8_BAR; PG8_WAIT_L(0); PG8_MMA(0, 0, At, B0); PG8_BAR; PG8_SCHED;
            PG8_LDB(B1, 0, 1); PG8_STAGE(PG8_SB(0, 0), b2, voffB);
            PG8_BAR; PG8_WAIT_L(0); PG8_MMA(0, 1, At, B1); PG8_BAR;
            PG8_LDA(At, 0, 1); PG8_STAGE(PG8_SA(0, 0), a2, voffA);
            PG8_BAR; PG8_WAIT_L(0); PG8_MMA(1, 0, At, B0); PG8_BAR; PG8_SCHED;
            PG8_STAGE(PG8_SB(0, 1), b2 + hstepB, voffB);
            PG8_WAIT_V(6); PG8_BAR; PG8_MMA(1, 1, At, B1); PG8_BAR;
            PG8_LDB(B0, 1, 0); PG8_SCHED; PG8_LDA(At, 1, 0); PG8_STAGE(PG8_SA(0, 1), a2 + hstep, voffA);
            PG8_WAIT_L(8); PG8_BAR; PG8_WAIT_L(0); PG8_MMA(0, 0, At, B0); PG8_BAR; PG8_SCHED;
            PG8_LDB(B1, 1, 1); PG8_STAGE(PG8_SB(1, 0), b3, voffB);
            PG8_BAR; PG8_WAIT_L(0); PG8_MMA(0, 1, At, B1); PG8_BAR;
            PG8_LDA(At, 1, 1); PG8_STAGE(PG8_SA(1, 0), a3, voffA);
            PG8_BAR; PG8_WAIT_L(0); PG8_MMA(1, 0, At, B0); PG8_BAR; PG8_SCHED;
            PG8_STAGE(PG8_SB(1, 1), b3 + hstepB, voffB);
            PG8_WAIT_V(6); PG8_BAR; PG8_MMA(1, 1, At, B1); PG8_BAR;
            }
        }
        if constexpr (ALIGN_EPI) { if (wr == 0) PG8_BAR; }
        if constexpr (!Epi::AFTER_DRAIN) { E(acc, cur, wr, wc, fr, fq); S.done(cur); }
        if (!has_next) break;
#pragma unroll
        for (int a = 0; a < 2; ++a)
#pragma unroll
            for (int b = 0; b < 2; ++b)
#pragma unroll
                for (int m = 0; m < 4; ++m)
#pragma unroll
                    for (int n = 0; n < 2; ++n) acc[a][b][m][n] = (f32x4){0.f, 0.f, 0.f, 0.f};
        cur = nxt; cA = nA; cB = nB; ++ui;
        if constexpr (ALIGN_EPI) { if (wr == 1) PG8_BAR; }
    }
    PG8_WAIT_V(0);
    if constexpr (!ALIGN_EPI) { if (wr == 0) PG8_BAR; }
    PG8_BAR;
    if constexpr (Epi::AFTER_DRAIN) { E.fused(acc, cur, wr, wc, fr, fq, lds, wid, lane); S.done(cur); }
#undef PG8_SA
#undef PG8_SB
#undef PG8_STAGE
#undef PG8_LDA
#undef PG8_LDB
#undef PG8_MMA
#undef PG8_WAIT_V
#undef PG8_WAIT_L
#undef PG8_BAR
#undef PG8_SCHED
}
}
constexpr int NWAVES = 8;
constexpr int NB = 8, T = 4096, D = 1024, NTOK = NB * T;
constexpr int DA = 512, DF = 512, NH = 8, HD = 64, GW = 64, ROWS = 64, WH = 8, WW = 16;
constexpr int NPROJ = 2048, NE = 32, DE = 256;
constexpr int MAXROWS = 73728;
constexpr float EPS = 1e-6f, LOG2E = 1.4426950408889634f, QSCALE = 0.125f * LOG2E;
constexpr size_t MiB = 1u << 20;
constexpr size_t WS_CTL = 0, CTL_ZERO_BYTES = 1 * MiB;
constexpr size_t WS_WIN = 2 * MiB, WS_WOUT = 6 * MiB, WS_WGU = 8 * MiB, WS_WD = 40 * MiB, WS_WR = 56 * MiB  , WS_MIXT = 57 * MiB  , WS_DFT1 = WS_MIXT + 256 * 1024  ,
                 WS_T2 = WS_MIXT + 320 * 1024  , WS_TW = WS_MIXT + 384 * 1024  ;
constexpr size_t WS_ROUTE = 58 * MiB;
constexpr size_t WS_META = 59 * MiB;
constexpr size_t WS_XN = 64 * MiB;
constexpr size_t WS_QKVU = 128 * MiB;
constexpr size_t WS_X1 = 256 * MiB;
constexpr size_t WS_MF = 384 * MiB;
constexpr size_t WS_HD = 388 * MiB;
constexpr size_t WS_END = 512 * MiB;
constexpr int CW_BAR = 4096, CW_CNT = 16384;
constexpr int RING_BYTES = 131072, RT_STRIDE = 2064  , RT_BYTES = 72 * RT_STRIDE, LDSCTL_OFF = 149504, LDS_BYTES = 153600;
constexpr int L_MISC = LDSCTL_OFF;
constexpr int L_PBASE = LDSCTL_OFF + 256;
constexpr int L_LCNT = LDSCTL_OFF + 512;
constexpr int L_GBASE = LDSCTL_OFF + 768;
constexpr int L_RT = LDSCTL_OFF + 1024;
static_assert(RT_BYTES <= LDSCTL_OFF && 8 * 16512 <= LDSCTL_OFF && RING_BYTES <= LDSCTL_OFF && L_RT + 4 * 128 * 4 <= LDS_BYTES, "LDS map");

#define LAS __attribute__((address_space(3)))
typedef unsigned short bf16;
typedef unsigned v4u __attribute__((ext_vector_type(4)));
typedef unsigned v2u __attribute__((ext_vector_type(2)));
typedef float f32x4 __attribute__((ext_vector_type(4)));
#define LDS_WAIT() asm volatile("s_waitcnt lgkmcnt(0)" ::: "memory")
#define VM_WAIT() asm volatile("s_waitcnt vmcnt(0)" ::: "memory")
__device__ __forceinline__ unsigned f2bf(float f) { unsigned u = __builtin_bit_cast(unsigned, f); return (u + 0x7fffu + ((u >> 16) & 1u)) >> 16; }
__device__ __forceinline__ unsigned pk2(float lo, float hi) { return f2bf(lo) | (f2bf(hi) << 16); }
typedef float f32x2_t __attribute__((ext_vector_type(2))); typedef __bf16 bf16x2_t __attribute__((ext_vector_type(2)));
__device__ __forceinline__ unsigned cvtpk(float lo, float hi) { f32x2_t v = {lo, hi}; bf16x2_t b = __builtin_convertvector(v, bf16x2_t); return __builtin_bit_cast(unsigned, b); }
__device__ __forceinline__ float bf2f(unsigned short b) { return __builtin_bit_cast(float, (unsigned)b << 16); }
__device__ __forceinline__ float bflo(unsigned w) { return __builtin_bit_cast(float, w << 16); }
__device__ __forceinline__ float bfhi(unsigned w) { return __builtin_bit_cast(float, w & 0xffff0000u); }
__device__ __forceinline__ float wave_sum(float v) {
#pragma unroll
    for (int o = 1; o < 64; o <<= 1) v += __shfl_xor(v, o);
    return v;
}
#define XB_TMO      128
#define XB_XCNT(j)  (256  + 64 * (j))
#define XB_XSUB(j)  (1280 + 64 * (j))
#define XB_XGEN(j)  (2304 + 64 * (j))
#define XB_TOP      3328
#define XB_TOPGEN   3392
#define XCD_BAR_WORDS 3456
#define XB_SPIN_CAP (1u << 18)

__device__ __forceinline__ unsigned xb_ld(unsigned* p)              { return __hip_atomic_load(p, __ATOMIC_RELAXED, __HIP_MEMORY_SCOPE_AGENT); }
__device__ __forceinline__ unsigned xb_add(unsigned* p, unsigned v) { return __hip_atomic_fetch_add(p, v, __ATOMIC_RELAXED, __HIP_MEMORY_SCOPE_AGENT); }
__device__ __forceinline__ unsigned xb_xcc_id() { return (unsigned)__builtin_amdgcn_s_getreg((3 << 11) | 20) & 0xFu; }
#define XB_SPIN(cond, bar) do { unsigned _sp = 0; while (cond) { __builtin_amdgcn_s_sleep(1); \
    if ((++_sp & 255u) == 0u) { if (xb_ld(&(bar)[XB_TMO])) break; if (_sp > XB_SPIN_CAP) { atomicAdd(&(bar)[XB_TMO], 1u); break; } } } } while (0)

struct XcdBarrier {
    unsigned* bar; unsigned x;
    volatile LAS unsigned* st;
};

__device__ __forceinline__ XcdBarrier xcd_barrier_post(unsigned* bar, volatile LAS unsigned* st) {
    XcdBarrier b; b.bar = bar; b.x = xb_xcc_id(); b.st = st;
    if (threadIdx.x == 0) (void)xb_add(&bar[XB_XCNT(b.x)], 1u);
    return b;
}
__device__ __forceinline__ void xcd_barrier_complete(unsigned* bar, unsigned x, unsigned& nloc, unsigned& nx) {
    const unsigned G = gridDim.x * gridDim.y * gridDim.z;
    unsigned sum, cnt, mine, sp = 0u;
    for (;;) {
        sum = 0u; cnt = 0u; mine = 0u;
#pragma unroll
        for (unsigned j = 0; j < 16; ++j) { const unsigned c = xb_ld(&bar[XB_XCNT(j)]); sum += c; cnt += (c > 0u) ? 1u : 0u; mine = (j == x) ? c : mine; }
        if (sum == G) break;
        __builtin_amdgcn_s_sleep(1);
        if ((++sp & 255u) == 0u) { if (xb_ld(&bar[XB_TMO])) break; if (sp > XB_SPIN_CAP) { atomicAdd(&bar[XB_TMO], 1u); break; } }
    }
    nloc = mine > 0u ? mine : 1u; nx = cnt > 0u ? cnt : 1u;
}

__device__ __forceinline__ void xcd_barrier(const XcdBarrier& b) {
    asm volatile("s_waitcnt vmcnt(0)" ::: "memory");
    __syncthreads();
    if (threadIdx.x == 0) {
        unsigned* bar = b.bar;
        __builtin_amdgcn_s_waitcnt(0);
        unsigned nloc = b.st[0], nx = b.st[1];
        if (nloc == 0u) { xcd_barrier_complete(bar, b.x, nloc, nx); b.st[0] = nloc; b.st[1] = nx; }
        const unsigned old = xb_add(&bar[XB_XSUB(b.x)], 1u);
        const unsigned gen = old / nloc;
        if (old + 1u == (gen + 1u) * nloc) {
            __builtin_amdgcn_fence(__ATOMIC_RELEASE, "agent");
            asm volatile("s_waitcnt vmcnt(0)" ::: "memory");
            const unsigned og = xb_add(&bar[XB_TOP], 1u);
            const unsigned tg = og / nx;
            if (og + 1u == (tg + 1u) * nx) xb_add(&bar[XB_TOPGEN], 1u);
            else XB_SPIN(xb_ld(&bar[XB_TOPGEN]) == tg, bar);
            __builtin_amdgcn_fence(__ATOMIC_ACQUIRE, "agent");
            xb_add(&bar[XB_XGEN(b.x)], 1u);
            asm volatile("s_waitcnt vmcnt(0)" ::: "memory");
        } else {
            XB_SPIN(xb_ld(&bar[XB_XGEN(b.x)]) == gen, bar);
            __builtin_amdgcn_fence(__ATOMIC_ACQUIRE, "agent");
            asm volatile("s_waitcnt vmcnt(0)" ::: "memory");
        }
    }
    __syncthreads();
}
struct Args { const float* in[18]; float* out; unsigned char* ws; };
struct Frame {
    LAS unsigned char* lds; unsigned* ctl; unsigned char* ws; float* out;
    int tid, lane, wave, vcu, G;
};
#define GW_ID(F) ((F).vcu * NWAVES + (F).wave)
#define N_GW(F) ((F).G * NWAVES)

__device__ __forceinline__ void tr_item(const float* W, int K, int N, bf16* WT, int drow, const float* kscale, LAS float* scr, int k0, int n0, int lane) {
#pragma unroll 8
    for (int i = 0; i < 32; ++i) { const int kk = 2 * i + (lane >> 5); float v = W[(size_t)(k0 + kk) * N + n0 + (lane & 31)]; if (kscale) v *= kscale[k0 + kk]; scr[kk * 33 + (lane & 31)] = v; }
    LDS_WAIT(); asm volatile("" ::: "memory");
    const int c = lane & 7;
#pragma unroll
    for (int j = 0; j < 4; ++j) { const int n = (lane >> 3) + 8 * j; const LAS float* s = scr + (8 * c) * 33 + n;
        v4u o; o.x = pk2(s[0 * 33], s[1 * 33]); o.y = pk2(s[2 * 33], s[3 * 33]); o.z = pk2(s[4 * 33], s[5 * 33]); o.w = pk2(s[6 * 33], s[7 * 33]);
        *(v4u*)(WT + (size_t)(drow + n) * K + k0 + 8 * c) = o; }
    LDS_WAIT(); asm volatile("" ::: "memory");
}
__device__ __forceinline__ void phase_prep(Frame& F, const Args& A) {
    LAS float* scr = (LAS float*)(F.lds + F.wave * 16384);
    const int gw = GW_ID(F), NGW = N_GW(F), lane = F.lane;
    bf16* WinT = (bf16*)(F.ws + WS_WIN); bf16* WoutT = (bf16*)(F.ws + WS_WOUT); bf16* Wgu = (bf16*)(F.ws + WS_WGU); bf16* Wd = (bf16*)(F.ws + WS_WD);
    constexpr int I_IN = 16 * 64, I_OUT = 16 * 32, I_G = 32 * 128, I_D = 32 * 128, NITEMS = I_IN + I_OUT + 2 * I_G + I_D;
    for (int it = gw; it < NITEMS; it += NGW) {
        int r = it;
        if (r < I_IN) { const int n0 = 32 * (r % 64), seg = n0 >> 9; const int drow = seg == 2 ? n0 + 512 : seg == 3 ? n0 - 512 : n0;
            tr_item(A.in[2], 1024, 2048, WinT, drow, nullptr, scr, 64 * (r / 64), n0, lane); continue; } r -= I_IN;
        if (r < I_OUT) { tr_item(A.in[8], 1024, 1024, WoutT, 32 * (r % 32), nullptr, scr, 64 * (r / 32), 32 * (r % 32), lane); continue; } r -= I_OUT;
        if (r < 2 * I_G) { const int up = r >= I_G ? 1 : 0; r -= up * I_G; const int e = r / 128, q = r % 128, kb = q / 8, n0 = 32 * (q % 8);
            tr_item(A.in[14 + up] + (size_t)e * 1024 * 256, 1024, 256, Wgu, e * 512 + (n0 / 128) * 256 + up * 128 + (n0 % 128), A.in[9], scr, 64 * kb, n0, lane); continue; } r -= 2 * I_G;
        { const int e = r / 128, q = r % 128, kb = q / 32, n0 = 32 * (q % 32);
            tr_item(A.in[16] + (size_t)e * 256 * 1024, 256, 1024, Wd + (size_t)e * 1024 * 256, n0, nullptr, scr, 64 * kb, n0, lane); }
    }
    { const float* g = A.in[1]; bf16* XN = (bf16*)(F.ws + WS_XN);
      f32x4 gv[4];
#pragma unroll
      for (int j = 0; j < 4; ++j) gv[j] = ((const f32x4*)g)[64 * j + lane];
      for (int m = gw; m < NTOK; m += NGW) {
        const f32x4* xr = (const f32x4*)(A.in[0] + (size_t)m * D) + lane; f32x4 v[4]; float s = 0.f;
#pragma unroll
        for (int j = 0; j < 4; ++j) { v[j] = xr[64 * j]; s += (v[j].x * v[j].x + v[j].y * v[j].y) + (v[j].z * v[j].z + v[j].w * v[j].w); }
        const float rstd = 1.0f / sqrtf(wave_sum(s) * (1.f / D) + EPS);
        unsigned long long* o8 = (unsigned long long*)(XN + (size_t)m * D) + lane;
#pragma unroll
        for (int j = 0; j < 4; ++j) { const f32x4 w = v[j] * rstd * gv[j]; o8[64 * j] = (unsigned long long)pk2(w.x, w.y) | ((unsigned long long)pk2(w.z, w.w) << 32); }
      } }
    { bf16* WRH = (bf16*)(F.ws + WS_WR); bf16* WRL = WRH + 36 * 1024; const float* nm = A.in[9];
      for (int i = gw * 64 + lane; i < 36 * 1024; i += NGW * 64) { const int j = i / 1024, k = i % 1024; const float w = nm[k] * (j < 4 ? A.in[10][k * 4 + j] : A.in[12][k * 32 + (j - 4)]);
          const unsigned hi = f2bf(w); WRH[i] = (bf16)hi; WRL[i] = (bf16)f2bf(w - __builtin_bit_cast(float, hi << 16)); } }
    { bf16* DFT1 = (bf16*)(F.ws + WS_DFT1); bf16* T2 = (bf16*)(F.ws + WS_T2); float* TW = (float*)(F.ws + WS_TW); bf16* MIXT = (bf16*)(F.ws + WS_MIXT); const float* wf = A.in[4];
      for (int i = gw * 64 + lane; i < 128 * 64; i += NGW * 64) { const int m = i >> 6, t1 = i & 63; const float ph = (float)(((m & 63) * t1) & 63) * (1.f / 64.f);
          DFT1[i] = (bf16)f2bf(m < 64 ? __builtin_amdgcn_cosf(ph) : -__builtin_amdgcn_sinf(ph)); }
      for (int i = gw * 64 + lane; i < 2 * 64 * 128; i += NGW * 64) { const int part = i >> 13, k2 = (i >> 7) & 63, k = i & 127, t2 = k & 63; const float ph = (float)((k2 * t2) & 63) * (1.f / 64.f);
          const float cs = __builtin_amdgcn_cosf(ph), sn = __builtin_amdgcn_sinf(ph); T2[i] = (bf16)f2bf(part == 0 ? (k < 64 ? cs : sn) : (k < 64 ? -sn : cs)); }
      for (int i = gw * 64 + lane; i < 64 * 64; i += NGW * 64) { const int t2 = i >> 6, k1 = i & 63; const float ph = (float)(t2 * k1) * (1.f / 4096.f); TW[2 * i] = __builtin_amdgcn_cosf(ph); TW[2 * i + 1] = -__builtin_amdgcn_sinf(ph); }
      for (int i = gw * 64 + lane; i < 8 * 64 * 128; i += NGW * 64) { const int grp = i >> 13, d = (i >> 7) & 63, k = i & 127, s = k >> 5, gg = (k >> 3) & 3, jj = k & 7;
          const int c = 32 * (s & 1) + (jj < 4 ? 4 * gg + jj : 16 + 4 * gg + jj - 4); float a = 0.f;
          for (int e = 0; e < 64; ++e) { const float ph = (float)((c * e) & 63) * (1.f / 64.f); a += ((s >> 1) ? __builtin_amdgcn_sinf(ph) : __builtin_amdgcn_cosf(ph)) * wf[(grp * 64 + e) * 64 + d]; }
          MIXT[i] = (bf16)f2bf(a * (1.f / 512.f)); } }
}

__device__ __forceinline__ void phase_attn(Frame& F, const Args& A) {
    typedef short bf16x8 __attribute__((ext_vector_type(8)));
    constexpr int SLOT = 16384, NSLOT = 9, BT_OFF = NSLOT * SLOT;
    static_assert(BT_OFF + 15 * 32 * 4 <= LDSCTL_OFF, "attention LDS map");
    const bf16* Q = (const bf16*)(F.ws + WS_QKVU); const bf16* Kb = Q + (size_t)NTOK * 512; const bf16* VT = Q + (size_t)3 * NTOK * 512;
    float* mf = (float*)F.out;
    const int tid = F.tid, lane = F.lane, q16 = lane & 15, g = lane >> 4, rowsel = F.wave >> 2, j = F.wave & 3;
    const int cb = (j == 0) ? 0 : (j == 1) ? 8 : (j == 2) ? 24 : 32, c = 16 * j + q16, cs = min(max(c - WW / 2, 0), GW - WW);
    unsigned koff[2][2], voff[4], dcoff[2][4];
#pragma unroll
    for (int t = 0; t < 2; ++t) { const int col = cb + 8 * (q16 >> 2) + 4 * t + (q16 & 3), fk = ((col >> 3) & 3) + 4 * ((col >> 1) & 1);
#pragma unroll
        for (int ks = 0; ks < 2; ++ks) koff[t][ks] = (unsigned)(col * 128 + (((4 * ks + g) ^ fk) << 4));
#pragma unroll
        for (int e = 0; e < 4; ++e) { const int kc = cb + 8 * g + 4 * t + e; const bool ok = (kc >= cs) && (kc <= cs + WW - 1); dcoff[t][e] = (unsigned)((ok ? (kc - c + WW - 1) : 31) * 4); } }
#pragma unroll
    for (int dt = 0; dt < 4; ++dt) { const int dh = 16 * dt + q16; voff[dt] = (unsigned)(8192 + dh * 128 + ((((cb >> 3) + g) ^ ((dh >> 1) & 7)) << 4)); }
    const int scol = tid >> 3, sch = tid & 7;
    const unsigned sK = (unsigned)(scol * 128 + ((sch ^ (((scol >> 3) & 3) + 4 * ((scol >> 1) & 1))) << 4)), sV = (unsigned)(8192 + scol * 128 + ((sch ^ ((scol >> 1) & 7)) << 4));
    LAS float* bt = (LAS float*)(F.lds + BT_OFF);
    for (int task = F.vcu; task < NB * NH * 4; task += F.G) {
        const int b = task >> 5, h = (task >> 2) & 7, r0 = 16 * (task & 3);
        __syncthreads();
        if (tid < 15 * 32) { const int dc = tid & 31, dr = tid >> 5; bt[tid] = (dc < 31) ? LOG2E * A.in[3][(h * 15 + dr) * 31 + dc] : -1e30f; }
        const bf16* gK = Kb + ((size_t)b * T + scol) * 512 + h * HD + sch * 8;
        const bf16* gV = VT + (size_t)(h * HD + scol) * NTOK + (size_t)b * T + sch * 8;
        int loaded_hi = min(max(r0 + 1 - WH / 2, 0), ROWS - WH) + WH - 1;
        for (int kr = min(max(r0 - WH / 2, 0), ROWS - WH); kr <= loaded_hi; ++kr) { const v4u kv = *(const v4u*)(gK + (size_t)kr * GW * 512), vv = *(const v4u*)(gV + kr * GW);
            const int so = (kr % NSLOT) * SLOT; *(LAS v4u*)(F.lds + so + sK) = kv; *(LAS v4u*)(F.lds + so + sV) = vv; }
        bf16x8 qn[2];
        { const size_t qtok = (size_t)b * T + (r0 + rowsel) * GW + c;
#pragma unroll
          for (int ks = 0; ks < 2; ++ks) qn[ks] = *(const bf16x8*)(Q + qtok * 512 + h * HD + 32 * ks + 8 * g); }
        __syncthreads();
#pragma unroll 1
        for (int s = 0; s < 8; ++s) {
            const int r = r0 + 2 * s + rowsel, rs = min(max(r - WH / 2, 0), ROWS - WH);
            const size_t qtok = (size_t)b * T + r * GW + c;
            bf16x8 qf[2]; qf[0] = qn[0]; qf[1] = qn[1];
            const int nhi = (s < 7) ? min(max(r0 + 2 * s + 3 - WH / 2, 0), ROWS - WH) + WH - 1 : loaded_hi; const int n_new = nhi - loaded_hi;
            v4u pk0 = {0u, 0u, 0u, 0u}, pv0 = pk0, pk1 = pk0, pv1 = pk0;
            if (n_new >= 1) { pk0 = *(const v4u*)(gK + (size_t)(loaded_hi + 1) * GW * 512); pv0 = *(const v4u*)(gV + (loaded_hi + 1) * GW); }
            if (n_new >= 2) { pk1 = *(const v4u*)(gK + (size_t)(loaded_hi + 2) * GW * 512); pv1 = *(const v4u*)(gV + (loaded_hi + 2) * GW); }
            if (s < 7) { const size_t qt2 = qtok + 2 * GW;
#pragma unroll
                for (int ks = 0; ks < 2; ++ks) qn[ks] = *(const bf16x8*)(Q + qt2 * 512 + h * HD + 32 * ks + 8 * g); }
            const LAS unsigned char* btr = (const LAS unsigned char*)bt + (rs - r + WH - 1) * 128;
            int sl = rs % NSLOT;
            float sc[8][2][4]; float mx = -1e30f;
#pragma unroll
            for (int i = 0; i < 8; ++i) {
                const LAS unsigned char* sb = F.lds + sl * SLOT; sl = (sl + 1 == NSLOT) ? 0 : sl + 1;
#pragma unroll
                for (int t = 0; t < 2; ++t) {
                    f32x4 a = {0.f, 0.f, 0.f, 0.f};
                    a = __builtin_amdgcn_mfma_f32_16x16x32_bf16(*(const LAS bf16x8*)(sb + koff[t][0]), qf[0], a, 0, 0, 0);
                    a = __builtin_amdgcn_mfma_f32_16x16x32_bf16(*(const LAS bf16x8*)(sb + koff[t][1]), qf[1], a, 0, 0, 0);
#pragma unroll
                    for (int e = 0; e < 4; ++e) { const float sv = a[e] + *(const LAS float*)(btr + dcoff[t][e] + i * 128); sc[i][t][e] = sv; mx = fmaxf(mx, sv); }
                }
            }
            mx = fmaxf(mx, __shfl_xor(mx, 16)); mx = fmaxf(mx, __shfl_xor(mx, 32));
            float lsum = 0.f; bf16x8 pf[8];
#pragma unroll
            for (int i = 0; i < 8; ++i) {
                float p[2][4];
#pragma unroll
                for (int t = 0; t < 2; ++t)
#pragma unroll
                    for (int e = 0; e < 4; ++e) { p[t][e] = __builtin_amdgcn_exp2f(sc[i][t][e] - mx); lsum += p[t][e]; }
                v4u w; w.x = cvtpk(p[0][0], p[0][1]); w.y = cvtpk(p[0][2], p[0][3]); w.z = cvtpk(p[1][0], p[1][1]); w.w = cvtpk(p[1][2], p[1][3]);
                pf[i] = __builtin_bit_cast(bf16x8, w);
            }
            lsum += __shfl_xor(lsum, 16); lsum += __shfl_xor(lsum, 32);
            f32x4 o[4];
#pragma unroll
            for (int dt = 0; dt < 4; ++dt) o[dt] = (f32x4){0.f, 0.f, 0.f, 0.f};
            sl = rs % NSLOT;
#pragma unroll
            for (int i = 0; i < 8; ++i) {
                const LAS unsigned char* sb = F.lds + sl * SLOT; sl = (sl + 1 == NSLOT) ? 0 : sl + 1;
#pragma unroll
                for (int dt = 0; dt < 4; ++dt) o[dt] = __builtin_amdgcn_mfma_f32_16x16x32_bf16(*(const LAS bf16x8*)(sb + voff[dt]), pf[i], o[dt], 0, 0, 0);
            }
            const float inv = 1.0f / lsum;
#pragma unroll
            for (int dt = 0; dt < 4; ++dt) *(f32x4*)(mf + qtok * D + h * HD + 16 * dt + 4 * g) = o[dt] * inv;
            __syncthreads();
            if (n_new >= 1) { const int so = ((loaded_hi + 1) % NSLOT) * SLOT; *(LAS v4u*)(F.lds + so + sK) = pk0; *(LAS v4u*)(F.lds + so + sV) = pv0; }
            if (n_new >= 2) { const int so = ((loaded_hi + 2) % NSLOT) * SLOT; *(LAS v4u*)(F.lds + so + sK) = pk1; *(LAS v4u*)(F.lds + so + sV) = pv1; }
            loaded_hi = nhi;
            __syncthreads();
        }
    }
    __syncthreads();
}
__device__ __forceinline__ void phase_fft1(Frame& F, const Args& A) {
    typedef short bf16x8 __attribute__((ext_vector_type(8)));
    const bf16* UT = (const bf16*)(F.ws + WS_QKVU) + (size_t)2 * NTOK * 512; const bf16* DFT1 = (const bf16*)(F.ws + WS_DFT1); const float2* TW = (const float2*)(F.ws + WS_TW);
    bf16* X1T = (bf16*)(F.ws + WS_MF);
    const int lane = F.lane, q16 = lane & 15, g = lane >> 4;
    for (int u = GW_ID(F); u < NB * 8 * 32; u += N_GW(F)) {
        const int ct = u & 31, t2b = (u >> 5) & 7, b = u >> 8, ch = 16 * ct + q16;
        bf16x8 bfr[8][2];
#pragma unroll
        for (int t2 = 0; t2 < 8; ++t2)
#pragma unroll
            for (int ks = 0; ks < 2; ++ks) bfr[t2][ks] = *(const bf16x8*)(UT + (size_t)ch * NTOK + (size_t)b * T + (8 * t2b + t2) * 64 + 32 * ks + 8 * g);
#pragma unroll 1
        for (int kt = 0; kt < 4; ++kt) {
            bf16x8 are[2], aim[2];
#pragma unroll
            for (int ks = 0; ks < 2; ++ks) { are[ks] = *(const bf16x8*)(DFT1 + (16 * kt + q16) * 64 + 32 * ks + 8 * g); aim[ks] = *(const bf16x8*)(DFT1 + (64 + 16 * kt + q16) * 64 + 32 * ks + 8 * g); }
            float xr[8][4], xi[8][4];
#pragma unroll
            for (int t2 = 0; t2 < 8; ++t2) {
                f32x4 ar = {0.f, 0.f, 0.f, 0.f}, ai = {0.f, 0.f, 0.f, 0.f};
                ar = __builtin_amdgcn_mfma_f32_16x16x32_bf16(are[0], bfr[t2][0], ar, 0, 0, 0); ar = __builtin_amdgcn_mfma_f32_16x16x32_bf16(are[1], bfr[t2][1], ar, 0, 0, 0);
                ai = __builtin_amdgcn_mfma_f32_16x16x32_bf16(aim[0], bfr[t2][0], ai, 0, 0, 0); ai = __builtin_amdgcn_mfma_f32_16x16x32_bf16(aim[1], bfr[t2][1], ai, 0, 0, 0);
#pragma unroll
                for (int e = 0; e < 4; ++e) { const float2 w = TW[(8 * t2b + t2) * 64 + 16 * kt + 4 * g + e]; xr[t2][e] = ar[e] * w.x - ai[e] * w.y; xi[t2][e] = ar[e] * w.y + ai[e] * w.x; }
            }
#pragma unroll
            for (int e = 0; e < 4; ++e) { const int k1 = 16 * kt + 4 * g + e;
                v4u wr, wi; wr.x = cvtpk(xr[0][e], xr[1][e]); wr.y = cvtpk(xr[2][e], xr[3][e]); wr.z = cvtpk(xr[4][e], xr[5][e]); wr.w = cvtpk(xr[6][e], xr[7][e]);
                wi.x = cvtpk(xi[0][e], xi[1][e]); wi.y = cvtpk(xi[2][e], xi[3][e]); wi.z = cvtpk(xi[4][e], xi[5][e]); wi.w = cvtpk(xi[6][e], xi[7][e]);
                v4u* dst = (v4u*)(X1T + ((((size_t)(b * 64 + k1) * 8 + t2b) * 512 + ch) << 4)); dst[0] = wr; dst[1] = wi; }
        }
    }
}
__device__ __forceinline__ void phase_fft2(Frame& F, const Args& A) {
    typedef short bf16x8 __attribute__((ext_vector_type(8)));
    const bf16* X1T = (const bf16*)(F.ws + WS_MF); const bf16* T2 = (const bf16*)(F.ws + WS_T2); const bf16* MIXT = (const bf16*)(F.ws + WS_MIXT);
    bf16* mg = (bf16*)(F.ws + WS_X1); const float* bfour = A.in[5]; const float* gfour = A.in[7];
    const int lane = F.lane, q16 = lane & 15, g = lane >> 4;
    LAS unsigned char* slab = F.lds + F.wave * 16512;
    for (int u = GW_ID(F); u < NB * 64 * 4; u += N_GW(F)) {
        const int k2t = u & 3, k1 = (u >> 2) & 63, b = u >> 8;
        bf16x8 wb[2][4];
#pragma unroll
        for (int part = 0; part < 2; ++part)
#pragma unroll
            for (int ks = 0; ks < 4; ++ks) wb[part][ks] = *(const bf16x8*)(T2 + (part * 64 + 16 * k2t + q16) * 128 + 32 * ks + 8 * g);
        float ssq = 0.f;
#pragma unroll 1
        for (int grp = 0; grp < 8; ++grp) {
            f32x4 yr[4], yi[4];
#pragma unroll
            for (int ctile = 0; ctile < 4; ++ctile) {
                const int c = grp * 64 + 16 * ctile + q16; bf16x8 af[4];
#pragma unroll
                for (int ks = 0; ks < 4; ++ks) af[ks] = *(const bf16x8*)(X1T + ((((size_t)(b * 64 + k1) * 8 + 4 * (ks & 1) + g) * 512 + c) << 4) + (ks >> 1) * 8);
                f32x4 r = {0.f, 0.f, 0.f, 0.f}, im = {0.f, 0.f, 0.f, 0.f};
#pragma unroll
                for (int ks = 0; ks < 4; ++ks) { r = __builtin_amdgcn_mfma_f32_16x16x32_bf16(af[ks], wb[0][ks], r, 0, 0, 0); im = __builtin_amdgcn_mfma_f32_16x16x32_bf16(af[ks], wb[1][ks], im, 0, 0, 0); }
                yr[ctile] = r; yi[ctile] = im;
            }
            bf16x8 yb[4];
#pragma unroll
            for (int s = 0; s < 4; ++s) { const f32x4 lo = (s < 2) ? yr[2 * (s & 1)] : yi[2 * (s & 1)], hi = (s < 2) ? yr[2 * (s & 1) + 1] : yi[2 * (s & 1) + 1];
                v4u w; w.x = cvtpk(lo[0], lo[1]); w.y = cvtpk(lo[2], lo[3]); w.z = cvtpk(hi[0], hi[1]); w.w = cvtpk(hi[2], hi[3]); yb[s] = __builtin_bit_cast(bf16x8, w); }
#pragma unroll
            for (int dt = 0; dt < 4; ++dt) {
                f32x4 acc = {0.f, 0.f, 0.f, 0.f};
#pragma unroll
                for (int s = 0; s < 4; ++s) { const bf16x8 ma = *(const bf16x8*)(MIXT + ((size_t)(grp * 64 + 16 * dt + q16) << 7) + 32 * s + 8 * g); acc = __builtin_amdgcn_mfma_f32_16x16x32_bf16(ma, yb[s], acc, 0, 0, 0); }
                const f32x4 bv = *(const f32x4*)(bfour + grp * 64 + 16 * dt + 4 * g); acc += bv;
                ssq += (acc[0] * acc[0] + acc[1] * acc[1]) + (acc[2] * acc[2] + acc[3] * acc[3]);
                v2u w; w.x = cvtpk(acc[0], acc[1]); w.y = cvtpk(acc[2], acc[3]);
                *(LAS v2u*)(slab + q16 * 1032 + (grp * 64 + 16 * dt + 4 * g) * 2) = w;
            }
        }
        ssq += __shfl_xor(ssq, 16); ssq += __shfl_xor(ssq, 32);
        const float rstd = 1.0f / sqrtf(ssq * (1.f / 512.f) + EPS);
        LDS_WAIT(); asm volatile("" ::: "memory");
        const f32x4 g0 = *(const f32x4*)(gfour + lane * 8), g1 = *(const f32x4*)(gfour + lane * 8 + 4);
#pragma unroll 4
        for (int row = 0; row < 16; ++row) {
            const float rs = __shfl(rstd, row);
            const v2u a = *(const LAS v2u*)(slab + row * 1032 + lane * 16), c2 = *(const LAS v2u*)(slab + row * 1032 + lane * 16 + 8);
            v4u o; o.x = cvtpk(bflo(a.x) * rs * g0[0], bfhi(a.x) * rs * g0[1]); o.y = cvtpk(bflo(a.y) * rs * g0[2], bfhi(a.y) * rs * g0[3]);
            o.z = cvtpk(bflo(c2.x) * rs * g1[0], bfhi(c2.x) * rs * g1[1]); o.w = cvtpk(bflo(c2.y) * rs * g1[2], bfhi(c2.y) * rs * g1[3]);
            *(v4u*)(mg + ((size_t)b * T + k1 + 64 * (16 * k2t + row)) * D + DA + lane * 8) = o;
        }
        LDS_WAIT(); asm volatile("" ::: "memory");
    }
}
__device__ __forceinline__ void phase_attn_norm(Frame& F, const Args& A) {
    const float* mf = (const float*)F.out; bf16* mg = (bf16*)(F.ws + WS_X1); const int lane = F.lane;
    const f32x4 g0 = *(const f32x4*)(A.in[6] + lane * 8), g1 = *(const f32x4*)(A.in[6] + lane * 8 + 4);
    for (int tok = GW_ID(F); tok < NTOK; tok += N_GW(F)) {
        const f32x4* src = (const f32x4*)(mf + (size_t)tok * D + lane * 8); const f32x4 a = src[0], c = src[1];
        float s = (a.x * a.x + a.y * a.y) + (a.z * a.z + a.w * a.w) + (c.x * c.x + c.y * c.y) + (c.z * c.z + c.w * c.w);
        const float rstd = 1.0f / sqrtf(wave_sum(s) * (1.f / 512.f) + EPS);
        const f32x4 x = a * rstd * g0, y = c * rstd * g1;
        v4u o; o.x = pk2(x.x, x.y); o.y = pk2(x.z, x.w); o.z = pk2(y.x, y.y); o.w = pk2(y.z, y.w);
        *(v4u*)(mg + (size_t)tok * D + lane * 8) = o;
    }
}
__device__ __forceinline__ void phase_router(Frame& F, const Args& A) {
    typedef short bf16x8 __attribute__((ext_vector_type(8)));
    LAS int* lcnt = (LAS int*)(F.lds + L_LCNT); LAS int* gbase = (LAS int*)(F.lds + L_GBASE); LAS int* rt = (LAS int*)(F.lds + L_RT);
    const bf16* h = (const bf16*)(F.ws + WS_XN);
    int2* e01 = (int2*)(F.ws + WS_ROUTE); int2* rank = e01 + NTOK; float2* wgt = (float2*)(rank + NTOK); float* rstd = (float*)(wgt + NTOK);
    const float* brc = A.in[11]; const float* brf = A.in[13]; const int lane = F.lane, q16 = lane & 15, g = lane >> 4;
    for (int batch = F.vcu; batch < NTOK / 128; batch += F.G) {
        { const v4u* src = (const v4u*)(F.ws + WS_WR); for (int i = F.tid; i < 72 * 128; i += NWAVES * 64) *(LAS v4u*)(F.lds + (i >> 7) * RT_STRIDE + (i & 127) * 16) = src[i]; }
        if (F.tid < 32) lcnt[F.tid] = 0;
        __syncthreads();
        const int tok0 = batch * 128 + F.wave * 16;
        f32x4 acc[3]; float ssq = 0.f;
#pragma unroll
        for (int nt = 0; nt < 3; ++nt) acc[nt] = (f32x4){0.f, 0.f, 0.f, 0.f};
        const bf16* hp = h + (size_t)(tok0 + q16) * D + 8 * g;
        const LAS unsigned char* w0 = F.lds + q16 * RT_STRIDE + 16 * g; const LAS unsigned char* w1 = w0 + 16 * RT_STRIDE; const LAS unsigned char* w2 = F.lds + min(32 + q16, 35) * RT_STRIDE + 16 * g;
#pragma unroll 4
        for (int ks = 0; ks < 32; ++ks) {
            const bf16x8 hf = *(const bf16x8*)(hp + 32 * ks);
#pragma unroll
            for (int i = 0; i < 8; ++i) { const float v = __builtin_bit_cast(float, (unsigned)(unsigned short)hf[i] << 16); ssq += v * v; }
            acc[0] = __builtin_amdgcn_mfma_f32_16x16x32_bf16(*(const LAS bf16x8*)(w0 + 64 * ks), hf, acc[0], 0, 0, 0);
            acc[0] = __builtin_amdgcn_mfma_f32_16x16x32_bf16(*(const LAS bf16x8*)(w0 + 36 * RT_STRIDE + 64 * ks), hf, acc[0], 0, 0, 0);
            acc[1] = __builtin_amdgcn_mfma_f32_16x16x32_bf16(*(const LAS bf16x8*)(w1 + 64 * ks), hf, acc[1], 0, 0, 0);
            acc[1] = __builtin_amdgcn_mfma_f32_16x16x32_bf16(*(const LAS bf16x8*)(w1 + 36 * RT_STRIDE + 64 * ks), hf, acc[1], 0, 0, 0);
            acc[2] = __builtin_amdgcn_mfma_f32_16x16x32_bf16(*(const LAS bf16x8*)(w2 + 64 * ks), hf, acc[2], 0, 0, 0);
            acc[2] = __builtin_amdgcn_mfma_f32_16x16x32_bf16(*(const LAS bf16x8*)(w2 + 36 * RT_STRIDE + 64 * ks), hf, acc[2], 0, 0, 0);
        }
        ssq += __shfl_xor(ssq, 16); ssq += __shfl_xor(ssq, 32);
        __syncthreads();
        LAS float* lg = (LAS float*)F.lds + (F.wave * 16) * 37;
#pragma unroll
        for (int nt = 0; nt < 3; ++nt)
#pragma unroll
            for (int e = 0; e < 4; ++e) { const int j = 16 * nt + 4 * g + e; if (j < 36) lg[q16 * 37 + j] = acc[nt][e]; }
        LDS_WAIT(); asm volatile("" ::: "memory");
        if (lane < 16) {
            const int tl = F.wave * 16 + lane, tok = batch * 128 + tl; const float rs = 1.0f / sqrtf(ssq * (1.f / D) + EPS); const LAS float* L = lg + lane * 37;
            const float c0 = L[0] * rs + brc[0], c1 = L[1] * rs + brc[1], c2 = L[2] * rs + brc[2], c3 = L[3] * rs + brc[3];
            int gi = 0; float mx = c0;
            if (c1 > mx) { mx = c1; gi = 1; }
            if (c2 > mx) { mx = c2; gi = 2; }
            if (c3 > mx) { mx = c3; gi = 3; }
            const float gwt = 1.0f / (expf(c0 - mx) + expf(c1 - mx) + expf(c2 - mx) + expf(c3 - mx));
            float v0 = -1e30f, v1 = -1e30f; int i0 = 0, i1 = 0;
#pragma unroll
            for (int j = 0; j < 8; ++j) { const float fv = L[4 + gi * 8 + j] * rs + brf[gi * 8 + j];
                if (fv > v0) { v1 = v0; i1 = i0; v0 = fv; i0 = j; } else if (fv > v1) { v1 = fv; i1 = j; } }
            const float e1 = expf(v1 - v0), p0 = 1.f / (1.f + e1), p1 = e1 / (1.f + e1);
            const int ea = gi * 8 + i0, eb = gi * 8 + i1;
            const int ra = __hip_atomic_fetch_add(lcnt + ea, 1, __ATOMIC_RELAXED, __HIP_MEMORY_SCOPE_WORKGROUP);
            const int rb = __hip_atomic_fetch_add(lcnt + eb, 1, __ATOMIC_RELAXED, __HIP_MEMORY_SCOPE_WORKGROUP);
            rt[tl] = ea; rt[128 + tl] = eb; rt[256 + tl] = ra; rt[384 + tl] = rb;
            wgt[tok] = make_float2(p0 * gwt, p1 * gwt); rstd[tok] = rs;
        }
        __syncthreads();
        if (F.tid < 32) gbase[F.tid] = (int)__hip_atomic_fetch_add(F.ctl + CW_CNT + 64 * F.tid, (unsigned)lcnt[F.tid], __ATOMIC_RELAXED, __HIP_MEMORY_SCOPE_AGENT);
        __syncthreads();
        if (F.tid < 128) { const int tok = batch * 128 + F.tid, ea = rt[F.tid], eb = rt[128 + F.tid];
            e01[tok] = make_int2(ea, eb); rank[tok] = make_int2(rt[256 + F.tid] + gbase[ea], rt[384 + F.tid] + gbase[eb]); }
        __syncthreads();
    }
}
__device__ __forceinline__ void phase_scatter(Frame& F, const Args& A) {
    LAS int* pbase = (LAS int*)(F.lds + L_PBASE);
    LAS int* lcnt = (LAS int*)(F.lds + L_LCNT);
    if (F.tid < 32) lcnt[F.tid] = (int)__hip_atomic_load(F.ctl + CW_CNT + 64 * F.tid, __ATOMIC_RELAXED, __HIP_MEMORY_SCOPE_AGENT);
    __syncthreads();
    if (F.tid == 0) { int acc = 0; for (int e = 0; e < 32; ++e) { pbase[e] = acc; acc += (lcnt[e] + 255) >> 8; } pbase[32] = acc; }
    __syncthreads();
    float* rstd_s = (float*)(F.ws + WS_META); float* w_s = rstd_s + MAXROWS; int* slotrow_s = (int*)(w_s + MAXROWS);
    for (int e = F.vcu; e < 32; e += F.G) { const int cnt = lcnt[e];
        for (int r = 256 * pbase[e] + cnt + F.tid; r < 256 * pbase[e + 1]; r += NWAVES * 64) { slotrow_s[r] = 2 * NTOK; w_s[r] = 0.f; rstd_s[r] = 0.f; } }
    const bf16* h = (const bf16*)(F.ws + WS_XN); bf16* hs = (bf16*)(F.ws + WS_QKVU);
    const int2* e01 = (const int2*)(F.ws + WS_ROUTE); const int2* rank = e01 + NTOK; const float2* wgt = (const float2*)(rank + NTOK); const float* rstd = (const float*)(wgt + NTOK);
    for (int tok = GW_ID(F); tok < NTOK; tok += N_GW(F)) {
        const int2 e = e01[tok], r = rank[tok]; const float2 w = wgt[tok]; const float rs = rstd[tok];
        const int pos0 = 256 * pbase[e.x] + r.x, pos1 = 256 * pbase[e.y] + r.y;
        const v4u* src = (const v4u*)(h + (size_t)tok * D) + F.lane * 2; const v4u a = src[0], b = src[1];
        v4u* d0 = (v4u*)(hs + (size_t)pos0 * D) + F.lane * 2; d0[0] = a; d0[1] = b;
        v4u* d1 = (v4u*)(hs + (size_t)pos1 * D) + F.lane * 2; d1[0] = a; d1[1] = b;
        if (F.lane == 0) { rstd_s[pos0] = rs; w_s[pos0] = w.x; slotrow_s[pos0] = 2 * tok; rstd_s[pos1] = rs; w_s[pos1] = w.y; slotrow_s[pos1] = 2 * tok + 1; }
    }
}
__device__ __forceinline__ void phase_final(Frame& F, const Args& A) {
    const bf16* h = (const bf16*)(F.ws + WS_XN); const bf16* y2 = (const bf16*)(F.ws + WS_X1); const int lane = F.lane;
    f32x4 gv[4];
#pragma unroll
    for (int j = 0; j < 4; ++j) gv[j] = ((const f32x4*)(A.in[17] + lane * 16))[j];
    for (int tok = GW_ID(F); tok < NTOK; tok += N_GW(F)) {
        const v4u* ph = (const v4u*)(h + (size_t)tok * D) + lane * 2; const v4u* p0 = (const v4u*)(y2 + (size_t)(2 * tok) * D) + lane * 2; const v4u* p1 = (const v4u*)(y2 + (size_t)(2 * tok + 1) * D) + lane * 2;
        f32x4 v[4]; float s = 0.f;
#pragma unroll
        for (int hh = 0; hh < 2; ++hh) { const v4u a = ph[hh], b = p0[hh], c = p1[hh];
            v[2 * hh] = (f32x4){bflo(a.x) + bflo(b.x) + bflo(c.x), bfhi(a.x) + bfhi(b.x) + bfhi(c.x), bflo(a.y) + bflo(b.y) + bflo(c.y), bfhi(a.y) + bfhi(b.y) + bfhi(c.y)};
            v[2 * hh + 1] = (f32x4){bflo(a.z) + bflo(b.z) + bflo(c.z), bfhi(a.z) + bfhi(b.z) + bfhi(c.z), bflo(a.w) + bflo(b.w) + bflo(c.w), bfhi(a.w) + bfhi(b.w) + bfhi(c.w)}; }
#pragma unroll
        for (int j = 0; j < 4; ++j) s += (v[j].x * v[j].x + v[j].y * v[j].y) + (v[j].z * v[j].z + v[j].w * v[j].w);
        const float rstd = 1.0f / sqrtf(wave_sum(s) * (1.f / D) + EPS);
        f32x4* dst = (f32x4*)(F.out + (size_t)tok * D + lane * 16);
#pragma unroll
        for (int j = 0; j < 4; ++j) dst[j] = v[j] * rstd * gv[j];
    }
}
__global__ void __launch_bounds__(NWAVES * 64, 2) mega_fwd(Args args) {
    extern __shared__ __attribute__((aligned(16))) unsigned char lds[];
    Frame F;
    F.lds = (LAS unsigned char*)lds;
    F.tid = threadIdx.x; F.lane = F.tid & 63; F.wave = __builtin_amdgcn_readfirstlane(F.tid >> 6);
    F.G = gridDim.x; { const int bx = blockIdx.x; F.vcu = (F.G % 8 == 0) ? (bx % 8) * (F.G / 8) + bx / 8 : bx; }
    F.ws = args.ws; F.ctl = (unsigned*)(args.ws + WS_CTL); F.out = args.out;
    for (int u = F.tid; u < (LDS_BYTES - LDSCTL_OFF) / 4; u += NWAVES * 64) ((LAS unsigned*)(F.lds + LDSCTL_OFF))[u] = 0u;
    __syncthreads();
    XcdBarrier bar = xcd_barrier_post(F.ctl + CW_BAR, (volatile LAS unsigned*)(F.lds + L_MISC) + 8);
#define GRID_BAR() xcd_barrier(bar)
    PG8_LAS unsigned char* ring = (PG8_LAS unsigned char*)lds;
    const pg8::bf16_t* XN = (const pg8::bf16_t*)(F.ws + WS_XN);

    phase_prep(F, args);
    GRID_BAR();
    {
        pg8::Gemm g{XN, (const pg8::bf16_t*)(F.ws + WS_WIN), NTOK, 1024, D}; pg8::StaticOrder S; S.init(NTOK, 1024, F.G, (int)blockIdx.x);
        pg8::EpiBf16 E{(pg8::bf16_t*)(F.ws + WS_QKVU), 512, 512, (size_t)NTOK * 512, QSCALE};
        pg8::gemm_phase<pg8::EpiBf16, pg8::StaticOrder, true, true>(ring, g, S, E);
    }
    {
        pg8::Gemm g{(const pg8::bf16_t*)(F.ws + WS_WIN) + (size_t)1536 * D, XN, 512, NTOK, D}; pg8::StaticOrder S; S.init(512, NTOK, F.G, (int)blockIdx.x);
        pg8::EpiBf16 E{(pg8::bf16_t*)(F.ws + WS_QKVU) + (size_t)3 * NTOK * 512, NTOK, NTOK, 0, 1.0f};
        pg8::gemm_phase<pg8::EpiBf16, pg8::StaticOrder, true, true>(ring, g, S, E);
    }
    {
        pg8::Gemm g{(const pg8::bf16_t*)(F.ws + WS_WIN) + (size_t)1024 * D, XN, 512, NTOK, D}; pg8::StaticOrder S; S.init(512, NTOK, F.G, (int)blockIdx.x);
        pg8::EpiBf16 E{(pg8::bf16_t*)(F.ws + WS_QKVU) + (size_t)2 * NTOK * 512, NTOK, NTOK, 0, 1.0f};
        pg8::gemm_phase<pg8::EpiBf16, pg8::StaticOrder, true, true, pg8::BGridT>(ring, g, S, E);
    }
    GRID_BAR();
    phase_attn(F, args);
    phase_fft1(F, args);
    GRID_BAR();
    phase_fft2(F, args);
    phase_attn_norm(F, args);
    GRID_BAR();
    {
        pg8::Gemm g{(const pg8::bf16_t*)(F.ws + WS_X1), (const pg8::bf16_t*)(F.ws + WS_WOUT), NTOK, D, D}; pg8::StaticOrder S; S.init(NTOK, D, F.G, (int)blockIdx.x);
        pg8::EpiResH E{args.in[0], (pg8::bf16_t*)(F.ws + WS_XN)};
        pg8::gemm_phase<pg8::EpiResH, pg8::StaticOrder, true, true>(ring, g, S, E);
    }
    GRID_BAR();
    phase_router(F, args);
    GRID_BAR();
    phase_scatter(F, args);
    GRID_BAR();
    {
        pg8::Gemm g{(const pg8::bf16_t*)(F.ws + WS_QKVU), (const pg8::bf16_t*)(F.ws + WS_WGU), MAXROWS, NE * 512, D};
        pg8::MoeOrder S{(const PG8_LAS int*)(ring + L_PBASE), 2, F.G, (int)blockIdx.x};
        const float* rstd_s = (const float*)(F.ws + WS_META);
        pg8::EpiMoe1 E{rstd_s, rstd_s + MAXROWS, (pg8::bf16_t*)(F.ws + WS_HD)};
        pg8::gemm_phase<pg8::EpiMoe1, pg8::MoeOrder, true, true>(ring, g, S, E);
    }
    GRID_BAR();
    {
        pg8::Gemm g{(const pg8::bf16_t*)(F.ws + WS_HD), (const pg8::bf16_t*)(F.ws + WS_WD), MAXROWS, NE * 1024, DE};
        pg8::MoeOrder S{(const PG8_LAS int*)(ring + L_PBASE), 4, F.G, (int)blockIdx.x};
        const int* slotrow_s = (const int*)(F.ws + WS_META) + 2 * MAXROWS;
        pg8::EpiMoe2 E{slotrow_s, (pg8::bf16_t*)(F.ws + WS_X1)};
        pg8::gemm_phase<pg8::EpiMoe2, pg8::MoeOrder, true, true>(ring, g, S, E);
    }
    GRID_BAR();
    phase_final(F, args);
}

extern "C" void kernel_launch(void* const* d_in, const int* in_sizes, int n_in, void* d_out, int out_size, void* d_ws, size_t ws_size, hipStream_t stream) {
    static int grid = 0;
    if (grid == 0) {
        if (n_in != 18 || out_size != NTOK * D || ws_size < WS_END) { fprintf(stderr, "kernel_launch: unexpected problem shape (n_in %d, out %d, ws %zu)\n", n_in, out_size, ws_size); grid = -1; return; }
        int dev = 0, cus = 0;
        if (hipGetDevice(&dev) != hipSuccess || hipDeviceGetAttribute(&cus, hipDeviceAttributeMultiprocessorCount, dev) != hipSuccess) { grid = -1; return; }
        if (hipFuncSetAttribute((const void*)mega_fwd, hipFuncAttributeMaxDynamicSharedMemorySize, LDS_BYTES) != hipSuccess) { fprintf(stderr, "kernel_launch: hipFuncSetAttribute failed\n"); grid = -1; return; }
        int per_cu = 0;
        if (hipOccupancyMaxActiveBlocksPerMultiprocessor(&per_cu, (const void*)mega_fwd, NWAVES * 64, LDS_BYTES) != hipSuccess || per_cu < 1) { fprintf(stderr, "kernel_launch: occupancy query says %d blocks per CU\n", per_cu); }
        (void)hipGetLastError();
        grid = cus;
    }
    if (grid < 0) return;
    (void)hipMemsetAsync((char*)d_ws + WS_CTL, 0, CTL_ZERO_BYTES, stream);
    Args a{};
    for (int i = 0; i < 18; ++i) a.in[i] = (const float*)d_in[i];
    a.out = (float*)d_out; a.ws = (unsigned char*)d_ws;
    hipLaunchKernelGGL(mega_fwd, dim3(grid), dim3(NWAVES * 64), LDS_BYTES, stream, a);
}
```

```cpp
#include <hip/hip_runtime.h>
#include <cstdint>
#include <cstdio>
namespace pg8 {
#define PG8_LAS __attribute__((address_space(3)))
typedef unsigned short bf16_t;
typedef short bf16x8 __attribute__((ext_vector_type(8)));
typedef float f32x4 __attribute__((ext_vector_type(4)));
typedef unsigned u32x4 __attribute__((ext_vector_type(4)));
constexpr int BM = 256, BK = 64, HALF = 128, HTB = HALF * BK * 2  , STAGE_BYTES = 8 * HTB, NXCD = 8, WGM = 8;

__host__ __device__ __forceinline__ int lds_byte(int r, int c) { const int st = (r >> 4) * 2 + (c >> 5), rr = r & 15, cc = c & 31, ob = rr * 64 + cc * 2; return st * 1024 + (ob ^ (((ob >> 9) & 1) << 5)); }
__host__ __device__ __forceinline__ void stage_rc(int b, int& R, int& C) { const int st = b / 1024, sb = b % 1024, swz = sb ^ (((sb >> 9) & 1) << 5); R = (st >> 1) * 16 + swz / 64; C = (st & 1) * 32 + (swz % 64) / 2; }
__host__ __device__ __forceinline__ int perm32(int rho) { const int n = rho >> 4, i = rho & 15; return 8 * (i >> 2) + 4 * n + (i & 3); }

struct Unit { int pm, pn; };
struct Gemm { const bf16_t* A; const bf16_t* Bt; int M, N, K; };

struct StaticOrder {
    int nM, nN, nwg, G, c;
    __host__ __device__ void init(int M, int N, int G_, int c_) { nM = M / BM; nN = N / BM; nwg = nM * nN; G = G_; c = c_; }
    __host__ __device__ bool next(int i, Unit& u) const {
        const long L = (long)i * G + c; if (L >= nwg) return false;
        int wgid = (int)L; { const int q = nwg / NXCD, r = nwg % NXCD, xcd = wgid % NXCD, off = wgid / NXCD; wgid = (xcd < r ? xcd * (q + 1) : r * (q + 1) + (xcd - r) * q) + off; }
        const int nig = WGM * nN, gid = wgid / nig, fm = gid * WGM, gsz = (nM - fm) < WGM ? (nM - fm) : WGM;
        u.pm = fm + ((wgid % nig) % gsz); u.pn = (wgid % nig) / gsz; return true;
    }
    __device__ __forceinline__ void a_ready(const Unit&) const {}
    __device__ __forceinline__ void done(const Unit&) const {}
};

typedef float f32x2c __attribute__((ext_vector_type(2))); typedef __bf16 bf16x2c __attribute__((ext_vector_type(2)));
__device__ __forceinline__ unsigned cvt_pk_bf16(float lo, float hi) { f32x2c v = {lo, hi}; bf16x2c b = __builtin_convertvector(v, bf16x2c); return __builtin_bit_cast(unsigned, b); }
typedef float f32x2 __attribute__((ext_vector_type(2)));
struct EpiBf16 {
    static constexpr bool PERM = true, AFTER_DRAIN = false; static constexpr int MID_TILE = 0;
    bf16_t* O; int ldc; int split_cols; size_t split_stride; float scale0;
    __device__ __forceinline__ void operator()(const f32x4 (&acc)[2][2][4][2], const Unit& u, int wr, int wc, int fr, int fq) const {
        const int row0 = u.pm * BM + wr * 64 + fr; int colt = u.pn * BM; bf16_t* base = O;
        float sc = 1.f; { const int t = colt / split_cols; base += (size_t)t * split_stride; colt -= t * split_cols; if (t == 0) sc = scale0; }
        const int col0 = colt + wc * 32 + 8 * fq;
#pragma unroll
        for (int ai = 0; ai < 2; ++ai)
#pragma unroll
            for (int m = 0; m < 4; ++m) { bf16_t* rowp = base + (size_t)(row0 + ai * HALF + m * 16) * ldc + col0;
#pragma unroll
                for (int bj = 0; bj < 2; ++bj) { f32x4 v0 = acc[ai][bj][m][0] * sc, v1 = acc[ai][bj][m][1] * sc;
                    u32x4 w; w.x = cvt_pk_bf16(v0[0], v0[1]); w.y = cvt_pk_bf16(v0[2], v0[3]); w.z = cvt_pk_bf16(v1[0], v1[1]); w.w = cvt_pk_bf16(v1[2], v1[3]);
                    *(u32x4*)(rowp + bj * HALF) = w; } }
    }
};
struct EpiResH {
    static constexpr bool PERM = true, AFTER_DRAIN = false; static constexpr int MID_TILE = 8;
    const float* x; bf16_t* h; const float* ssq;
    __device__ __forceinline__ void mid(f32x4 (&acc)[2][2][4][2], const Unit& u, int wr, int wc, int fr, int fq) const {
        const int row0 = u.pm * BM + wr * 64 + fr;
#pragma unroll
        for (int ai = 0; ai < 2; ++ai)
#pragma unroll
            for (int m = 0; m < 4; ++m) { const f32x4* p = (const f32x4*)(ssq + (size_t)(row0 + ai * HALF + m * 16) * 8); const f32x4 a = p[0], b = p[1];
                const float s = ((a[0] + a[1]) + (a[2] + a[3])) + ((b[0] + b[1]) + (b[2] + b[3])); const float rs = 1.0f / sqrtf(s * (1.0f / 512.0f) + 1e-6f);
#pragma unroll
                for (int bj = 0; bj < 2; ++bj)
#pragma unroll
                    for (int n = 0; n < 2; ++n) acc[ai][bj][m][n] *= rs; }
    }
    __device__ __forceinline__ void operator()(const f32x4 (&acc)[2][2][4][2], const Unit& u, int wr, int wc, int fr, int fq) const {
        const int row0 = u.pm * BM + wr * 64 + fr, col0 = u.pn * BM + wc * 32 + 8 * fq;
#pragma unroll
        for (int ai = 0; ai < 2; ++ai)
#pragma unroll
            for (int m = 0; m < 4; ++m) { const size_t off = (size_t)(row0 + ai * HALF + m * 16) * 1024 + col0;
#pragma unroll
                for (int bj = 0; bj < 2; ++bj) { const f32x4 xa = *(const f32x4*)(x + off + bj * HALF), xb = *(const f32x4*)(x + off + bj * HALF + 4);
                    const f32x4 v0 = acc[ai][bj][m][0] + xa, v1 = acc[ai][bj][m][1] + xb;
                    u32x4 w; w.x = cvt_pk_bf16(v0[0], v0[1]); w.y = cvt_pk_bf16(v0[2], v0[3]); w.z = cvt_pk_bf16(v1[0], v1[1]); w.w = cvt_pk_bf16(v1[2], v1[3]);
                    *(u32x4*)(h + off + bj * HALF) = w; } }
    }
};
struct EpiMoe1 {
    static constexpr bool PERM = true, AFTER_DRAIN = false; static constexpr int MID_TILE = 0;
    const float* rstd_s; const float* w_s; bf16_t* hd;
    __device__ __forceinline__ void operator()(const f32x4 (&acc)[2][2][4][2], const Unit& u, int wr, int wc, int fr, int fq) const {
        const int row0 = u.pm * BM + wr * 64 + fr, col0 = (u.pn & 1) * HALF + wc * 32 + 8 * fq;
#pragma unroll
        for (int ai = 0; ai < 2; ++ai)
#pragma unroll
            for (int m = 0; m < 4; ++m) { const int row = row0 + ai * HALF + m * 16; const float rs = rstd_s[row], wv = w_s[row];
                float o[8];
#pragma unroll
                for (int n = 0; n < 2; ++n)
#pragma unroll
                    for (int j = 0; j < 4; ++j) { const float g = acc[ai][0][m][n][j] * rs, uu = acc[ai][1][m][n][j] * rs;
                        o[n * 4 + j] = g * __builtin_amdgcn_rcpf(1.0f + __builtin_amdgcn_exp2f(-1.4426950408889634f * g)) * uu * wv; }
                u32x4 w; w.x = cvt_pk_bf16(o[0], o[1]); w.y = cvt_pk_bf16(o[2], o[3]); w.z = cvt_pk_bf16(o[4], o[5]); w.w = cvt_pk_bf16(o[6], o[7]);
                *(u32x4*)(hd + (size_t)row * 256 + col0) = w; }
    }
};
struct EpiMoe2 {
    static constexpr bool PERM = true, AFTER_DRAIN = false; static constexpr int MID_TILE = 0;
    const int* slotrow_s; bf16_t* y2;
    __device__ __forceinline__ void operator()(const f32x4 (&acc)[2][2][4][2], const Unit& u, int wr, int wc, int fr, int fq) const {
        const int row0 = u.pm * BM + wr * 64 + fr, col0 = (u.pn & 3) * BM + wc * 32 + 8 * fq;
#pragma unroll
        for (int ai = 0; ai < 2; ++ai)
#pragma unroll
            for (int m = 0; m < 4; ++m) { const int sr = slotrow_s[row0 + ai * HALF + m * 16];
                bf16_t* rowp = y2 + (size_t)sr * 1024 + col0;
#pragma unroll
                for (int bj = 0; bj < 2; ++bj) { const f32x4 v0 = acc[ai][bj][m][0], v1 = acc[ai][bj][m][1];
                    u32x4 w; w.x = cvt_pk_bf16(v0[0], v0[1]); w.y = cvt_pk_bf16(v0[2], v0[3]); w.z = cvt_pk_bf16(v1[0], v1[1]); w.w = cvt_pk_bf16(v1[2], v1[3]);
                    *(u32x4*)(rowp + bj * HALF) = w; }
                asm volatile("" ::: "memory"); }
    }
};
struct MoeOrder {
    const PG8_LAS int* pbase; int ntn, G, c;
    __device__ __forceinline__ bool next(int i, Unit& u) const {
        const int L = i * G + c; const int total = pbase[32] * ntn; if (L >= total) return false;
        const int pm = L / ntn, pl = L - pm * ntn; int e = 0;
#pragma unroll 1
        for (int j = 1; j < 32; ++j) e += (pbase[j] <= pm) ? 1 : 0;
        u.pm = pm; u.pn = e * ntn + pl; return true;
    }
    __device__ __forceinline__ void a_ready(const Unit&) const {}
    __device__ __forceinline__ void done(const Unit&) const {}
};
struct BNat { static __device__ __forceinline__ int row(int v) { return v; } static __device__ __forceinline__ size_t hstep(int K) { return (size_t)HALF * K * 2; } static __device__ __forceinline__ size_t tile(int pn, int K) { return (size_t)pn * BM * K * 2; } };
struct BGridT { static __device__ __forceinline__ int row(int v) { return (v & 63) * 64 + (v >> 6); } static __device__ __forceinline__ size_t hstep(int K) { return (size_t)2 * K * 2; }
    static __device__ __forceinline__ size_t tile(int pn, int K) { return (size_t)((pn >> 4) * 4096 + (pn & 15) * 4) * K * 2; } };
template <class Epi, class Sched, bool ALIGN_EPI = false, bool SP2 = false, class BMap = BNat>
__device__ __forceinline__ void gemm_phase(PG8_LAS unsigned char* lds, const Gemm g, const Sched& S, const Epi& E) {
    int tid_ = threadIdx.x; asm volatile("" : "+v"(tid_));
    const int tid = tid_, wid = __builtin_amdgcn_readfirstlane(tid >> 6), lane = tid & 63, wr = wid >> 2, wc = wid & 3, fr = lane & 15, fq = lane >> 4;
    const int K = g.K; int nt_ = K / BK; asm volatile("" : "+s"(nt_)); const int nt = nt_;
    unsigned voffA[2], voffB[2];
#pragma unroll
    for (int i = 0; i < 2; ++i) { int R, C; stage_rc(tid * 16 + i * 8192, R, C); const int Rb = Epi::PERM ? ((R & ~31) + perm32(R & 31)) : R;
        voffA[i] = (unsigned)(R * K + C) * 2u; voffB[i] = (unsigned)(BMap::row(Rb) * K + C) * 2u; }
    const size_t kstep = (size_t)(BK * 2);
    const size_t hstep = (size_t)HALF * K * 2;
    const size_t tstep = 2 * hstep; const size_t hstepB = BMap::hstep(K);
    const unsigned ldsw = (unsigned)wid * 1024u;
    const int aoff = lds_byte(wr * 64 + fr, fq * 8), boff = lds_byte(wc * 32 + fr, fq * 8);
#define PG8_SA(b, h) (((b) * 2 + (h)) * HTB)
#define PG8_SB(b, h) ((4 + (b) * 2 + (h)) * HTB)
#define PG8_STAGE(bufoff, gbase, voff) do { _Pragma("unroll") for (int _i = 0; _i < 2; ++_i) \
        __builtin_amdgcn_global_load_lds((const unsigned*)((const char*)(gbase) + (voff)[_i]), (PG8_LAS unsigned*)(lds + (bufoff) + ldsw + _i * 8192), 16, 0, 0); } while (0)
#define PG8_LDA(dst, b, h) do { _Pragma("unroll") for (int m = 0; m < 4; ++m) _Pragma("unroll") for (int k = 0; k < 2; ++k) dst[m][k] = *(const PG8_LAS bf16x8*)(lds + PG8_SA(b, h) + aoff + m * 2048 + k * 1024); } while (0)
#define PG8_LDB(dst, b, h) do { _Pragma("unroll") for (int n = 0; n < 2; ++n) _Pragma("unroll") for (int k = 0; k < 2; ++k) dst[n][k] = *(const PG8_LAS bf16x8*)(lds + PG8_SB(b, h) + boff + n * 2048 + k * 1024); } while (0)
#define PG8_MMA(ai, bj, At, Bt) do { __builtin_amdgcn_s_setprio(1); _Pragma("unroll") for (int m = 0; m < 4; ++m) _Pragma("unroll") for (int n = 0; n < 2; ++n) _Pragma("unroll") for (int k = 0; k < 2; ++k) \
        acc[ai][bj][m][n] = __builtin_amdgcn_mfma_f32_16x16x32_bf16(Bt[n][k], At[m][k], acc[ai][bj][m][n], 0, 0, 0); __builtin_amdgcn_s_setprio(0); } while (0)
#define PG8_WAIT_V(n) asm volatile("s_waitcnt vmcnt(" #n ")" ::: "memory")
#define PG8_WAIT_L(n) asm volatile("s_waitcnt lgkmcnt(" #n ")" ::: "memory")
#define PG8_BAR __builtin_amdgcn_s_barrier()
#define PG8_SCHED __builtin_amdgcn_sched_barrier(0)
    Unit cur, nxt; int ui = 0;
    if (!S.next(0, cur)) return;
    f32x4 acc[2][2][4][2];
#pragma unroll
    for (int a = 0; a < 2; ++a)
#pragma unroll
        for (int b = 0; b < 2; ++b)
#pragma unroll
            for (int m = 0; m < 4; ++m)
#pragma unroll
                for (int n = 0; n < 2; ++n) acc[a][b][m][n] = (f32x4){0.f, 0.f, 0.f, 0.f};
    bf16x8 At[4][2], B0[2][2], B1[2][2];
    const char* cA = (const char*)g.A + (size_t)cur.pm * tstep; const char* cB = (const char*)g.Bt + BMap::tile(cur.pn, K);
    S.a_ready(cur);
    if constexpr (SP2) {
        PG8_STAGE(PG8_SB(0, 0), cB, voffB); PG8_STAGE(PG8_SB(0, 1), cB + hstepB, voffB); PG8_STAGE(PG8_SA(0, 0), cA, voffA); PG8_STAGE(PG8_SA(0, 1), cA + hstep, voffA);
        if (wr == 1) PG8_BAR;
        PG8_WAIT_V(2); PG8_BAR;
        PG8_STAGE(PG8_SB(1, 0), cB + kstep, voffB); PG8_STAGE(PG8_SA(1, 0), cA + kstep, voffA); PG8_STAGE(PG8_SB(1, 1), cB + hstepB + kstep, voffB);
        PG8_WAIT_V(6); PG8_BAR;
    } else {
        PG8_STAGE(PG8_SB(0, 0), cB, voffB); PG8_STAGE(PG8_SA(0, 0), cA, voffA); PG8_STAGE(PG8_SB(0, 1), cB + hstepB, voffB); PG8_STAGE(PG8_SA(0, 1), cA + hstep, voffA);
        if (wr == 1) PG8_BAR;
        PG8_WAIT_V(4); PG8_BAR;
        PG8_STAGE(PG8_SB(1, 0), cB + kstep, voffB); PG8_STAGE(PG8_SA(1, 0), cA + kstep, voffA); PG8_STAGE(PG8_SB(1, 1), cB + hstepB + kstep, voffB);
        PG8_WAIT_V(6); PG8_BAR;
    }
    for (;;) {
        const bool has_next = S.next(ui + 1, nxt);
        const char* nA = has_next ? (const char*)g.A + (size_t)nxt.pm * tstep : cA; const char* nB = has_next ? (const char*)g.Bt + BMap::tile(nxt.pn, K) : cB;
        for (int t = 0; t < nt; t += 2) {
            const bool last = (t == nt - 2);
            const char* a1 = cA + (size_t)(t + 1) * kstep;
            const char* a2 = last ? nA : cA + (size_t)(t + 2) * kstep; const char* b2 = last ? nB : cB + (size_t)(t + 2) * kstep;
            const char* a3 = a2 + kstep; const char* b3 = b2 + kstep;
            if (last && has_next) S.a_ready(nxt);
            if constexpr (SP2) {
            PG8_LDB(B0, 0, 0); PG8_LDB(B1, 0, 1); PG8_SCHED; PG8_LDA(At, 0, 0); PG8_STAGE(PG8_SA(1, 1), a1 + hstep, voffA);
            PG8_WAIT_V(8); PG8_WAIT_L(0); PG8_BAR; PG8_MMA(0, 0, At, B0); PG8_MMA(0, 1, At, B1); PG8_BAR; PG8_SCHED;
            PG8_LDA(At, 0, 1); PG8_STAGE(PG8_SB(0, 0), b2, voffB); PG8_STAGE(PG8_SB(0, 1), b2 + hstepB, voffB); PG8_STAGE(PG8_SA(0, 0), a2, voffA);
            PG8_WAIT_V(8); PG8_WAIT_L(0); PG8_BAR; PG8_MMA(1, 0, At, B0); PG8_MMA(1, 1, At, B1); PG8_BAR; PG8_SCHED;
            PG8_LDB(B0, 1, 0); PG8_LDB(B1, 1, 1); PG8_SCHED; PG8_LDA(At, 1, 0); PG8_STAGE(PG8_SA(0, 1), a2 + hstep, voffA);
            PG8_WAIT_V(8); PG8_WAIT_L(0); PG8_BAR; PG8_MMA(0, 0, At, B0); PG8_MMA(0, 1, At, B1); PG8_BAR; PG8_SCHED;
            PG8_LDA(At, 1, 1); PG8_STAGE(PG8_SB(1, 0), b3, voffB); PG8_STAGE(PG8_SB(1, 1), b3 + hstepB, voffB); PG8_STAGE(PG8_SA(1, 0), a3, voffA);
            PG8_WAIT_V(8); PG8_WAIT_L(0); PG8_BAR; PG8_MMA(1, 0, At, B0); PG8_MMA(1, 1, At, B1); PG8_BAR; PG8_SCHED;
            } else {
            PG8_LDB(B0, 0, 0); PG8_SCHED; PG8_LDA(At, 0, 0); PG8_STAGE(PG8_SA(1, 1), a1 + hstep, voffA);
            PG8_WAIT_L(8); PG8_BAR; PG8_WAIT_L(0); PG8_MMA(0, 0, At, B0); PG8_BAR; PG8_SCHED;
            PG8_LDB(B1, 0, 1); PG8_STAGE(PG8_SB(0, 0), b2, voffB);
            PG8_BAR; PG8_WAIT_L(0); PG8_MMA(0, 1, At, B1); PG8_BAR;
            PG8_LDA(At, 0, 1); PG8_STAGE(PG8_SA(0, 0), a2, voffA);
            PG8_BAR; PG8_WAIT_L(0); PG8_MMA(1, 0, At, B0); PG8_BAR; PG8_SCHED;
            PG8_STAGE(PG8_SB(0, 1), b2 + hstepB, voffB);
            PG8_WAIT_V(6); PG8_BAR; PG8_MMA(1, 1, At, B1); PG8_BAR;
            PG8_LDB(B0, 1, 0); PG8_SCHED; PG8_LDA(At, 1, 0); PG8_STAGE(PG8_SA(0, 1), a2 + hstep, voffA);
            PG8_WAIT_L(8); PG8_BAR; PG8_WAIT_L(0); PG8_MMA(0, 0, At, B0); PG8_BAR; PG8_SCHED;
            PG8_LDB(B1, 1, 1); PG8_STAGE(PG8_SB(1, 0), b3, voffB);
            PG8_BAR; PG8_WAIT_L(0); PG8_MMA(0, 1, At, B1); PG8_BAR;
            PG8_LDA(At, 1, 1); PG8_STAGE(PG8_SA(1, 0), a3, voffA);
            PG8_BAR; PG8_WAIT_L(0); PG8_MMA(1, 0, At, B0); PG8_BAR; PG8_SCHED;
            PG8_STAGE(PG8_SB(1, 1), b3 + hstepB, voffB);
            PG8_WAIT_V(6); PG8_BAR; PG8_MMA(1, 1, At, B1); PG8_BAR;
            }
            if constexpr (Epi::MID_TILE > 0) { if (t + 2 == Epi::MID_TILE) E.mid(acc, cur, wr, wc, fr, fq); }
        }
        if constexpr (ALIGN_EPI) { if (wr == 0) PG8_BAR; }
        if constexpr (!Epi::AFTER_DRAIN) { E(acc, cur, wr, wc, fr, fq); S.done(cur); }
        if (!has_next) break;
#pragma unroll
        for (int a = 0; a < 2; ++a)
#pragma unroll
            for (int b = 0; b < 2; ++b)
#pragma unroll
                for (int m = 0; m < 4; ++m)
#pragma unroll
                    for (int n = 0; n < 2; ++n) acc[a][b][m][n] = (f32x4){0.f, 0.f, 0.f, 0.f};
        cur = nxt; cA = nA; cB = nB; ++ui;
        if constexpr (ALIGN_EPI) { if (wr == 1) PG8_BAR; }
    }
    PG8_WAIT_V(0);
    if constexpr (!ALIGN_EPI) { if (wr == 0) PG8_BAR; }
    PG8_BAR;
    if constexpr (Epi::AFTER_DRAIN) { E.fused(acc, cur, wr, wc, fr, fq, lds, wid, lane); S.done(cur); }
#undef PG8_SA
#undef PG8_SB
#undef PG8_STAGE
#undef PG8_LDA
#undef PG8_LDB
#undef PG8_MMA
#undef PG8_WAIT_V
#undef PG8_WAIT_L
#undef PG8_BAR
#undef PG8_SCHED
}
}
constexpr int NWAVES = 8;
constexpr int NB = 8, T = 4096, D = 1024, NTOK = NB * T;
constexpr int DA = 512, DF = 512, NH = 8, HD = 64, GW = 64, ROWS = 64, WH = 8, WW = 16;
constexpr int NPROJ = 2048, NE = 32, DE = 256;
constexpr int MAXROWS = 73728;
constexpr float EPS = 1e-6f, LOG2E = 1.4426950408889634f, QSCALE = 0.125f * LOG2E;
constexpr size_t MiB = 1u << 20;
constexpr size_t WS_CTL = 0, CTL_ZERO_BYTES = 1 * MiB;
constexpr size_t WS_WIN = 2 * MiB, WS_WOUT = 6 * MiB, WS_WGU = 8 * MiB, WS_WD = 40 * MiB, WS_WR = 56 * MiB  , WS_MIXT = 57 * MiB  , WS_DFT1 = WS_MIXT + 256 * 1024  ,
                 WS_T2 = WS_MIXT + 320 * 1024  , WS_TW = WS_MIXT + 384 * 1024  ;
constexpr size_t WS_ROUTE = 58 * MiB;
constexpr size_t WS_SSQ = 60 * MiB;
constexpr size_t WS_META = 59 * MiB;
constexpr size_t WS_XN = 64 * MiB;
constexpr size_t WS_QKVU = 128 * MiB;
constexpr size_t WS_X1 = 256 * MiB;
constexpr size_t WS_MF = 384 * MiB;
constexpr size_t WS_HD = 388 * MiB;
constexpr size_t WS_END = 512 * MiB;
constexpr int CW_BAR = 4096, CW_CNT = 16384;
constexpr int RING_BYTES = 131072, RT_STRIDE = 2064  , RT_BYTES = 72 * RT_STRIDE, LDSCTL_OFF = 149504, LDS_BYTES = 153600;
constexpr int L_MISC = LDSCTL_OFF;
constexpr int L_PBASE = LDSCTL_OFF + 256;
constexpr int L_LCNT = LDSCTL_OFF + 512;
constexpr int L_GBASE = LDSCTL_OFF + 768;
constexpr int L_RT = LDSCTL_OFF + 1024;
static_assert(RT_BYTES <= LDSCTL_OFF && 8 * 16512 <= LDSCTL_OFF && RING_BYTES <= LDSCTL_OFF && L_RT + 4 * 128 * 4 <= LDS_BYTES, "LDS map");

#define LAS __attribute__((address_space(3)))
typedef unsigned short bf16;
typedef unsigned v4u __attribute__((ext_vector_type(4)));
typedef unsigned v2u __attribute__((ext_vector_type(2)));
typedef float f32x4 __attribute__((ext_vector_type(4)));
#define LDS_WAIT() asm volatile("s_waitcnt lgkmcnt(0)" ::: "memory")
#define VM_WAIT() asm volatile("s_waitcnt vmcnt(0)" ::: "memory")
__device__ __forceinline__ unsigned f2bf(float f) { unsigned u = __builtin_bit_cast(unsigned, f); return (u + 0x7fffu + ((u >> 16) & 1u)) >> 16; }
__device__ __forceinline__ unsigned pk2(float lo, float hi) { return f2bf(lo) | (f2bf(hi) << 16); }
typedef float f32x2_t __attribute__((ext_vector_type(2))); typedef __bf16 bf16x2_t __attribute__((ext_vector_type(2)));
__device__ __forceinline__ unsigned cvtpk(float lo, float hi) { f32x2_t v = {lo, hi}; bf16x2_t b = __builtin_convertvector(v, bf16x2_t); return __builtin_bit_cast(unsigned, b); }
__device__ __forceinline__ float bf2f(unsigned short b) { return __builtin_bit_cast(float, (unsigned)b << 16); }
__device__ __forceinline__ float bflo(unsigned w) { return __builtin_bit_cast(float, w << 16); }
__device__ __forceinline__ float bfhi(unsigned w) { return __builtin_bit_cast(float, w & 0xffff0000u); }
__device__ __forceinline__ float wave_sum(float v) {
#pragma unroll
    for (int o = 1; o < 64; o <<= 1) v += __shfl_xor(v, o);
    return v;
}
#define XB_TMO      128
#define XB_XCNT(j)  (256  + 64 * (j))
#define XB_XSUB(j)  (1280 + 64 * (j))
#define XB_XGEN(j)  (2304 + 64 * (j))
#define XB_TOP      3328
#define XB_TOPGEN   3392
#define XCD_BAR_WORDS 3456
#define XB_SPIN_CAP (1u << 18)

__device__ __forceinline__ unsigned xb_ld(unsigned* p)              { return __hip_atomic_load(p, __ATOMIC_RELAXED, __HIP_MEMORY_SCOPE_AGENT); }
__device__ __forceinline__ unsigned xb_add(unsigned* p, unsigned v) { return __hip_atomic_fetch_add(p, v, __ATOMIC_RELAXED, __HIP_MEMORY_SCOPE_AGENT); }
__device__ __forceinline__ unsigned xb_xcc_id() { return (unsigned)__builtin_amdgcn_s_getreg((3 << 11) | 20) & 0xFu; }
#define XB_SPIN(cond, bar) do { unsigned _sp = 0; while (cond) { __builtin_amdgcn_s_sleep(1); \
    if ((++_sp & 255u) == 0u) { if (xb_ld(&(bar)[XB_TMO])) break; if (_sp > XB_SPIN_CAP) { atomicAdd(&(bar)[XB_TMO], 1u); break; } } } } while (0)

struct XcdBarrier {
    unsigned* bar; unsigned x;
    volatile LAS unsigned* st;
};

__device__ __forceinline__ XcdBarrier xcd_barrier_post(unsigned* bar, volatile LAS unsigned* st) {
    XcdBarrier b; b.bar = bar; b.x = xb_xcc_id(); b.st = st;
    if (threadIdx.x == 0) (void)xb_add(&bar[XB_XCNT(b.x)], 1u);
    return b;
}
__device__ __forceinline__ void xcd_barrier_complete(unsigned* bar, unsigned x, unsigned& nloc, unsigned& nx) {
    const unsigned G = gridDim.x * gridDim.y * gridDim.z;
    unsigned sum, cnt, mine, sp = 0u;
    for (;;) {
        sum = 0u; cnt = 0u; mine = 0u;
#pragma unroll
        for (unsigned j = 0; j < 16; ++j) { const unsigned c = xb_ld(&bar[XB_XCNT(j)]); sum += c; cnt += (c > 0u) ? 1u : 0u; mine = (j == x) ? c : mine; }
        if (sum == G) break;
        __builtin_amdgcn_s_sleep(1);
        if ((++sp & 255u) == 0u) { if (xb_ld(&bar[XB_TMO])) break; if (sp > XB_SPIN_CAP) { atomicAdd(&bar[XB_TMO], 1u); break; } }
    }
    nloc = mine > 0u ? mine : 1u; nx = cnt > 0u ? cnt : 1u;
}

__device__ __forceinline__ void xcd_barrier(const XcdBarrier& b) {
    asm volatile("s_waitcnt vmcnt(0)" ::: "memory");
    __syncthreads();
    if (threadIdx.x == 0) {
        unsigned* bar = b.bar;
        __builtin_amdgcn_s_waitcnt(0);
        unsigned nloc = b.st[0], nx = b.st[1];
        if (nloc == 0u) { xcd_barrier_complete(bar, b.x, nloc, nx); b.st[0] = nloc; b.st[1] = nx; }
        const unsigned old = xb_add(&bar[XB_XSUB(b.x)], 1u);
        const unsigned gen = old / nloc;
        if (old + 1u == (gen + 1u) * nloc) {
            __builtin_amdgcn_fence(__ATOMIC_RELEASE, "agent");
            asm volatile("s_waitcnt vmcnt(0)" ::: "memory");
            const unsigned og = xb_add(&bar[XB_TOP], 1u);
            const unsigned tg = og / nx;
            if (og + 1u == (tg + 1u) * nx) xb_add(&bar[XB_TOPGEN], 1u);
            else XB_SPIN(xb_ld(&bar[XB_TOPGEN]) == tg, bar);
            __builtin_amdgcn_fence(__ATOMIC_ACQUIRE, "agent");
            xb_add(&bar[XB_XGEN(b.x)], 1u);
            asm volatile("s_waitcnt vmcnt(0)" ::: "memory");
        } else {
            XB_SPIN(xb_ld(&bar[XB_XGEN(b.x)]) == gen, bar);
            __builtin_amdgcn_fence(__ATOMIC_ACQUIRE, "agent");
            asm volatile("s_waitcnt vmcnt(0)" ::: "memory");
        }
    }
    __syncthreads();
}
struct Args { const float* in[18]; float* out; unsigned char* ws; };
struct Frame {
    LAS unsigned char* lds; unsigned* ctl; unsigned char* ws; float* out;
    int tid, lane, wave, vcu, G;
};
#define GW_ID(F) ((F).vcu * NWAVES + (F).wave)
#define N_GW(F) ((F).G * NWAVES)

__device__ __forceinline__ void tr_item(const float* W, int K, int N, bf16* WT, int drow, const float* kscale, LAS float* scr, int k0, int n0, int lane) {
    float v[32];
#pragma unroll
    for (int i = 0; i < 32; ++i) v[i] = W[(size_t)(k0 + 2 * i + (lane >> 5)) * N + n0 + (lane & 31)];
    if (kscale) {
#pragma unroll
        for (int i = 0; i < 32; ++i) v[i] *= kscale[k0 + 2 * i + (lane >> 5)];
    }
#pragma unroll
    for (int i = 0; i < 32; ++i) scr[(2 * i + (lane >> 5)) * 33 + (lane & 31)] = v[i];
    LDS_WAIT(); asm volatile("" ::: "memory");
    const int c = lane & 7;
#pragma unroll
    for (int j = 0; j < 4; ++j) { const int n = (lane >> 3) + 8 * j; const LAS float* s = scr + (8 * c) * 33 + n;
        v4u o; o.x = pk2(s[0 * 33], s[1 * 33]); o.y = pk2(s[2 * 33], s[3 * 33]); o.z = pk2(s[4 * 33], s[5 * 33]); o.w = pk2(s[6 * 33], s[7 * 33]);
        *(v4u*)(WT + (size_t)(drow + n) * K + k0 + 8 * c) = o; }
    LDS_WAIT(); asm volatile("" ::: "memory");
}
__device__ __forceinline__ void phase_prep(Frame& F, const Args& A) {
    LAS float* scr = (LAS float*)(F.lds + F.wave * 16384);
    const int gw = GW_ID(F), NGW = N_GW(F), lane = F.lane;
    bf16* WinT = (bf16*)(F.ws + WS_WIN); bf16* WoutT = (bf16*)(F.ws + WS_WOUT); bf16* Wgu = (bf16*)(F.ws + WS_WGU); bf16* Wd = (bf16*)(F.ws + WS_WD);
    constexpr int I_IN = 16 * 64, I_OUT = 16 * 32, I_G = 32 * 128, I_D = 32 * 128, NITEMS = I_IN + I_OUT + 2 * I_G + I_D;
    for (int it = gw; it < NITEMS; it += NGW) {
        int r = it;
        if (r < I_IN) { const int n0 = 32 * (r % 64), seg = n0 >> 9; const int drow = seg == 2 ? n0 + 512 : seg == 3 ? n0 - 512 : n0;
            tr_item(A.in[2], 1024, 2048, WinT, drow, nullptr, scr, 64 * (r / 64), n0, lane); continue; } r -= I_IN;
        if (r < I_OUT) { tr_item(A.in[8], 1024, 1024, WoutT, 32 * (r % 32), (r / 32) < 8 ? A.in[6] : nullptr, scr, 64 * (r / 32), 32 * (r % 32), lane); continue; } r -= I_OUT;
        if (r < 2 * I_G) { const int up = r >= I_G ? 1 : 0; r -= up * I_G; const int e = r / 128, q = r % 128, kb = q / 8, n0 = 32 * (q % 8);
            tr_item(A.in[14 + up] + (size_t)e * 1024 * 256, 1024, 256, Wgu, e * 512 + (n0 / 128) * 256 + up * 128 + (n0 % 128), A.in[9], scr, 64 * kb, n0, lane); continue; } r -= 2 * I_G;
        { const int e = r / 128, q = r % 128, kb = q / 32, n0 = 32 * (q % 32);
            tr_item(A.in[16] + (size_t)e * 256 * 1024, 256, 1024, Wd + (size_t)e * 1024 * 256, n0, nullptr, scr, 64 * kb, n0, lane); }
    }
    { const float* g = A.in[1]; bf16* XN = (bf16*)(F.ws + WS_XN);
      f32x4 gv[4];
#pragma unroll
      for (int j = 0; j < 4; ++j) gv[j] = ((const f32x4*)g)[64 * j + lane];
      for (int m = gw; m < NTOK; m += 2 * NGW) {
        const int m2 = m + NGW;
        const f32x4* xr = (const f32x4*)(A.in[0] + (size_t)m * D) + lane; const f32x4* xr2 = (const f32x4*)(A.in[0] + (size_t)(m2 < NTOK ? m2 : m) * D) + lane; f32x4 v[4], w2[4]; float s = 0.f, s2 = 0.f;
#pragma unroll
        for (int j = 0; j < 4; ++j) { v[j] = xr[64 * j]; w2[j] = xr2[64 * j]; }
#pragma unroll
        for (int j = 0; j < 4; ++j) { s += (v[j].x * v[j].x + v[j].y * v[j].y) + (v[j].z * v[j].z + v[j].w * v[j].w); s2 += (w2[j].x * w2[j].x + w2[j].y * w2[j].y) + (w2[j].z * w2[j].z + w2[j].w * w2[j].w); }
        const float rstd = 1.0f / sqrtf(wave_sum(s) * (1.f / D) + EPS), rstd2 = 1.0f / sqrtf(wave_sum(s2) * (1.f / D) + EPS);
        unsigned long long* o8 = (unsigned long long*)(XN + (size_t)m * D) + lane;
#pragma unroll
        for (int j = 0; j < 4; ++j) { const f32x4 w = v[j] * rstd * gv[j]; o8[64 * j] = (unsigned long long)pk2(w.x, w.y) | ((unsigned long long)pk2(w.z, w.w) << 32); }
        if (m2 < NTOK) { unsigned long long* p8 = (unsigned long long*)(XN + (size_t)m2 * D) + lane;
#pragma unroll
            for (int j = 0; j < 4; ++j) { const f32x4 w = w2[j] * rstd2 * gv[j]; p8[64 * j] = (unsigned long long)pk2(w.x, w.y) | ((unsigned long long)pk2(w.z, w.w) << 32); } }
      } }
    { bf16* WRH = (bf16*)(F.ws + WS_WR); bf16* WRL = WRH + 36 * 1024; const float* nm = A.in[9];
      for (int i = gw * 64 + lane; i < 36 * 1024; i += NGW * 64) { const int j = i / 1024, k = i % 1024; const float w = nm[k] * (j < 4 ? A.in[10][k * 4 + j] : A.in[12][k * 32 + (j - 4)]);
          const unsigned hi = f2bf(w); WRH[i] = (bf16)hi; WRL[i] = (bf16)f2bf(w - __builtin_bit_cast(float, hi << 16)); } }
    { bf16* DFT1 = (bf16*)(F.ws + WS_DFT1); bf16* T2 = (bf16*)(F.ws + WS_T2); float* TW = (float*)(F.ws + WS_TW); bf16* MIXT = (bf16*)(F.ws + WS_MIXT); const float* wf = A.in[4];
      for (int i = gw * 64 + lane; i < 128 * 64; i += NGW * 64) { const int m = i >> 6, t1 = i & 63; const float ph = (float)(((m & 63) * t1) & 63) * (1.f / 64.f);
          DFT1[i] = (bf16)f2bf(m < 64 ? __builtin_amdgcn_cosf(ph) : -__builtin_amdgcn_sinf(ph)); }
      for (int i = gw * 64 + lane; i < 2 * 64 * 128; i += NGW * 64) { const int part = i >> 13, k2 = (i >> 7) & 63, k = i & 127, t2 = k & 63; const float ph = (float)((k2 * t2) & 63) * (1.f / 64.f);
          const float cs = __builtin_amdgcn_cosf(ph), sn = __builtin_amdgcn_sinf(ph); T2[i] = (bf16)f2bf(part == 0 ? (k < 64 ? cs : sn) : (k < 64 ? -sn : cs)); }
      for (int i = gw * 64 + lane; i < 64 * 64; i += NGW * 64) { const int t2 = i >> 6, k1 = i & 63; const float ph = (float)(t2 * k1) * (1.f / 4096.f); TW[2 * i] = __builtin_amdgcn_cosf(ph); TW[2 * i + 1] = -__builtin_amdgcn_sinf(ph); }
      for (int i = gw * 64 + lane; i < 8 * 64 * 128; i += NGW * 64) { const int grp = i >> 13, d = (i >> 7) & 63, k = i & 127, s = k >> 5, gg = (k >> 3) & 3, jj = k & 7;
          const int c = 32 * (s & 1) + (jj < 4 ? 4 * gg + jj : 16 + 4 * gg + jj - 4); float a = 0.f;
          for (int e = 0; e < 64; ++e) { const float ph = (float)((c * e) & 63) * (1.f / 64.f); a += ((s >> 1) ? __builtin_amdgcn_sinf(ph) : __builtin_amdgcn_cosf(ph)) * wf[(grp * 64 + e) * 64 + d]; }
          MIXT[i] = (bf16)f2bf(a * (1.f / 512.f)); } }
}

__device__ __forceinline__ void phase_attn(Frame& F, const Args& A) {
    typedef short bf16x8 __attribute__((ext_vector_type(8)));
    constexpr int SLOT = 16384, NSLOT = 9, BT_OFF = NSLOT * SLOT;
    static_assert(BT_OFF + 15 * 32 * 4 <= LDSCTL_OFF, "attention LDS map");
    const bf16* Q = (const bf16*)(F.ws + WS_QKVU); const bf16* Kb = Q + (size_t)NTOK * 512; const bf16* VT = Q + (size_t)3 * NTOK * 512;
    bf16* mg = (bf16*)(F.ws + WS_X1); float* ssq = (float*)(F.ws + WS_SSQ);
    const int tid = F.tid, lane = F.lane, q16 = lane & 15, g = lane >> 4, rowsel = F.wave >> 2, j = F.wave & 3;
    const int cb = (j == 0) ? 0 : (j == 1) ? 8 : (j == 2) ? 24 : 32, c = 16 * j + q16, cs = min(max(c - WW / 2, 0), GW - WW);
    unsigned koff[2][2], voff[4], dcoff[2][4];
#pragma unroll
    for (int t = 0; t < 2; ++t) { const int col = cb + 8 * (q16 >> 2) + 4 * t + (q16 & 3), fk = ((col >> 3) & 3) + 4 * ((col >> 1) & 1);
#pragma unroll
        for (int ks = 0; ks < 2; ++ks) koff[t][ks] = (unsigned)(col * 128 + (((4 * ks + g) ^ fk) << 4));
#pragma unroll
        for (int e = 0; e < 4; ++e) { const int kc = cb + 8 * g + 4 * t + e; const bool ok = (kc >= cs) && (kc <= cs + WW - 1); dcoff[t][e] = (unsigned)((ok ? (kc - c + WW - 1) : 31) * 4); } }
#pragma unroll
    for (int dt = 0; dt < 4; ++dt) { const int dh = 16 * dt + q16; voff[dt] = (unsigned)(8192 + dh * 128 + ((((cb >> 3) + g) ^ ((dh >> 1) & 7)) << 4)); }
    const int scol = tid >> 3, sch = tid & 7;
    const unsigned sK = (unsigned)(scol * 128 + ((sch ^ (((scol >> 3) & 3) + 4 * ((scol >> 1) & 1))) << 4)), sV = (unsigned)(8192 + scol * 128 + ((sch ^ ((scol >> 1) & 7)) << 4));
    LAS float* bt = (LAS float*)(F.lds + BT_OFF);
    for (int task = F.vcu; task < NB * NH * 4; task += F.G) {
        const int b = task >> 5, h = (task >> 2) & 7, r0 = 16 * (task & 3);
        __syncthreads();
        if (tid < 15 * 32) { const int dc = tid & 31, dr = tid >> 5; bt[tid] = (dc < 31) ? LOG2E * A.in[3][(h * 15 + dr) * 31 + dc] : -1e30f; }
        const bf16* gK = Kb + ((size_t)b * T + scol) * 512 + h * HD + sch * 8;
        const bf16* gV = VT + (size_t)(h * HD + scol) * NTOK + (size_t)b * T + sch * 8;
        int loaded_hi = min(max(r0 + 1 - WH / 2, 0), ROWS - WH) + WH - 1;
        for (int kr = min(max(r0 - WH / 2, 0), ROWS - WH); kr <= loaded_hi; ++kr) { const v4u kv = *(const v4u*)(gK + (size_t)kr * GW * 512), vv = *(const v4u*)(gV + kr * GW);
            const int so = (kr % NSLOT) * SLOT; *(LAS v4u*)(F.lds + so + sK) = kv; *(LAS v4u*)(F.lds + so + sV) = vv; }
        bf16x8 qn[2];
        { const size_t qtok = (size_t)b * T + (r0 + rowsel) * GW + c;
#pragma unroll
          for (int ks = 0; ks < 2; ++ks) qn[ks] = *(const bf16x8*)(Q + qtok * 512 + h * HD + 32 * ks + 8 * g); }
        __syncthreads();
#pragma unroll 1
        for (int s = 0; s < 8; ++s) {
            const int r = r0 + 2 * s + rowsel, rs = min(max(r - WH / 2, 0), ROWS - WH);
            const size_t qtok = (size_t)b * T + r * GW + c;
            bf16x8 qf[2]; qf[0] = qn[0]; qf[1] = qn[1];
            const int nhi = (s < 7) ? min(max(r0 + 2 * s + 3 - WH / 2, 0), ROWS - WH) + WH - 1 : loaded_hi; const int n_new = nhi - loaded_hi;
            v4u pk0 = {0u, 0u, 0u, 0u}, pv0 = pk0, pk1 = pk0, pv1 = pk0;
            if (n_new >= 1) { pk0 = *(const v4u*)(gK + (size_t)(loaded_hi + 1) * GW * 512); pv0 = *(const v4u*)(gV + (loaded_hi + 1) * GW); }
            if (n_new >= 2) { pk1 = *(const v4u*)(gK + (size_t)(loaded_hi + 2) * GW * 512); pv1 = *(const v4u*)(gV + (loaded_hi + 2) * GW); }
            if (s < 7) { const size_t qt2 = qtok + 2 * GW;
#pragma unroll
                for (int ks = 0; ks < 2; ++ks) qn[ks] = *(const bf16x8*)(Q + qt2 * 512 + h * HD + 32 * ks + 8 * g); }
            const LAS unsigned char* btr = (const LAS unsigned char*)bt + (rs - r + WH - 1) * 128;
            int sl = rs % NSLOT;
            float sc[8][2][4]; float mx = -1e30f;
#pragma unroll
            for (int i = 0; i < 8; ++i) {
                const LAS unsigned char* sb = F.lds + sl * SLOT; sl = (sl + 1 == NSLOT) ? 0 : sl + 1;
#pragma unroll
                for (int t = 0; t < 2; ++t) {
                    f32x4 a = {0.f, 0.f, 0.f, 0.f};
                    a = __builtin_amdgcn_mfma_f32_16x16x32_bf16(*(const LAS bf16x8*)(sb + koff[t][0]), qf[0], a, 0, 0, 0);
                    a = __builtin_amdgcn_mfma_f32_16x16x32_bf16(*(const LAS bf16x8*)(sb + koff[t][1]), qf[1], a, 0, 0, 0);
#pragma unroll
                    for (int e = 0; e < 4; ++e) { const float sv = a[e] + *(const LAS float*)(btr + dcoff[t][e] + i * 128); sc[i][t][e] = sv; mx = fmaxf(mx, sv); }
                }
            }
            mx = fmaxf(mx, __shfl_xor(mx, 16)); mx = fmaxf(mx, __shfl_xor(mx, 32));
            float lsum = 0.f; bf16x8 pf[8];
#pragma unroll
            for (int i = 0; i < 8; ++i) {
                float p[2][4];
#pragma unroll
                for (int t = 0; t < 2; ++t)
#pragma unroll
                    for (int e = 0; e < 4; ++e) { p[t][e] = __builtin_amdgcn_exp2f(sc[i][t][e] - mx); lsum += p[t][e]; }
                v4u w; w.x = cvtpk(p[0][0], p[0][1]); w.y = cvtpk(p[0][2], p[0][3]); w.z = cvtpk(p[1][0], p[1][1]); w.w = cvtpk(p[1][2], p[1][3]);
                pf[i] = __builtin_bit_cast(bf16x8, w);
            }
            lsum += __shfl_xor(lsum, 16); lsum += __shfl_xor(lsum, 32);
            f32x4 o[4];
#pragma unroll
            for (int dt = 0; dt < 4; ++dt) o[dt] = (f32x4){0.f, 0.f, 0.f, 0.f};
            sl = rs % NSLOT;
#pragma unroll
            for (int i = 0; i < 8; ++i) {
                const LAS unsigned char* sb = F.lds + sl * SLOT; sl = (sl + 1 == NSLOT) ? 0 : sl + 1;
#pragma unroll
                for (int dt = 0; dt < 4; ++dt) o[dt] = __builtin_amdgcn_mfma_f32_16x16x32_bf16(*(const LAS bf16x8*)(sb + voff[dt]), pf[i], o[dt], 0, 0, 0);
            }
            const float inv = 1.0f / lsum; float sq = 0.f;
#pragma unroll
            for (int dt = 0; dt < 4; ++dt) { const f32x4 v = o[dt] * inv; sq += (v[0] * v[0] + v[1] * v[1]) + (v[2] * v[2] + v[3] * v[3]);
                v2u w; w.x = cvtpk(v[0], v[1]); w.y = cvtpk(v[2], v[3]); *(v2u*)(mg + qtok * D + h * HD + 16 * dt + 4 * g) = w; }
            sq += __shfl_xor(sq, 16); sq += __shfl_xor(sq, 32);
            if (g == 0) ssq[qtok * 8 + h] = sq;
            __syncthreads();
            if (n_new >= 1) { const int so = ((loaded_hi + 1) % NSLOT) * SLOT; *(LAS v4u*)(F.lds + so + sK) = pk0; *(LAS v4u*)(F.lds + so + sV) = pv0; }
            if (n_new >= 2) { const int so = ((loaded_hi + 2) % NSLOT) * SLOT; *(LAS v4u*)(F.lds + so + sK) = pk1; *(LAS v4u*)(F.lds + so + sV) = pv1; }
            loaded_hi = nhi;
            __syncthreads();
        }
    }
    __syncthreads();
}
__device__ __forceinline__ void phase_fft1(Frame& F, const Args& A) {
    typedef short bf16x8 __attribute__((ext_vector_type(8)));
    const bf16* UT = (const bf16*)(F.ws + WS_QKVU) + (size_t)2 * NTOK * 512; const bf16* DFT1 = (const bf16*)(F.ws + WS_DFT1); const float2* TW = (const float2*)(F.ws + WS_TW);
    bf16* X1T = (bf16*)(F.ws + WS_MF);
    const int lane = F.lane, q16 = lane & 15, g = lane >> 4;
    for (int u = GW_ID(F); u < NB * 8 * 32; u += N_GW(F)) {
        const int ct = u & 31, t2b = (u >> 5) & 7, b = u >> 8, ch = 16 * ct + q16;
        bf16x8 bfr[8][2];
#pragma unroll
        for (int t2 = 0; t2 < 8; ++t2)
#pragma unroll
            for (int ks = 0; ks < 2; ++ks) bfr[t2][ks] = *(const bf16x8*)(UT + (size_t)ch * NTOK + (size_t)b * T + (8 * t2b + t2) * 64 + 32 * ks + 8 * g);
#pragma unroll 1
        for (int kt = 0; kt < 4; ++kt) {
            bf16x8 are[2], aim[2];
#pragma unroll
            for (int ks = 0; ks < 2; ++ks) { are[ks] = *(const bf16x8*)(DFT1 + (16 * kt + q16) * 64 + 32 * ks + 8 * g); aim[ks] = *(const bf16x8*)(DFT1 + (64 + 16 * kt + q16) * 64 + 32 * ks + 8 * g); }
            float xr[8][4], xi[8][4];
#pragma unroll
            for (int t2 = 0; t2 < 8; ++t2) {
                f32x4 ar = {0.f, 0.f, 0.f, 0.f}, ai = {0.f, 0.f, 0.f, 0.f};
                ar = __builtin_amdgcn_mfma_f32_16x16x32_bf16(are[0], bfr[t2][0], ar, 0, 0, 0); ar = __builtin_amdgcn_mfma_f32_16x16x32_bf16(are[1], bfr[t2][1], ar, 0, 0, 0);
                ai = __builtin_amdgcn_mfma_f32_16x16x32_bf16(aim[0], bfr[t2][0], ai, 0, 0, 0); ai = __builtin_amdgcn_mfma_f32_16x16x32_bf16(aim[1], bfr[t2][1], ai, 0, 0, 0);
#pragma unroll
                for (int e = 0; e < 4; ++e) { const float2 w = TW[(8 * t2b + t2) * 64 + 16 * kt + 4 * g + e]; xr[t2][e] = ar[e] * w.x - ai[e] * w.y; xi[t2][e] = ar[e] * w.y + ai[e] * w.x; }
            }
#pragma unroll
            for (int e = 0; e < 4; ++e) { const int k1 = 16 * kt + 4 * g + e;
                v4u wr, wi; wr.x = cvtpk(xr[0][e], xr[1][e]); wr.y = cvtpk(xr[2][e], xr[3][e]); wr.z = cvtpk(xr[4][e], xr[5][e]); wr.w = cvtpk(xr[6][e], xr[7][e]);
                wi.x = cvtpk(xi[0][e], xi[1][e]); wi.y = cvtpk(xi[2][e], xi[3][e]); wi.z = cvtpk(xi[4][e], xi[5][e]); wi.w = cvtpk(xi[6][e], xi[7][e]);
                v4u* dst = (v4u*)(X1T + ((((size_t)(b * 64 + k1) * 8 + t2b) * 512 + ch) << 4)); dst[0] = wr; dst[1] = wi; }
        }
    }
}
__device__ __forceinline__ void phase_fft2(Frame& F, const Args& A) {
    typedef short bf16x8 __attribute__((ext_vector_type(8)));
    const bf16* X1T = (const bf16*)(F.ws + WS_MF); const bf16* T2 = (const bf16*)(F.ws + WS_T2); const bf16* MIXT = (const bf16*)(F.ws + WS_MIXT);
    bf16* mg = (bf16*)(F.ws + WS_X1); const float* bfour = A.in[5]; const float* gfour = A.in[7];
    const int lane = F.lane, q16 = lane & 15, g = lane >> 4;
    LAS unsigned char* slab = F.lds + F.wave * 16512;
    for (int u = GW_ID(F); u < NB * 64 * 4; u += N_GW(F)) {
        const int k2t = u & 3, k1 = (u >> 2) & 63, b = u >> 8;
        bf16x8 wb[2][4];
#pragma unroll
        for (int part = 0; part < 2; ++part)
#pragma unroll
            for (int ks = 0; ks < 4; ++ks) wb[part][ks] = *(const bf16x8*)(T2 + (part * 64 + 16 * k2t + q16) * 128 + 32 * ks + 8 * g);
        float ssq = 0.f;
#pragma unroll 1
        for (int grp = 0; grp < 8; ++grp) {
            f32x4 yr[4], yi[4];
#pragma unroll
            for (int ctile = 0; ctile < 4; ++ctile) {
                const int c = grp * 64 + 16 * ctile + q16; bf16x8 af[4];
#pragma unroll
                for (int ks = 0; ks < 4; ++ks) af[ks] = *(const bf16x8*)(X1T + ((((size_t)(b * 64 + k1) * 8 + 4 * (ks & 1) + g) * 512 + c) << 4) + (ks >> 1) * 8);
                f32x4 r = {0.f, 0.f, 0.f, 0.f}, im = {0.f, 0.f, 0.f, 0.f};
#pragma unroll
                for (int ks = 0; ks < 4; ++ks) { r = __builtin_amdgcn_mfma_f32_16x16x32_bf16(af[ks], wb[0][ks], r, 0, 0, 0); im = __builtin_amdgcn_mfma_f32_16x16x32_bf16(af[ks], wb[1][ks], im, 0, 0, 0); }
                yr[ctile] = r; yi[ctile] = im;
            }
            bf16x8 yb[4];
#pragma unroll
            for (int s = 0; s < 4; ++s) { const f32x4 lo = (s < 2) ? yr[2 * (s & 1)] : yi[2 * (s & 1)], hi = (s < 2) ? yr[2 * (s & 1) + 1] : yi[2 * (s & 1) + 1];
                v4u w; w.x = cvtpk(lo[0], lo[1]); w.y = cvtpk(lo[2], lo[3]); w.z = cvtpk(hi[0], hi[1]); w.w = cvtpk(hi[2], hi[3]); yb[s] = __builtin_bit_cast(bf16x8, w); }
#pragma unroll
            for (int dt = 0; dt < 4; ++dt) {
                f32x4 acc = {0.f, 0.f, 0.f, 0.f};
#pragma unroll
                for (int s = 0; s < 4; ++s) { const bf16x8 ma = *(const bf16x8*)(MIXT + ((size_t)(grp * 64 + 16 * dt + q16) << 7) + 32 * s + 8 * g); acc = __builtin_amdgcn_mfma_f32_16x16x32_bf16(ma, yb[s], acc, 0, 0, 0); }
                const f32x4 bv = *(const f32x4*)(bfour + grp * 64 + 16 * dt + 4 * g); acc += bv;
                ssq += (acc[0] * acc[0] + acc[1] * acc[1]) + (acc[2] * acc[2] + acc[3] * acc[3]);
                v2u w; w.x = cvtpk(acc[0], acc[1]); w.y = cvtpk(acc[2], acc[3]);
                *(LAS v2u*)(slab + q16 * 1032 + (grp * 64 + 16 * dt + 4 * g) * 2) = w;
            }
        }
        ssq += __shfl_xor(ssq, 16); ssq += __shfl_xor(ssq, 32);
        const float rstd = 1.0f / sqrtf(ssq * (1.f / 512.f) + EPS);
        LDS_WAIT(); asm volatile("" ::: "memory");
        const f32x4 g0 = *(const f32x4*)(gfour + lane * 8), g1 = *(const f32x4*)(gfour + lane * 8 + 4);
#pragma unroll 4
        for (int row = 0; row < 16; ++row) {
            const float rs = __shfl(rstd, row);
            const v2u a = *(const LAS v2u*)(slab + row * 1032 + lane * 16), c2 = *(const LAS v2u*)(slab + row * 1032 + lane * 16 + 8);
            v4u o; o.x = cvtpk(bflo(a.x) * rs * g0[0], bfhi(a.x) * rs * g0[1]); o.y = cvtpk(bflo(a.y) * rs * g0[2], bfhi(a.y) * rs * g0[3]);
            o.z = cvtpk(bflo(c2.x) * rs * g1[0], bfhi(c2.x) * rs * g1[1]); o.w = cvtpk(bflo(c2.y) * rs * g1[2], bfhi(c2.y) * rs * g1[3]);
            *(v4u*)(mg + ((size_t)b * T + k1 + 64 * (16 * k2t + row)) * D + DA + lane * 8) = o;
        }
        LDS_WAIT(); asm volatile("" ::: "memory");
    }
}
__device__ __forceinline__ void phase_router(Frame& F, const Args& A) {
    typedef short bf16x8 __attribute__((ext_vector_type(8)));
    LAS int* lcnt = (LAS int*)(F.lds + L_LCNT); LAS int* gbase = (LAS int*)(F.lds + L_GBASE); LAS int* rt = (LAS int*)(F.lds + L_RT);
    const bf16* h = (const bf16*)(F.ws + WS_XN);
    int2* e01 = (int2*)(F.ws + WS_ROUTE); int2* rank = e01 + NTOK; float2* wgt = (float2*)(rank + NTOK); float* rstd = (float*)(wgt + NTOK);
    const float* brc = A.in[11]; const float* brf = A.in[13]; const int lane = F.lane, q16 = lane & 15, g = lane >> 4;
    for (int batch = F.vcu; batch < NTOK / 128; batch += F.G) {
        { const v4u* src = (const v4u*)(F.ws + WS_WR); for (int i = F.tid; i < 72 * 128; i += NWAVES * 64) *(LAS v4u*)(F.lds + (i >> 7) * RT_STRIDE + (i & 127) * 16) = src[i]; }
        if (F.tid < 32) lcnt[F.tid] = 0;
        __syncthreads();
        const int tok0 = batch * 128 + F.wave * 16;
        f32x4 acc[3]; float ssq = 0.f;
#pragma unroll
        for (int nt = 0; nt < 3; ++nt) acc[nt] = (f32x4){0.f, 0.f, 0.f, 0.f};
        const bf16* hp = h + (size_t)(tok0 + q16) * D + 8 * g;
        const LAS unsigned char* w0 = F.lds + q16 * RT_STRIDE + 16 * g; const LAS unsigned char* w1 = w0 + 16 * RT_STRIDE; const LAS unsigned char* w2 = F.lds + min(32 + q16, 35) * RT_STRIDE + 16 * g;
#pragma unroll 4
        for (int ks = 0; ks < 32; ++ks) {
            const bf16x8 hf = *(const bf16x8*)(hp + 32 * ks);
#pragma unroll
            for (int i = 0; i < 8; ++i) { const float v = __builtin_bit_cast(float, (unsigned)(unsigned short)hf[i] << 16); ssq += v * v; }
            acc[0] = __builtin_amdgcn_mfma_f32_16x16x32_bf16(*(const LAS bf16x8*)(w0 + 64 * ks), hf, acc[0], 0, 0, 0);
            acc[0] = __builtin_amdgcn_mfma_f32_16x16x32_bf16(*(const LAS bf16x8*)(w0 + 36 * RT_STRIDE + 64 * ks), hf, acc[0], 0, 0, 0);
            acc[1] = __builtin_amdgcn_mfma_f32_16x16x32_bf16(*(const LAS bf16x8*)(w1 + 64 * ks), hf, acc[1], 0, 0, 0);
            acc[1] = __builtin_amdgcn_mfma_f32_16x16x32_bf16(*(const LAS bf16x8*)(w1 + 36 * RT_STRIDE + 64 * ks), hf, acc[1], 0, 0, 0);
            acc[2] = __builtin_amdgcn_mfma_f32_16x16x32_bf16(*(const LAS bf16x8*)(w2 + 64 * ks), hf, acc[2], 0, 0, 0);
            acc[2] = __builtin_amdgcn_mfma_f32_16x16x32_bf16(*(const LAS bf16x8*)(w2 + 36 * RT_STRIDE + 64 * ks), hf, acc[2], 0, 0, 0);
        }
        ssq += __shfl_xor(ssq, 16); ssq += __shfl_xor(ssq, 32);
        __syncthreads();
        LAS float* lg = (LAS float*)F.lds + (F.wave * 16) * 37;
#pragma unroll
        for (int nt = 0; nt < 3; ++nt)
#pragma unroll
            for (int e = 0; e < 4; ++e) { const int j = 16 * nt + 4 * g + e; if (j < 36) lg[q16 * 37 + j] = acc[nt][e]; }
        LDS_WAIT(); asm volatile("" ::: "memory");
        if (lane < 16) {
            const int tl = F.wave * 16 + lane, tok = batch * 128 + tl; const float rs = 1.0f / sqrtf(ssq * (1.f / D) + EPS); const LAS float* L = lg + lane * 37;
            const float c0 = L[0] * rs + brc[0], c1 = L[1] * rs + brc[1], c2 = L[2] * rs + brc[2], c3 = L[3] * rs + brc[3];
            int gi = 0; float mx = c0;
            if (c1 > mx) { mx = c1; gi = 1; }
            if (c2 > mx) { mx = c2; gi = 2; }
            if (c3 > mx) { mx = c3; gi = 3; }
            const float gwt = 1.0f / (expf(c0 - mx) + expf(c1 - mx) + expf(c2 - mx) + expf(c3 - mx));
            float v0 = -1e30f, v1 = -1e30f; int i0 = 0, i1 = 0;
#pragma unroll
            for (int j = 0; j < 8; ++j) { const float fv = L[4 + gi * 8 + j] * rs + brf[gi * 8 + j];
                if (fv > v0) { v1 = v0; i1 = i0; v0 = fv; i0 = j; } else if (fv > v1) { v1 = fv; i1 = j; } }
            const float e1 = expf(v1 - v0), p0 = 1.f / (1.f + e1), p1 = e1 / (1.f + e1);
            const int ea = gi * 8 + i0, eb = gi * 8 + i1;
            const int ra = __hip_atomic_fetch_add(lcnt + ea, 1, __ATOMIC_RELAXED, __HIP_MEMORY_SCOPE_WORKGROUP);
            const int rb = __hip_atomic_fetch_add(lcnt + eb, 1, __ATOMIC_RELAXED, __HIP_MEMORY_SCOPE_WORKGROUP);
            rt[tl] = ea; rt[128 + tl] = eb; rt[256 + tl] = ra; rt[384 + tl] = rb;
            wgt[tok] = make_float2(p0 * gwt, p1 * gwt); rstd[tok] = rs;
        }
        __syncthreads();
        if (F.tid < 32) gbase[F.tid] = (int)__hip_atomic_fetch_add(F.ctl + CW_CNT + 64 * F.tid, (unsigned)lcnt[F.tid], __ATOMIC_RELAXED, __HIP_MEMORY_SCOPE_AGENT);
        __syncthreads();
        if (F.tid < 128) { const int tok = batch * 128 + F.tid, ea = rt[F.tid], eb = rt[128 + F.tid];
            e01[tok] = make_int2(ea, eb); rank[tok] = make_int2(rt[256 + F.tid] + gbase[ea], rt[384 + F.tid] + gbase[eb]); }
        __syncthreads();
    }
}
__device__ __forceinline__ void phase_scatter(Frame& F, const Args& A) {
    LAS int* pbase = (LAS int*)(F.lds + L_PBASE);
    LAS int* lcnt = (LAS int*)(F.lds + L_LCNT);
    if (F.tid < 32) lcnt[F.tid] = (int)__hip_atomic_load(F.ctl + CW_CNT + 64 * F.tid, __ATOMIC_RELAXED, __HIP_MEMORY_SCOPE_AGENT);
    __syncthreads();
    if (F.tid == 0) { int acc = 0; for (int e = 0; e < 32; ++e) { pbase[e] = acc; acc += (lcnt[e] + 255) >> 8; } pbase[32] = acc; }
    __syncthreads();
    float* rstd_s = (float*)(F.ws + WS_META); float* w_s = rstd_s + MAXROWS; int* slotrow_s = (int*)(w_s + MAXROWS);
    for (int e = F.vcu; e < 32; e += F.G) { const int cnt = lcnt[e];
        for (int r = 256 * pbase[e] + cnt + F.tid; r < 256 * pbase[e + 1]; r += NWAVES * 64) { slotrow_s[r] = 2 * NTOK; w_s[r] = 0.f; rstd_s[r] = 0.f; } }
    const bf16* h = (const bf16*)(F.ws + WS_XN); bf16* hs = (bf16*)(F.ws + WS_QKVU);
    const int2* e01 = (const int2*)(F.ws + WS_ROUTE); const int2* rank = e01 + NTOK; const float2* wgt = (const float2*)(rank + NTOK); const float* rstd = (const float*)(wgt + NTOK);
    for (int tok = GW_ID(F); tok < NTOK; tok += N_GW(F)) {
        const int2 e = e01[tok], r = rank[tok]; const float2 w = wgt[tok]; const float rs = rstd[tok];
        const int pos0 = 256 * pbase[e.x] + r.x, pos1 = 256 * pbase[e.y] + r.y;
        const v4u* src = (const v4u*)(h + (size_t)tok * D) + F.lane * 2; const v4u a = src[0], b = src[1];
        v4u* d0 = (v4u*)(hs + (size_t)pos0 * D) + F.lane * 2; d0[0] = a; d0[1] = b;
        v4u* d1 = (v4u*)(hs + (size_t)pos1 * D) + F.lane * 2; d1[0] = a; d1[1] = b;
        if (F.lane == 0) { rstd_s[pos0] = rs; w_s[pos0] = w.x; slotrow_s[pos0] = 2 * tok; rstd_s[pos1] = rs; w_s[pos1] = w.y; slotrow_s[pos1] = 2 * tok + 1; }
    }
}
__device__ __forceinline__ void phase_final(Frame& F, const Args& A) {
    const bf16* h = (const bf16*)(F.ws + WS_XN); const bf16* y2 = (const bf16*)(F.ws + WS_X1); const int lane = F.lane;
    f32x4 gv[4];
#pragma unroll
    for (int j = 0; j < 4; ++j) gv[j] = ((const f32x4*)(A.in[17] + lane * 16))[j];
    for (int tok = GW_ID(F); tok < NTOK; tok += N_GW(F)) {
        const v4u* ph = (const v4u*)(h + (size_t)tok * D) + lane * 2; const v4u* p0 = (const v4u*)(y2 + (size_t)(2 * tok) * D) + lane * 2; const v4u* p1 = (const v4u*)(y2 + (size_t)(2 * tok + 1) * D) + lane * 2;
        f32x4 v[4]; float s = 0.f;
#pragma unroll
        for (int hh = 0; hh < 2; ++hh) { const v4u a = ph[hh], b = p0[hh], c = p1[hh];
            v[2 * hh] = (f32x4){bflo(a.x) + bflo(b.x) + bflo(c.x), bfhi(a.x) + bfhi(b.x) + bfhi(c.x), bflo(a.y) + bflo(b.y) + bflo(c.y), bfhi(a.y) + bfhi(b.y) + bfhi(c.y)};
            v[2 * hh + 1] = (f32x4){bflo(a.z) + bflo(b.z) + bflo(c.z), bfhi(a.z) + bfhi(b.z) + bfhi(c.z), bflo(a.w) + bflo(b.w) + bflo(c.w), bfhi(a.w) + bfhi(b.w) + bfhi(c.w)}; }
#pragma unroll
        for (int j = 0; j < 4; ++j) s += (v[j].x * v[j].x + v[j].y * v[j].y) + (v[j].z * v[j].z + v[j].w * v[j].w);
        const float rstd = 1.0f / sqrtf(wave_sum(s) * (1.f / D) + EPS);
        f32x4* dst = (f32x4*)(F.out + (size_t)tok * D + lane * 16);
#pragma unroll
        for (int j = 0; j < 4; ++j) dst[j] = v[j] * rstd * gv[j];
    }
}
__global__ void __launch_bounds__(NWAVES * 64, 2) mega_fwd(Args args) {
    extern __shared__ __attribute__((aligned(16))) unsigned char lds[];
    Frame F;
    F.lds = (LAS unsigned char*)lds;
    F.tid = threadIdx.x; F.lane = F.tid & 63; F.wave = __builtin_amdgcn_readfirstlane(F.tid >> 6);
    F.G = gridDim.x; { const int bx = blockIdx.x; F.vcu = (F.G % 8 == 0) ? (bx % 8) * (F.G / 8) + bx / 8 : bx; }
    F.ws = args.ws; F.ctl = (unsigned*)(args.ws + WS_CTL); F.out = args.out;
    for (int u = F.tid; u < (LDS_BYTES - LDSCTL_OFF) / 4; u += NWAVES * 64) ((LAS unsigned*)(F.lds + LDSCTL_OFF))[u] = 0u;
    __syncthreads();
    XcdBarrier bar = xcd_barrier_post(F.ctl + CW_BAR, (volatile LAS unsigned*)(F.lds + L_MISC) + 8);
#define GRID_BAR() xcd_barrier(bar)
    PG8_LAS unsigned char* ring = (PG8_LAS unsigned char*)lds;
    const pg8::bf16_t* XN = (const pg8::bf16_t*)(F.ws + WS_XN);

    phase_prep(F, args);
    GRID_BAR();
    {
        pg8::Gemm g{XN, (const pg8::bf16_t*)(F.ws + WS_WIN), NTOK, 1024, D}; pg8::StaticOrder S; S.init(NTOK, 1024, F.G, (int)blockIdx.x);
        pg8::EpiBf16 E{(pg8::bf16_t*)(F.ws + WS_QKVU), 512, 512, (size_t)NTOK * 512, QSCALE};
        pg8::gemm_phase<pg8::EpiBf16, pg8::StaticOrder, true, true>(ring, g, S, E);
    }
    {
        pg8::Gemm g{(const pg8::bf16_t*)(F.ws + WS_WIN) + (size_t)1536 * D, XN, 512, NTOK, D}; pg8::StaticOrder S; S.init(512, NTOK, F.G, (int)blockIdx.x);
        pg8::EpiBf16 E{(pg8::bf16_t*)(F.ws + WS_QKVU) + (size_t)3 * NTOK * 512, NTOK, NTOK, 0, 1.0f};
        pg8::gemm_phase<pg8::EpiBf16, pg8::StaticOrder, true, true>(ring, g, S, E);
    }
    {
        pg8::Gemm g{(const pg8::bf16_t*)(F.ws + WS_WIN) + (size_t)1024 * D, XN, 512, NTOK, D}; pg8::StaticOrder S; S.init(512, NTOK, F.G, (int)blockIdx.x);
        pg8::EpiBf16 E{(pg8::bf16_t*)(F.ws + WS_QKVU) + (size_t)2 * NTOK * 512, NTOK, NTOK, 0, 1.0f};
        pg8::gemm_phase<pg8::EpiBf16, pg8::StaticOrder, true, true, pg8::BGridT>(ring, g, S, E);
    }
    GRID_BAR();
    phase_attn(F, args);
    phase_fft1(F, args);
    GRID_BAR();
    phase_fft2(F, args);
    GRID_BAR();
    {
        pg8::Gemm g{(const pg8::bf16_t*)(F.ws + WS_X1), (const pg8::bf16_t*)(F.ws + WS_WOUT), NTOK, D, D}; pg8::StaticOrder S; S.init(NTOK, D, F.G, (int)blockIdx.x);
        pg8::EpiResH E{args.in[0], (pg8::bf16_t*)(F.ws + WS_XN), (const float*)(F.ws + WS_SSQ)};
        pg8::gemm_phase<pg8::EpiResH, pg8::StaticOrder, true, true>(ring, g, S, E);
    }
    GRID_BAR();
    phase_router(F, args);
    GRID_BAR();
    phase_scatter(F, args);
    GRID_BAR();
    {
        pg8::Gemm g{(const pg8::bf16_t*)(F.ws + WS_QKVU), (const pg8::bf16_t*)(F.ws + WS_WGU), MAXROWS, NE * 512, D};
        pg8::MoeOrder S{(const PG8_LAS int*)(ring + L_PBASE), 2, F.G, (int)blockIdx.x};
        const float* rstd_s = (const float*)(F.ws + WS_META);
        pg8::EpiMoe1 E{rstd_s, rstd_s + MAXROWS, (pg8::bf16_t*)(F.ws + WS_HD)};
        pg8::gemm_phase<pg8::EpiMoe1, pg8::MoeOrder, true, true>(ring, g, S, E);
    }
    GRID_BAR();
    {
        pg8::Gemm g{(const pg8::bf16_t*)(F.ws + WS_HD), (const pg8::bf16_t*)(F.ws + WS_WD), MAXROWS, NE * 1024, DE};
        pg8::MoeOrder S{(const PG8_LAS int*)(ring + L_PBASE), 4, F.G, (int)blockIdx.x};
        const int* slotrow_s = (const int*)(F.ws + WS_META) + 2 * MAXROWS;
        pg8::EpiMoe2 E{slotrow_s, (pg8::bf16_t*)(F.ws + WS_X1)};
        pg8::gemm_phase<pg8::EpiMoe2, pg8::MoeOrder, true, true>(ring, g, S, E);
    }
    GRID_BAR();
    phase_final(F, args);
}

extern "C" void kernel_launch(void* const* d_in, const int* in_sizes, int n_in, void* d_out, int out_size, void* d_ws, size_t ws_size, hipStream_t stream) {
    static int grid = 0;
    if (grid == 0) {
        if (n_in != 18 || out_size != NTOK * D || ws_size < WS_END) { fprintf(stderr, "kernel_launch: unexpected problem shape (n_in %d, out %d, ws %zu)\n", n_in, out_size, ws_size); grid = -1; return; }
        int dev = 0, cus = 0;
        if (hipGetDevice(&dev) != hipSuccess || hipDeviceGetAttribute(&cus, hipDeviceAttributeMultiprocessorCount, dev) != hipSuccess) { grid = -1; return; }
        if (hipFuncSetAttribute((const void*)mega_fwd, hipFuncAttributeMaxDynamicSharedMemorySize, LDS_BYTES) != hipSuccess) { fprintf(stderr, "kernel_launch: hipFuncSetAttribute failed\n"); grid = -1; return; }
        int per_cu = 0;
        if (hipOccupancyMaxActiveBlocksPerMultiprocessor(&per_cu, (const void*)mega_fwd, NWAVES * 64, LDS_BYTES) != hipSuccess || per_cu < 1) { fprintf(stderr, "kernel_launch: occupancy query says %d blocks per CU\n", per_cu); }
        (void)hipGetLastError();
        grid = cus;
    }
    if (grid < 0) return;
    (void)hipMemsetAsync((char*)d_ws + WS_CTL, 0, CTL_ZERO_BYTES, stream);
    Args a{};
    for (int i = 0; i < 18; ++i) a.in[i] = (const float*)d_in[i];
    a.out = (float*)d_out; a.ws = (unsigned char*)d_ws;
    hipLaunchKernelGGL(mega_fwd, dim3(grid), dim3(NWAVES * 64), LDS_BYTES, stream, a);
}
```

```cpp
#include <hip/hip_runtime.h>
#include <cstdint>
#include <cstdio>
namespace pg8 {
#define PG8_LAS __attribute__((address_space(3)))
typedef unsigned short bf16_t;
typedef short bf16x8 __attribute__((ext_vector_type(8)));
typedef float f32x4 __attribute__((ext_vector_type(4)));
typedef unsigned u32x4 __attribute__((ext_vector_type(4)));
constexpr int BM = 256, BK = 64, HALF = 128, HTB = HALF * BK * 2  , STAGE_BYTES = 8 * HTB, NXCD = 8, WGM = 8;

__host__ __device__ __forceinline__ int lds_byte(int r, int c) { const int st = (r >> 4) * 2 + (c >> 5), rr = r & 15, cc = c & 31, ob = rr * 64 + cc * 2; return st * 1024 + (ob ^ (((ob >> 9) & 1) << 5)); }
__host__ __device__ __forceinline__ void stage_rc(int b, int& R, int& C) { const int st = b / 1024, sb = b % 1024, swz = sb ^ (((sb >> 9) & 1) << 5); R = (st >> 1) * 16 + swz / 64; C = (st & 1) * 32 + (swz % 64) / 2; }
__host__ __device__ __forceinline__ int perm32(int rho) { const int n = rho >> 4, i = rho & 15; return 8 * (i >> 2) + 4 * n + (i & 3); }

struct Unit { int pm, pn; };
struct Gemm { const bf16_t* A; const bf16_t* Bt; int M, N, K; };

struct StaticOrder {
    int nM, nN, nwg, G, c;
    __host__ __device__ void init(int M, int N, int G_, int c_) { nM = M / BM; nN = N / BM; nwg = nM * nN; G = G_; c = c_; }
    __host__ __device__ bool next(int i, Unit& u) const {
        const long L = (long)i * G + c; if (L >= nwg) return false;
        int wgid = (int)L; { const int q = nwg / NXCD, r = nwg % NXCD, xcd = wgid % NXCD, off = wgid / NXCD; wgid = (xcd < r ? xcd * (q + 1) : r * (q + 1) + (xcd - r) * q) + off; }
        const int nig = WGM * nN, gid = wgid / nig, fm = gid * WGM, gsz = (nM - fm) < WGM ? (nM - fm) : WGM;
        u.pm = fm + ((wgid % nig) % gsz); u.pn = (wgid % nig) / gsz; return true;
    }
    __device__ __forceinline__ void a_ready(const Unit&) const {}
    __device__ __forceinline__ void done(const Unit&) const {}
};

typedef float f32x2c __attribute__((ext_vector_type(2))); typedef __bf16 bf16x2c __attribute__((ext_vector_type(2)));
__device__ __forceinline__ unsigned cvt_pk_bf16(float lo, float hi) { f32x2c v = {lo, hi}; bf16x2c b = __builtin_convertvector(v, bf16x2c); return __builtin_bit_cast(unsigned, b); }
typedef float f32x2 __attribute__((ext_vector_type(2)));
struct EpiBf16 {
    static constexpr bool PERM = true, AFTER_DRAIN = false; static constexpr int MID_TILE = 0;
    bf16_t* O; int ldc; int split_cols; size_t split_stride; float scale0;
    __device__ __forceinline__ void operator()(const f32x4 (&acc)[2][2][4][2], const Unit& u, int wr, int wc, int fr, int fq) const {
        const int row0 = u.pm * BM + wr * 64 + fr; int colt = u.pn * BM; bf16_t* base = O;
        float sc = 1.f; { const int t = colt / split_cols; base += (size_t)t * split_stride; colt -= t * split_cols; if (t == 0) sc = scale0; }
        const int col0 = colt + wc * 32 + 8 * fq;
#pragma unroll
        for (int ai = 0; ai < 2; ++ai)
#pragma unroll
            for (int m = 0; m < 4; ++m) { bf16_t* rowp = base + (size_t)(row0 + ai * HALF + m * 16) * ldc + col0;
#pragma unroll
                for (int bj = 0; bj < 2; ++bj) { f32x4 v0 = acc[ai][bj][m][0] * sc, v1 = acc[ai][bj][m][1] * sc;
                    u32x4 w; w.x = cvt_pk_bf16(v0[0], v0[1]); w.y = cvt_pk_bf16(v0[2], v0[3]); w.z = cvt_pk_bf16(v1[0], v1[1]); w.w = cvt_pk_bf16(v1[2], v1[3]);
                    *(u32x4*)(rowp + bj * HALF) = w; } }
    }
};
struct EpiResH {
    static constexpr bool PERM = true, AFTER_DRAIN = false; static constexpr int MID_TILE = 8;
    const float* x; bf16_t* h; const float* ssq;
    __device__ __forceinline__ void mid(f32x4 (&acc)[2][2][4][2], const Unit& u, int wr, int wc, int fr, int fq) const {
        const int row0 = u.pm * BM + wr * 64 + fr;
#pragma unroll
        for (int ai = 0; ai < 2; ++ai)
#pragma unroll
            for (int m = 0; m < 4; ++m) { const f32x4* p = (const f32x4*)(ssq + (size_t)(row0 + ai * HALF + m * 16) * 8); const f32x4 a = p[0], b = p[1];
                const float s = ((a[0] + a[1]) + (a[2] + a[3])) + ((b[0] + b[1]) + (b[2] + b[3])); const float rs = 1.0f / sqrtf(s * (1.0f / 512.0f) + 1e-6f);
#pragma unroll
                for (int bj = 0; bj < 2; ++bj)
#pragma unroll
                    for (int n = 0; n < 2; ++n) acc[ai][bj][m][n] *= rs; }
    }
    __device__ __forceinline__ void operator()(const f32x4 (&acc)[2][2][4][2], const Unit& u, int wr, int wc, int fr, int fq) const {
        const int row0 = u.pm * BM + wr * 64 + fr, col0 = u.pn * BM + wc * 32 + 8 * fq;
#pragma unroll
        for (int ai = 0; ai < 2; ++ai)
#pragma unroll
            for (int m = 0; m < 4; ++m) { const size_t off = (size_t)(row0 + ai * HALF + m * 16) * 1024 + col0;
#pragma unroll
                for (int bj = 0; bj < 2; ++bj) { const f32x4 xa = *(const f32x4*)(x + off + bj * HALF), xb = *(const f32x4*)(x + off + bj * HALF + 4);
                    const f32x4 v0 = acc[ai][bj][m][0] + xa, v1 = acc[ai][bj][m][1] + xb;
                    u32x4 w; w.x = cvt_pk_bf16(v0[0], v0[1]); w.y = cvt_pk_bf16(v0[2], v0[3]); w.z = cvt_pk_bf16(v1[0], v1[1]); w.w = cvt_pk_bf16(v1[2], v1[3]);
                    *(u32x4*)(h + off + bj * HALF) = w; } }
    }
};
struct MoeEnt { int slotrow; float w; float rstd; int pad; };
constexpr int MOE_CAP = 32768;
struct MoeCtx { const PG8_LAS int* pbase; const PG8_LAS int* cnt; const MoeEnt* ent; int ntn;
    __device__ __forceinline__ int expert(const Unit& u) const { return u.pn / ntn; }
    __device__ __forceinline__ const MoeEnt* row_ent(const Unit& u, int e, int row, bool& valid) const { const int rank = (u.pm - pbase[e]) * BM + row, c = cnt[e]; valid = rank < c; return ent + (size_t)e * MOE_CAP + (valid ? rank : c - 1); }
};
struct EpiMoe1 {
    static constexpr bool PERM = true, AFTER_DRAIN = false; static constexpr int MID_TILE = 0;
    MoeCtx cx; bf16_t* hd;
    __device__ __forceinline__ void operator()(const f32x4 (&acc)[2][2][4][2], const Unit& u, int wr, int wc, int fr, int fq) const {
        const int rl0 = wr * 64 + fr, col0 = (u.pn & 1) * HALF + wc * 32 + 8 * fq, e = cx.expert(u);
#pragma unroll
        for (int ai = 0; ai < 2; ++ai)
#pragma unroll
            for (int m = 0; m < 4; ++m) { const int rl = rl0 + ai * HALF + m * 16; bool valid; const MoeEnt* en = cx.row_ent(u, e, rl, valid); const float rs = en->rstd, wv = en->w;
                float o[8];
#pragma unroll
                for (int n = 0; n < 2; ++n)
#pragma unroll
                    for (int j = 0; j < 4; ++j) { const float g = acc[ai][0][m][n][j] * rs, uu = acc[ai][1][m][n][j] * rs;
                        o[n * 4 + j] = g * __builtin_amdgcn_rcpf(1.0f + __builtin_amdgcn_exp2f(-1.4426950408889634f * g)) * uu * wv; }
                u32x4 w; w.x = cvt_pk_bf16(o[0], o[1]); w.y = cvt_pk_bf16(o[2], o[3]); w.z = cvt_pk_bf16(o[4], o[5]); w.w = cvt_pk_bf16(o[6], o[7]);
                *(u32x4*)(hd + (size_t)(u.pm * BM + rl) * 256 + col0) = w; }
    }
};
struct EpiMoe2 {
    static constexpr bool PERM = true, AFTER_DRAIN = false; static constexpr int MID_TILE = 0;
    MoeCtx cx; bf16_t* y2; int dump;
    __device__ __forceinline__ void operator()(const f32x4 (&acc)[2][2][4][2], const Unit& u, int wr, int wc, int fr, int fq) const {
        const int rl0 = wr * 64 + fr, col0 = (u.pn & 3) * BM + wc * 32 + 8 * fq, e = cx.expert(u);
#pragma unroll
        for (int ai = 0; ai < 2; ++ai)
#pragma unroll
            for (int m = 0; m < 4; ++m) { bool valid; const MoeEnt* en = cx.row_ent(u, e, rl0 + ai * HALF + m * 16, valid); const int sr = valid ? en->slotrow : dump;
                bf16_t* rowp = y2 + (size_t)sr * 1024 + col0;
#pragma unroll
                for (int bj = 0; bj < 2; ++bj) { const f32x4 v0 = acc[ai][bj][m][0], v1 = acc[ai][bj][m][1];
                    u32x4 w; w.x = cvt_pk_bf16(v0[0], v0[1]); w.y = cvt_pk_bf16(v0[2], v0[3]); w.z = cvt_pk_bf16(v1[0], v1[1]); w.w = cvt_pk_bf16(v1[2], v1[3]);
                    *(u32x4*)(rowp + bj * HALF) = w; }
                asm volatile("" ::: "memory"); }
    }
};
struct MoeOrder {
    MoeCtx cx; int G, c;
    __device__ __forceinline__ bool next(int i, Unit& u) const {
        const int L = i * G + c; const int total = cx.pbase[32] * cx.ntn; if (L >= total) return false;
        const int pm = L / cx.ntn, pl = L - pm * cx.ntn; int e = 0;
#pragma unroll 1
        for (int j = 1; j < 32; ++j) e += (cx.pbase[j] <= pm) ? 1 : 0;
        u.pm = pm; u.pn = e * cx.ntn + pl; return true;
    }
    __device__ __forceinline__ int a_row(const Unit& u, int half, int r) const { bool valid; return cx.row_ent(u, cx.expert(u), half * HALF + r, valid)->slotrow >> 1; }
    __device__ __forceinline__ void a_ready(const Unit&) const {}
    __device__ __forceinline__ void done(const Unit&) const {}
};
struct BNat { static __device__ __forceinline__ int row(int v) { return v; } static __device__ __forceinline__ size_t hstep(int K) { return (size_t)HALF * K * 2; } static __device__ __forceinline__ size_t tile(int pn, int K) { return (size_t)pn * BM * K * 2; } };
struct BGridT { static __device__ __forceinline__ int row(int v) { return (v & 63) * 64 + (v >> 6); } static __device__ __forceinline__ size_t hstep(int K) { return (size_t)2 * K * 2; }
    static __device__ __forceinline__ size_t tile(int pn, int K) { return (size_t)((pn >> 4) * 4096 + (pn & 15) * 4) * K * 2; } };
struct ANat { static constexpr bool GATHER = false; };
struct AGather { static constexpr bool GATHER = true; };
template <class Epi, class Sched, bool ALIGN_EPI = false, bool SP2 = false, class BMap = BNat, class AMap = ANat>
__device__ __forceinline__ void gemm_phase(PG8_LAS unsigned char* lds, const Gemm g, const Sched& S, const Epi& E) {
    int tid_ = threadIdx.x; asm volatile("" : "+v"(tid_));
    const int tid = tid_, wid = __builtin_amdgcn_readfirstlane(tid >> 6), lane = tid & 63, wr = wid >> 2, wc = wid & 3, fr = lane & 15, fq = lane >> 4;
    const int K = g.K; int nt_ = K / BK; asm volatile("" : "+s"(nt_)); const int nt = nt_;
    unsigned voffA[2], voffB[2], cA_[2]; int rA_[2];
#pragma unroll
    for (int i = 0; i < 2; ++i) { int R, C; stage_rc(tid * 16 + i * 8192, R, C); const int Rb = Epi::PERM ? ((R & ~31) + perm32(R & 31)) : R;
        voffA[i] = (unsigned)(R * K + C) * 2u; voffB[i] = (unsigned)(BMap::row(Rb) * K + C) * 2u; rA_[i] = R; cA_[i] = (unsigned)C * 2u; }
    static_assert(SP2 || !AMap::GATHER, "the gathered A operand is wired into the SP2 loop only");
    const size_t hstepA = AMap::GATHER ? (size_t)0 : (size_t)HALF * K * 2;
    const size_t kstep = (size_t)(BK * 2);
    const size_t hstep = (size_t)HALF * K * 2;
    const size_t tstep = 2 * hstep; const size_t hstepB = BMap::hstep(K);
    const unsigned ldsw = (unsigned)wid * 1024u;
    const int aoff = lds_byte(wr * 64 + fr, fq * 8), boff = lds_byte(wc * 32 + fr, fq * 8);
#define PG8_SA(b, h) (((b) * 2 + (h)) * HTB)
#define PG8_SB(b, h) ((4 + (b) * 2 + (h)) * HTB)
#define PG8_STAGE(bufoff, gbase, voff) do { _Pragma("unroll") for (int _i = 0; _i < 2; ++_i) \
        __builtin_amdgcn_global_load_lds((const unsigned*)((const char*)(gbase) + (voff)[_i]), (PG8_LAS unsigned*)(lds + (bufoff) + ldsw + _i * 8192), 16, 0, 0); } while (0)
#define PG8_LDA(dst, b, h) do { _Pragma("unroll") for (int m = 0; m < 4; ++m) _Pragma("unroll") for (int k = 0; k < 2; ++k) dst[m][k] = *(const PG8_LAS bf16x8*)(lds + PG8_SA(b, h) + aoff + m * 2048 + k * 1024); } while (0)
#define PG8_LDB(dst, b, h) do { _Pragma("unroll") for (int n = 0; n < 2; ++n) _Pragma("unroll") for (int k = 0; k < 2; ++k) dst[n][k] = *(const PG8_LAS bf16x8*)(lds + PG8_SB(b, h) + boff + n * 2048 + k * 1024); } while (0)
#define PG8_MMA(ai, bj, At, Bt) do { __builtin_amdgcn_s_setprio(1); _Pragma("unroll") for (int m = 0; m < 4; ++m) _Pragma("unroll") for (int n = 0; n < 2; ++n) _Pragma("unroll") for (int k = 0; k < 2; ++k) \
        acc[ai][bj][m][n] = __builtin_amdgcn_mfma_f32_16x16x32_bf16(Bt[n][k], At[m][k], acc[ai][bj][m][n], 0, 0, 0); __builtin_amdgcn_s_setprio(0); } while (0)
#define PG8_WAIT_V(n) asm volatile("s_waitcnt vmcnt(" #n ")" ::: "memory")
#define PG8_WAIT_L(n) asm volatile("s_waitcnt lgkmcnt(" #n ")" ::: "memory")
#define PG8_BAR __builtin_amdgcn_s_barrier()
#define PG8_SCHED __builtin_amdgcn_sched_barrier(0)
    Unit cur, nxt; int ui = 0;
    if (!S.next(0, cur)) return;
    f32x4 acc[2][2][4][2];
#pragma unroll
    for (int a = 0; a < 2; ++a)
#pragma unroll
        for (int b = 0; b < 2; ++b)
#pragma unroll
            for (int m = 0; m < 4; ++m)
#pragma unroll
                for (int n = 0; n < 2; ++n) acc[a][b][m][n] = (f32x4){0.f, 0.f, 0.f, 0.f};
    bf16x8 At[4][2], B0[2][2], B1[2][2];
    const char* cA = (const char*)g.A + (AMap::GATHER ? (size_t)0 : (size_t)cur.pm * tstep); const char* cB = (const char*)g.Bt + BMap::tile(cur.pn, K);
    S.a_ready(cur);
#define PG8_AOFFS(U, V0, V1) do { _Pragma("unroll") for (int _i = 0; _i < 2; ++_i) { V0[_i] = (unsigned)S.a_row(U, 0, rA_[_i]) * (unsigned)(K * 2) + cA_[_i]; V1[_i] = (unsigned)S.a_row(U, 1, rA_[_i]) * (unsigned)(K * 2) + cA_[_i]; } } while (0)
    unsigned cv0[2], cv1[2], nv0[2], nv1[2];
    if constexpr (AMap::GATHER) { PG8_AOFFS(cur, cv0, cv1); } else { cv0[0] = voffA[0]; cv0[1] = voffA[1]; cv1[0] = voffA[0]; cv1[1] = voffA[1]; }
    nv0[0] = cv0[0]; nv0[1] = cv0[1]; nv1[0] = cv1[0]; nv1[1] = cv1[1];
    if constexpr (SP2) {
        PG8_STAGE(PG8_SB(0, 0), cB, voffB); PG8_STAGE(PG8_SB(0, 1), cB + hstepB, voffB); PG8_STAGE(PG8_SA(0, 0), cA, cv0); PG8_STAGE(PG8_SA(0, 1), cA + hstepA, cv1);
        if (wr == 1) PG8_BAR;
        PG8_WAIT_V(2); PG8_BAR;
        PG8_STAGE(PG8_SB(1, 0), cB + kstep, voffB); PG8_STAGE(PG8_SA(1, 0), cA + kstep, cv0); PG8_STAGE(PG8_SB(1, 1), cB + hstepB + kstep, voffB);
        PG8_WAIT_V(6); PG8_BAR;
    } else {
        PG8_STAGE(PG8_SB(0, 0), cB, voffB); PG8_STAGE(PG8_SA(0, 0), cA, voffA); PG8_STAGE(PG8_SB(0, 1), cB + hstepB, voffB); PG8_STAGE(PG8_SA(0, 1), cA + hstep, voffA);
        if (wr == 1) PG8_BAR;
        PG8_WAIT_V(4); PG8_BAR;
        PG8_STAGE(PG8_SB(1, 0), cB + kstep, voffB); PG8_STAGE(PG8_SA(1, 0), cA + kstep, voffA); PG8_STAGE(PG8_SB(1, 1), cB + hstepB + kstep, voffB);
        PG8_WAIT_V(6); PG8_BAR;
    }
    for (;;) {
        const bool has_next = S.next(ui + 1, nxt);
        const char* nA = has_next ? (const char*)g.A + (AMap::GATHER ? (size_t)0 : (size_t)nxt.pm * tstep) : cA;
        if constexpr (AMap::GATHER) { if (has_next) { PG8_AOFFS(nxt, nv0, nv1); } else { nv0[0] = cv0[0]; nv0[1] = cv0[1]; nv1[0] = cv1[0]; nv1[1] = cv1[1]; } } const char* nB = has_next ? (const char*)g.Bt + BMap::tile(nxt.pn, K) : cB;
        for (int t = 0; t < nt; t += 2) {
            const bool last = (t == nt - 2);
            const char* a1 = cA + (size_t)(t + 1) * kstep;
            const char* a2 = last ? nA : cA + (size_t)(t + 2) * kstep; const char* b2 = last ? nB : cB + (size_t)(t + 2) * kstep;
            const char* a3 = a2 + kstep; const char* b3 = b2 + kstep;
            if (last && has_next) S.a_ready(nxt);
            unsigned sv0[2], sv1[2]; sv0[0] = last ? nv0[0] : cv0[0]; sv0[1] = last ? nv0[1] : cv0[1]; sv1[0] = last ? nv1[0] : cv1[0]; sv1[1] = last ? nv1[1] : cv1[1];
            if constexpr (SP2) {
            PG8_LDB(B0, 0, 0); PG8_LDB(B1, 0, 1); PG8_SCHED; PG8_LDA(At, 0, 0); PG8_STAGE(PG8_SA(1, 1), a1 + hstepA, cv1);
            PG8_WAIT_V(8); PG8_WAIT_L(0); PG8_BAR; PG8_MMA(0, 0, At, B0); PG8_MMA(0, 1, At, B1); PG8_BAR; PG8_SCHED;
            PG8_LDA(At, 0, 1); PG8_STAGE(PG8_SB(0, 0), b2, voffB); PG8_STAGE(PG8_SB(0, 1), b2 + hstepB, voffB); PG8_STAGE(PG8_SA(0, 0), a2, sv0);
            PG8_WAIT_V(8); PG8_WAIT_L(0); PG8_BAR; PG8_MMA(1, 0, At, B0); PG8_MMA(1, 1, At, B1); PG8_BAR; PG8_SCHED;
            PG8_LDB(B0, 1, 0); PG8_LDB(B1, 1, 1); PG8_SCHED; PG8_LDA(At, 1, 0); PG8_STAGE(PG8_SA(0, 1), a2 + hstepA, sv1);
            PG8_WAIT_V(8); PG8_WAIT_L(0); PG8_BAR; PG8_MMA(0, 0, At, B0); PG8_MMA(0, 1, At, B1); PG8_BAR; PG8_SCHED;
            PG8_LDA(At, 1, 1); PG8_STAGE(PG8_SB(1, 0), b3, voffB); PG8_STAGE(PG8_SB(1, 1), b3 + hstepB, voffB); PG8_STAGE(PG8_SA(1, 0), a3, sv0);
            PG8_WAIT_V(8); PG8_WAIT_L(0); PG8_BAR; PG8_MMA(1, 0, At, B0); PG8_MMA(1, 1, At, B1); PG8_BAR; PG8_SCHED;
            } else {
            PG8_LDB(B0, 0, 0); PG8_SCHED; PG8_LDA(At, 0, 0); PG8_STAGE(PG8_SA(1, 1), a1 + hstep, voffA);
            PG8_WAIT_L(8); PG8_BAR; PG8_WAIT_L(0); PG8_MMA(0, 0, At, B0); PG8_BAR; PG8_SCHED;
            PG8_LDB(B1, 0, 1); PG8_STAGE(PG8_SB(0, 0), b2, voffB);
            PG8_BAR; PG8_WAIT_L(0); PG8_MMA(0, 1, At, B1); PG8_BAR;
            PG8_LDA(At, 0, 1); PG8_STAGE(PG8_SA(0, 0), a2, voffA);
            PG8_BAR; PG8_WAIT_L(0); PG8_MMA(1, 0, At, B0); PG8_BAR; PG8_SCHED;
            PG8_STAGE(PG8_SB(0, 1), b2 + hstepB, voffB);
            PG8_WAIT_V(6); PG8_BAR; PG8_MMA(1, 1, At, B1); PG8_BAR;
            PG8_LDB(B0, 1, 0); PG8_SCHED; PG8_LDA(At, 1, 0); PG8_STAGE(PG8_SA(0, 1), a2 + hstep, voffA);
            PG8_WAIT_L(8); PG8_BAR; PG8_WAIT_L(0); PG8_MMA(0, 0, At, B0); PG8_BAR; PG8_SCHED;
            PG8_LDB(B1, 1, 1); PG8_STAGE(PG8_SB(1, 0), b3, voffB);
            PG8_BAR; PG8_WAIT_L(0); PG8_MMA(0, 1, At, B1); PG8_BAR;
            PG8_LDA(At, 1, 1); PG8_STAGE(PG8_SA(1, 0), a3, voffA);
            PG8_BAR; PG8_WAIT_L(0); PG8_MMA(1, 0, At, B0); PG8_BAR; PG8_SCHED;
            PG8_STAGE(PG8_SB(1, 1), b3 + hstepB, voffB);
            PG8_WAIT_V(6); PG8_BAR; PG8_MMA(1, 1, At, B1); PG8_BAR;
            }
            if constexpr (Epi::MID_TILE > 0) { if (t + 2 == Epi::MID_TILE) E.mid(acc, cur, wr, wc, fr, fq); }
        }
        if constexpr (ALIGN_EPI) { if (wr == 0) PG8_BAR; }
        if constexpr (!Epi::AFTER_DRAIN) { E(acc, cur, wr, wc, fr, fq); S.done(cur); }
        if (!has_next) break;
#pragma unroll
        for (int a = 0; a < 2; ++a)
#pragma unroll
            for (int b = 0; b < 2; ++b)
#pragma unroll
                for (int m = 0; m < 4; ++m)
#pragma unroll
                    for (int n = 0; n < 2; ++n) acc[a][b][m][n] = (f32x4){0.f, 0.f, 0.f, 0.f};
        cur = nxt; cA = nA; cB = nB; ++ui; cv0[0] = nv0[0]; cv0[1] = nv0[1]; cv1[0] = nv1[0]; cv1[1] = nv1[1];
        if constexpr (ALIGN_EPI) { if (wr == 1) PG8_BAR; }
    }
    PG8_WAIT_V(0);
    if constexpr (!ALIGN_EPI) { if (wr == 0) PG8_BAR; }
    PG8_BAR;
    if constexpr (Epi::AFTER_DRAIN) { E.fused(acc, cur, wr, wc, fr, fq, lds, wid, lane); S.done(cur); }
#undef PG8_SA
#undef PG8_AOFFS
#undef PG8_SB
#undef PG8_STAGE
#undef PG8_LDA
#undef PG8_LDB
#undef PG8_MMA
#undef PG8_WAIT_V
#undef PG8_WAIT_L
#undef PG8_BAR
#undef PG8_SCHED
}
}
constexpr int NWAVES = 8;
constexpr int NB = 8, T = 4096, D = 1024, NTOK = NB * T;
constexpr int DA = 512, DF = 512, NH = 8, HD = 64, GW = 64, ROWS = 64, WH = 8, WW = 16;
constexpr int NPROJ = 2048, NE = 32, DE = 256;
constexpr int MAXROWS = 73728;
constexpr float EPS = 1e-6f, LOG2E = 1.4426950408889634f, QSCALE = 0.125f * LOG2E;
constexpr size_t MiB = 1u << 20;
constexpr size_t WS_CTL = 0, CTL_ZERO_BYTES = 1 * MiB;
constexpr size_t WS_WIN = 2 * MiB, WS_WOUT = 6 * MiB, WS_WGU = 8 * MiB, WS_WD = 40 * MiB, WS_WR = 56 * MiB  , WS_MIXT = 57 * MiB  , WS_DFT1 = WS_MIXT + 256 * 1024  ,
                 WS_T2 = WS_MIXT + 320 * 1024  , WS_TW = WS_MIXT + 384 * 1024  ;
constexpr size_t WS_ROUTE = 58 * MiB;
constexpr size_t WS_LIST = 128 * MiB;
constexpr size_t WS_SSQ = 60 * MiB;
constexpr size_t WS_META = 59 * MiB;
constexpr size_t WS_XN = 64 * MiB;
constexpr size_t WS_QKVU = 128 * MiB;
constexpr size_t WS_X1 = 256 * MiB;
constexpr size_t WS_MF = 384 * MiB;
constexpr size_t WS_HD = 388 * MiB;
constexpr size_t WS_END = 512 * MiB;
constexpr int CW_BAR = 4096, CW_CNT = 16384;
constexpr int RING_BYTES = 131072, RT_STRIDE = 2064  , RT_BYTES = 72 * RT_STRIDE, LDSCTL_OFF = 149504, LDS_BYTES = 155648;
constexpr int L_MISC = LDSCTL_OFF;
constexpr int L_PBASE = LDSCTL_OFF + 256;
constexpr int L_LCNT = LDSCTL_OFF + 512;
constexpr int L_GBASE = LDSCTL_OFF + 768;
constexpr int L_RT = LDSCTL_OFF + 1024;
static_assert(RT_BYTES <= LDSCTL_OFF && 8 * 16512 <= LDSCTL_OFF && RING_BYTES <= LDSCTL_OFF && L_RT + 7 * 128 * 4 <= LDS_BYTES, "LDS map");

#define LAS __attribute__((address_space(3)))
typedef unsigned short bf16;
typedef unsigned v4u __attribute__((ext_vector_type(4)));
typedef unsigned v2u __attribute__((ext_vector_type(2)));
typedef float f32x4 __attribute__((ext_vector_type(4)));
#define LDS_WAIT() asm volatile("s_waitcnt lgkmcnt(0)" ::: "memory")
#define VM_WAIT() asm volatile("s_waitcnt vmcnt(0)" ::: "memory")
__device__ __forceinline__ unsigned f2bf(float f) { unsigned u = __builtin_bit_cast(unsigned, f); return (u + 0x7fffu + ((u >> 16) & 1u)) >> 16; }
__device__ __forceinline__ unsigned pk2(float lo, float hi) { return f2bf(lo) | (f2bf(hi) << 16); }
typedef float f32x2_t __attribute__((ext_vector_type(2))); typedef __bf16 bf16x2_t __attribute__((ext_vector_type(2)));
__device__ __forceinline__ unsigned cvtpk(float lo, float hi) { f32x2_t v = {lo, hi}; bf16x2_t b = __builtin_convertvector(v, bf16x2_t); return __builtin_bit_cast(unsigned, b); }
__device__ __forceinline__ float bf2f(unsigned short b) { return __builtin_bit_cast(float, (unsigned)b << 16); }
__device__ __forceinline__ float bflo(unsigned w) { return __builtin_bit_cast(float, w << 16); }
__device__ __forceinline__ float bfhi(unsigned w) { return __builtin_bit_cast(float, w & 0xffff0000u); }
__device__ __forceinline__ float wave_sum(float v) {
#pragma unroll
    for (int o = 1; o < 64; o <<= 1) v += __shfl_xor(v, o);
    return v;
}
#define XB_TMO      128
#define XB_XCNT(j)  (256  + 64 * (j))
#define XB_XSUB(j)  (1280 + 64 * (j))
#define XB_XGEN(j)  (2304 + 64 * (j))
#define XB_TOP      3328
#define XB_TOPGEN   3392
#define XCD_BAR_WORDS 3456
#define XB_SPIN_CAP (1u << 18)

__device__ __forceinline__ unsigned xb_ld(unsigned* p)              { return __hip_atomic_load(p, __ATOMIC_RELAXED, __HIP_MEMORY_SCOPE_AGENT); }
__device__ __forceinline__ unsigned xb_add(unsigned* p, unsigned v) { return __hip_atomic_fetch_add(p, v, __ATOMIC_RELAXED, __HIP_MEMORY_SCOPE_AGENT); }
__device__ __forceinline__ unsigned xb_xcc_id() { return (unsigned)__builtin_amdgcn_s_getreg((3 << 11) | 20) & 0xFu; }
#define XB_SPIN(cond, bar) do { unsigned _sp = 0; while (cond) { __builtin_amdgcn_s_sleep(1); \
    if ((++_sp & 255u) == 0u) { if (xb_ld(&(bar)[XB_TMO])) break; if (_sp > XB_SPIN_CAP) { atomicAdd(&(bar)[XB_TMO], 1u); break; } } } } while (0)

struct XcdBarrier {
    unsigned* bar; unsigned x;
    volatile LAS unsigned* st;
};

__device__ __forceinline__ XcdBarrier xcd_barrier_post(unsigned* bar, volatile LAS unsigned* st) {
    XcdBarrier b; b.bar = bar; b.x = xb_xcc_id(); b.st = st;
    if (threadIdx.x == 0) (void)xb_add(&bar[XB_XCNT(b.x)], 1u);
    return b;
}
__device__ __forceinline__ void xcd_barrier_complete(unsigned* bar, unsigned x, unsigned& nloc, unsigned& nx) {
    const unsigned G = gridDim.x * gridDim.y * gridDim.z;
    unsigned sum, cnt, mine, sp = 0u;
    for (;;) {
        sum = 0u; cnt = 0u; mine = 0u;
#pragma unroll
        for (unsigned j = 0; j < 16; ++j) { const unsigned c = xb_ld(&bar[XB_XCNT(j)]); sum += c; cnt += (c > 0u) ? 1u : 0u; mine = (j == x) ? c : mine; }
        if (sum == G) break;
        __builtin_amdgcn_s_sleep(1);
        if ((++sp & 255u) == 0u) { if (xb_ld(&bar[XB_TMO])) break; if (sp > XB_SPIN_CAP) { atomicAdd(&bar[XB_TMO], 1u); break; } }
    }
    nloc = mine > 0u ? mine : 1u; nx = cnt > 0u ? cnt : 1u;
}

__device__ __forceinline__ void xcd_barrier(const XcdBarrier& b) {
    asm volatile("s_waitcnt vmcnt(0)" ::: "memory");
    __syncthreads();
    if (threadIdx.x == 0) {
        unsigned* bar = b.bar;
        __builtin_amdgcn_s_waitcnt(0);
        unsigned nloc = b.st[0], nx = b.st[1];
        if (nloc == 0u) { xcd_barrier_complete(bar, b.x, nloc, nx); b.st[0] = nloc; b.st[1] = nx; }
        const unsigned old = xb_add(&bar[XB_XSUB(b.x)], 1u);
        const unsigned gen = old / nloc;
        if (old + 1u == (gen + 1u) * nloc) {
            __builtin_amdgcn_fence(__ATOMIC_RELEASE, "agent");
            asm volatile("s_waitcnt vmcnt(0)" ::: "memory");
            const unsigned og = xb_add(&bar[XB_TOP], 1u);
            const unsigned tg = og / nx;
            if (og + 1u == (tg + 1u) * nx) xb_add(&bar[XB_TOPGEN], 1u);
            else XB_SPIN(xb_ld(&bar[XB_TOPGEN]) == tg, bar);
            __builtin_amdgcn_fence(__ATOMIC_ACQUIRE, "agent");
            xb_add(&bar[XB_XGEN(b.x)], 1u);
            asm volatile("s_waitcnt vmcnt(0)" ::: "memory");
        } else {
            XB_SPIN(xb_ld(&bar[XB_XGEN(b.x)]) == gen, bar);
            __builtin_amdgcn_fence(__ATOMIC_ACQUIRE, "agent");
            asm volatile("s_waitcnt vmcnt(0)" ::: "memory");
        }
    }
    __syncthreads();
}
struct Args { const float* in[18]; float* out; unsigned char* ws; };
struct Frame {
    LAS unsigned char* lds; unsigned* ctl; unsigned char* ws; float* out;
    int tid, lane, wave, vcu, G;
};
#define GW_ID(F) ((F).vcu * NWAVES + (F).wave)
#define N_GW(F) ((F).G * NWAVES)

__device__ __forceinline__ void tr_item(const float* W, int K, int N, bf16* WT, int drow, const float* kscale, LAS float* scr, int k0, int n0, int lane) {
    float v[32];
#pragma unroll
    for (int i = 0; i < 32; ++i) v[i] = W[(size_t)(k0 + 2 * i + (lane >> 5)) * N + n0 + (lane & 31)];
    if (kscale) {
#pragma unroll
        for (int i = 0; i < 32; ++i) v[i] *= kscale[k0 + 2 * i + (lane >> 5)];
    }
#pragma unroll
    for (int i = 0; i < 32; ++i) scr[(2 * i + (lane >> 5)) * 33 + (lane & 31)] = v[i];
    LDS_WAIT(); asm volatile("" ::: "memory");
    const int c = lane & 7;
#pragma unroll
    for (int j = 0; j < 4; ++j) { const int n = (lane >> 3) + 8 * j; const LAS float* s = scr + (8 * c) * 33 + n;
        v4u o; o.x = pk2(s[0 * 33], s[1 * 33]); o.y = pk2(s[2 * 33], s[3 * 33]); o.z = pk2(s[4 * 33], s[5 * 33]); o.w = pk2(s[6 * 33], s[7 * 33]);
        *(v4u*)(WT + (size_t)(drow + n) * K + k0 + 8 * c) = o; }
    LDS_WAIT(); asm volatile("" ::: "memory");
}
__device__ __forceinline__ void phase_prep(Frame& F, const Args& A) {
    LAS float* scr = (LAS float*)(F.lds + F.wave * 16384);
    const int gw = GW_ID(F), NGW = N_GW(F), lane = F.lane;
    bf16* WinT = (bf16*)(F.ws + WS_WIN); bf16* WoutT = (bf16*)(F.ws + WS_WOUT); bf16* Wgu = (bf16*)(F.ws + WS_WGU); bf16* Wd = (bf16*)(F.ws + WS_WD);
    constexpr int I_IN = 16 * 64, I_OUT = 16 * 32, I_G = 32 * 128, I_D = 32 * 128, NITEMS = I_IN + I_OUT + 2 * I_G + I_D;
    for (int it = gw; it < NITEMS; it += NGW) {
        int r = it;
        if (r < I_IN) { const int n0 = 32 * (r % 64), seg = n0 >> 9; const int drow = seg == 2 ? n0 + 512 : seg == 3 ? n0 - 512 : n0;
            tr_item(A.in[2], 1024, 2048, WinT, drow, nullptr, scr, 64 * (r / 64), n0, lane); continue; } r -= I_IN;
        if (r < I_OUT) { tr_item(A.in[8], 1024, 1024, WoutT, 32 * (r % 32), (r / 32) < 8 ? A.in[6] : nullptr, scr, 64 * (r / 32), 32 * (r % 32), lane); continue; } r -= I_OUT;
        if (r < 2 * I_G) { const int up = r >= I_G ? 1 : 0; r -= up * I_G; const int e = r / 128, q = r % 128, kb = q / 8, n0 = 32 * (q % 8);
            tr_item(A.in[14 + up] + (size_t)e * 1024 * 256, 1024, 256, Wgu, e * 512 + (n0 / 128) * 256 + up * 128 + (n0 % 128), A.in[9], scr, 64 * kb, n0, lane); continue; } r -= 2 * I_G;
        { const int e = r / 128, q = r % 128, kb = q / 32, n0 = 32 * (q % 32);
            tr_item(A.in[16] + (size_t)e * 256 * 1024, 256, 1024, Wd + (size_t)e * 1024 * 256, n0, nullptr, scr, 64 * kb, n0, lane); }
    }
    { const float* g = A.in[1]; bf16* XN = (bf16*)(F.ws + WS_XN);
      f32x4 gv[4];
#pragma unroll
      for (int j = 0; j < 4; ++j) gv[j] = ((const f32x4*)g)[64 * j + lane];
      for (int m = gw; m < NTOK; m += 2 * NGW) {
        const int m2 = m + NGW;
        const f32x4* xr = (const f32x4*)(A.in[0] + (size_t)m * D) + lane; const f32x4* xr2 = (const f32x4*)(A.in[0] + (size_t)(m2 < NTOK ? m2 : m) * D) + lane; f32x4 v[4], w2[4]; float s = 0.f, s2 = 0.f;
#pragma unroll
        for (int j = 0; j < 4; ++j) { v[j] = xr[64 * j]; w2[j] = xr2[64 * j]; }
#pragma unroll
        for (int j = 0; j < 4; ++j) { s += (v[j].x * v[j].x + v[j].y * v[j].y) + (v[j].z * v[j].z + v[j].w * v[j].w); s2 += (w2[j].x * w2[j].x + w2[j].y * w2[j].y) + (w2[j].z * w2[j].z + w2[j].w * w2[j].w); }
        const float rstd = 1.0f / sqrtf(wave_sum(s) * (1.f / D) + EPS), rstd2 = 1.0f / sqrtf(wave_sum(s2) * (1.f / D) + EPS);
        unsigned long long* o8 = (unsigned long long*)(XN + (size_t)m * D) + lane;
#pragma unroll
        for (int j = 0; j < 4; ++j) { const f32x4 w = v[j] * rstd * gv[j]; o8[64 * j] = (unsigned long long)pk2(w.x, w.y) | ((unsigned long long)pk2(w.z, w.w) << 32); }
        if (m2 < NTOK) { unsigned long long* p8 = (unsigned long long*)(XN + (size_t)m2 * D) + lane;
#pragma unroll
            for (int j = 0; j < 4; ++j) { const f32x4 w = w2[j] * rstd2 * gv[j]; p8[64 * j] = (unsigned long long)pk2(w.x, w.y) | ((unsigned long long)pk2(w.z, w.w) << 32); } }
      } }
    { bf16* WRH = (bf16*)(F.ws + WS_WR); bf16* WRL = WRH + 36 * 1024; const float* nm = A.in[9];
      for (int i = gw * 64 + lane; i < 36 * 1024; i += NGW * 64) { const int j = i / 1024, k = i % 1024; const float w = nm[k] * (j < 4 ? A.in[10][k * 4 + j] : A.in[12][k * 32 + (j - 4)]);
          const unsigned hi = f2bf(w); WRH[i] = (bf16)hi; WRL[i] = (bf16)f2bf(w - __builtin_bit_cast(float, hi << 16)); } }
    { bf16* DFT1 = (bf16*)(F.ws + WS_DFT1); bf16* T2 = (bf16*)(F.ws + WS_T2); float* TW = (float*)(F.ws + WS_TW); bf16* MIXT = (bf16*)(F.ws + WS_MIXT); const float* wf = A.in[4];
      for (int i = gw * 64 + lane; i < 128 * 64; i += NGW * 64) { const int m = i >> 6, t1 = i & 63; const float ph = (float)(((m & 63) * t1) & 63) * (1.f / 64.f);
          DFT1[i] = (bf16)f2bf(m < 64 ? __builtin_amdgcn_cosf(ph) : -__builtin_amdgcn_sinf(ph)); }
      for (int i = gw * 64 + lane; i < 2 * 64 * 128; i += NGW * 64) { const int part = i >> 13, k2 = (i >> 7) & 63, k = i & 127, t2 = k & 63; const float ph = (float)((k2 * t2) & 63) * (1.f / 64.f);
          const float cs = __builtin_amdgcn_cosf(ph), sn = __builtin_amdgcn_sinf(ph); T2[i] = (bf16)f2bf(part == 0 ? (k < 64 ? cs : sn) : (k < 64 ? -sn : cs)); }
      for (int i = gw * 64 + lane; i < 64 * 64; i += NGW * 64) { const int t2 = i >> 6, k1 = i & 63; const float ph = (float)(t2 * k1) * (1.f / 4096.f); TW[2 * i] = __builtin_amdgcn_cosf(ph); TW[2 * i + 1] = -__builtin_amdgcn_sinf(ph); }
      for (int i = gw * 64 + lane; i < 8 * 64 * 128; i += NGW * 64) { const int grp = i >> 13, d = (i >> 7) & 63, k = i & 127, s = k >> 5, gg = (k >> 3) & 3, jj = k & 7;
          const int c = 32 * (s & 1) + (jj < 4 ? 4 * gg + jj : 16 + 4 * gg + jj - 4); float a = 0.f;
          for (int e = 0; e < 64; ++e) { const float ph = (float)((c * e) & 63) * (1.f / 64.f); a += ((s >> 1) ? __builtin_amdgcn_sinf(ph) : __builtin_amdgcn_cosf(ph)) * wf[(grp * 64 + e) * 64 + d]; }
          MIXT[i] = (bf16)f2bf(a * (1.f / 512.f)); } }
}

__device__ __forceinline__ void phase_attn(Frame& F, const Args& A) {
    typedef short bf16x8 __attribute__((ext_vector_type(8)));
    constexpr int SLOT = 16384, NSLOT = 9, BT_OFF = NSLOT * SLOT;
    static_assert(BT_OFF + 15 * 32 * 4 <= LDSCTL_OFF, "attention LDS map");
    const bf16* Q = (const bf16*)(F.ws + WS_QKVU); const bf16* Kb = Q + (size_t)NTOK * 512; const bf16* VT = Q + (size_t)3 * NTOK * 512;
    bf16* mg = (bf16*)(F.ws + WS_X1); float* ssq = (float*)(F.ws + WS_SSQ);
    const int tid = F.tid, lane = F.lane, q16 = lane & 15, g = lane >> 4, rowsel = F.wave >> 2, j = F.wave & 3;
    const int cb = (j == 0) ? 0 : (j == 1) ? 8 : (j == 2) ? 24 : 32, c = 16 * j + q16, cs = min(max(c - WW / 2, 0), GW - WW);
    unsigned koff[2][2], voff[4], dcoff[2][4];
#pragma unroll
    for (int t = 0; t < 2; ++t) { const int col = cb + 8 * (q16 >> 2) + 4 * t + (q16 & 3), fk = ((col >> 3) & 3) + 4 * ((col >> 1) & 1);
#pragma unroll
        for (int ks = 0; ks < 2; ++ks) koff[t][ks] = (unsigned)(col * 128 + (((4 * ks + g) ^ fk) << 4));
#pragma unroll
        for (int e = 0; e < 4; ++e) { const int kc = cb + 8 * g + 4 * t + e; const bool ok = (kc >= cs) && (kc <= cs + WW - 1); dcoff[t][e] = (unsigned)((ok ? (kc - c + WW - 1) : 31) * 4); } }
#pragma unroll
    for (int dt = 0; dt < 4; ++dt) { const int dh = 16 * dt + q16; voff[dt] = (unsigned)(8192 + dh * 128 + ((((cb >> 3) + g) ^ ((dh >> 1) & 7)) << 4)); }
    const int scol = tid >> 3, sch = tid & 7;
    const unsigned sK = (unsigned)(scol * 128 + ((sch ^ (((scol >> 3) & 3) + 4 * ((scol >> 1) & 1))) << 4)), sV = (unsigned)(8192 + scol * 128 + ((sch ^ ((scol >> 1) & 7)) << 4));
    LAS float* bt = (LAS float*)(F.lds + BT_OFF);
    for (int task = F.vcu; task < NB * NH * 4; task += F.G) {
        const int b = task >> 5, h = (task >> 2) & 7, r0 = 16 * (task & 3);
        __syncthreads();
        if (tid < 15 * 32) { const int dc = tid & 31, dr = tid >> 5; bt[tid] = (dc < 31) ? LOG2E * A.in[3][(h * 15 + dr) * 31 + dc] : -1e30f; }
        const bf16* gK = Kb + ((size_t)b * T + scol) * 512 + h * HD + sch * 8;
        const bf16* gV = VT + (size_t)(h * HD + scol) * NTOK + (size_t)b * T + sch * 8;
        int loaded_hi = min(max(r0 + 1 - WH / 2, 0), ROWS - WH) + WH - 1;
        for (int kr = min(max(r0 - WH / 2, 0), ROWS - WH); kr <= loaded_hi; ++kr) { const v4u kv = *(const v4u*)(gK + (size_t)kr * GW * 512), vv = *(const v4u*)(gV + kr * GW);
            const int so = (kr % NSLOT) * SLOT; *(LAS v4u*)(F.lds + so + sK) = kv; *(LAS v4u*)(F.lds + so + sV) = vv; }
        bf16x8 qn[2];
        { const size_t qtok = (size_t)b * T + (r0 + rowsel) * GW + c;
#pragma unroll
          for (int ks = 0; ks < 2; ++ks) qn[ks] = *(const bf16x8*)(Q + qtok * 512 + h * HD + 32 * ks + 8 * g); }
        __syncthreads();
#pragma unroll 1
        for (int s = 0; s < 8; ++s) {
            const int r = r0 + 2 * s + rowsel, rs = min(max(r - WH / 2, 0), ROWS - WH);
            const size_t qtok = (size_t)b * T + r * GW + c;
            bf16x8 qf[2]; qf[0] = qn[0]; qf[1] = qn[1];
            const int nhi = (s < 7) ? min(max(r0 + 2 * s + 3 - WH / 2, 0), ROWS - WH) + WH - 1 : loaded_hi; const int n_new = nhi - loaded_hi;
            v4u pk0 = {0u, 0u, 0u, 0u}, pv0 = pk0, pk1 = pk0, pv1 = pk0;
            if (n_new >= 1) { pk0 = *(const v4u*)(gK + (size_t)(loaded_hi + 1) * GW * 512); pv0 = *(const v4u*)(gV + (loaded_hi + 1) * GW); }
            if (n_new >= 2) { pk1 = *(const v4u*)(gK + (size_t)(loaded_hi + 2) * GW * 512); pv1 = *(const v4u*)(gV + (loaded_hi + 2) * GW); }
            if (s < 7) { const size_t qt2 = qtok + 2 * GW;
#pragma unroll
                for (int ks = 0; ks < 2; ++ks) qn[ks] = *(const bf16x8*)(Q + qt2 * 512 + h * HD + 32 * ks + 8 * g); }
            const LAS unsigned char* btr = (const LAS unsigned char*)bt + (rs - r + WH - 1) * 128;
            int sl = rs % NSLOT;
            float sc[8][2][4]; float mx = -1e30f;
#pragma unroll
            for (int i = 0; i < 8; ++i) {
                const LAS unsigned char* sb = F.lds + sl * SLOT; sl = (sl + 1 == NSLOT) ? 0 : sl + 1;
#pragma unroll
                for (int t = 0; t < 2; ++t) {
                    f32x4 a = {0.f, 0.f, 0.f, 0.f};
                    a = __builtin_amdgcn_mfma_f32_16x16x32_bf16(*(const LAS bf16x8*)(sb + koff[t][0]), qf[0], a, 0, 0, 0);
                    a = __builtin_amdgcn_mfma_f32_16x16x32_bf16(*(const LAS bf16x8*)(sb + koff[t][1]), qf[1], a, 0, 0, 0);
#pragma unroll
                    for (int e = 0; e < 4; ++e) { const float sv = a[e] + *(const LAS float*)(btr + dcoff[t][e] + i * 128); sc[i][t][e] = sv; mx = fmaxf(mx, sv); }
                }
            }
            mx = fmaxf(mx, __shfl_xor(mx, 16)); mx = fmaxf(mx, __shfl_xor(mx, 32));
            float lsum = 0.f; bf16x8 pf[8];
#pragma unroll
            for (int i = 0; i < 8; ++i) {
                float p[2][4];
#pragma unroll
                for (int t = 0; t < 2; ++t)
#pragma unroll
                    for (int e = 0; e < 4; ++e) { p[t][e] = __builtin_amdgcn_exp2f(sc[i][t][e] - mx); lsum += p[t][e]; }
                v4u w; w.x = cvtpk(p[0][0], p[0][1]); w.y = cvtpk(p[0][2], p[0][3]); w.z = cvtpk(p[1][0], p[1][1]); w.w = cvtpk(p[1][2], p[1][3]);
                pf[i] = __builtin_bit_cast(bf16x8, w);
            }
            lsum += __shfl_xor(lsum, 16); lsum += __shfl_xor(lsum, 32);
            f32x4 o[4];
#pragma unroll
            for (int dt = 0; dt < 4; ++dt) o[dt] = (f32x4){0.f, 0.f, 0.f, 0.f};
            sl = rs % NSLOT;
#pragma unroll
            for (int i = 0; i < 8; ++i) {
                const LAS unsigned char* sb = F.lds + sl * SLOT; sl = (sl + 1 == NSLOT) ? 0 : sl + 1;
#pragma unroll
                for (int dt = 0; dt < 4; ++dt) o[dt] = __builtin_amdgcn_mfma_f32_16x16x32_bf16(*(const LAS bf16x8*)(sb + voff[dt]), pf[i], o[dt], 0, 0, 0);
            }
            const float inv = 1.0f / lsum; float sq = 0.f;
#pragma unroll
            for (int dt = 0; dt < 4; ++dt) { const f32x4 v = o[dt] * inv; sq += (v[0] * v[0] + v[1] * v[1]) + (v[2] * v[2] + v[3] * v[3]);
                v2u w; w.x = cvtpk(v[0], v[1]); w.y = cvtpk(v[2], v[3]); *(v2u*)(mg + qtok * D + h * HD + 16 * dt + 4 * g) = w; }
            sq += __shfl_xor(sq, 16); sq += __shfl_xor(sq, 32);
            if (g == 0) ssq[qtok * 8 + h] = sq;
            __syncthreads();
            if (n_new >= 1) { const int so = ((loaded_hi + 1) % NSLOT) * SLOT; *(LAS v4u*)(F.lds + so + sK) = pk0; *(LAS v4u*)(F.lds + so + sV) = pv0; }
            if (n_new >= 2) { const int so = ((loaded_hi + 2) % NSLOT) * SLOT; *(LAS v4u*)(F.lds + so + sK) = pk1; *(LAS v4u*)(F.lds + so + sV) = pv1; }
            loaded_hi = nhi;
            __syncthreads();
        }
    }
    __syncthreads();
}
__device__ __forceinline__ void phase_fft1(Frame& F, const Args& A) {
    typedef short bf16x8 __attribute__((ext_vector_type(8)));
    const bf16* UT = (const bf16*)(F.ws + WS_QKVU) + (size_t)2 * NTOK * 512; const bf16* DFT1 = (const bf16*)(F.ws + WS_DFT1); const float2* TW = (const float2*)(F.ws + WS_TW);
    bf16* X1T = (bf16*)(F.ws + WS_MF);
    const int lane = F.lane, q16 = lane & 15, g = lane >> 4;
    for (int u = GW_ID(F); u < NB * 8 * 32; u += N_GW(F)) {
        const int ct = u & 31, t2b = (u >> 5) & 7, b = u >> 8, ch = 16 * ct + q16;
        bf16x8 bfr[8][2];
#pragma unroll
        for (int t2 = 0; t2 < 8; ++t2)
#pragma unroll
            for (int ks = 0; ks < 2; ++ks) bfr[t2][ks] = *(const bf16x8*)(UT + (size_t)ch * NTOK + (size_t)b * T + (8 * t2b + t2) * 64 + 32 * ks + 8 * g);
#pragma unroll 1
        for (int kt = 0; kt < 4; ++kt) {
            bf16x8 are[2], aim[2];
#pragma unroll
            for (int ks = 0; ks < 2; ++ks) { are[ks] = *(const bf16x8*)(DFT1 + (16 * kt + q16) * 64 + 32 * ks + 8 * g); aim[ks] = *(const bf16x8*)(DFT1 + (64 + 16 * kt + q16) * 64 + 32 * ks + 8 * g); }
            float xr[8][4], xi[8][4];
#pragma unroll
            for (int t2 = 0; t2 < 8; ++t2) {
                f32x4 ar = {0.f, 0.f, 0.f, 0.f}, ai = {0.f, 0.f, 0.f, 0.f};
                ar = __builtin_amdgcn_mfma_f32_16x16x32_bf16(are[0], bfr[t2][0], ar, 0, 0, 0); ar = __builtin_amdgcn_mfma_f32_16x16x32_bf16(are[1], bfr[t2][1], ar, 0, 0, 0);
                ai = __builtin_amdgcn_mfma_f32_16x16x32_bf16(aim[0], bfr[t2][0], ai, 0, 0, 0); ai = __builtin_amdgcn_mfma_f32_16x16x32_bf16(aim[1], bfr[t2][1], ai, 0, 0, 0);
#pragma unroll
                for (int e = 0; e < 4; ++e) { const float2 w = TW[(8 * t2b + t2) * 64 + 16 * kt + 4 * g + e]; xr[t2][e] = ar[e] * w.x - ai[e] * w.y; xi[t2][e] = ar[e] * w.y + ai[e] * w.x; }
            }
#pragma unroll
            for (int e = 0; e < 4; ++e) { const int k1 = 16 * kt + 4 * g + e;
                v4u wr, wi; wr.x = cvtpk(xr[0][e], xr[1][e]); wr.y = cvtpk(xr[2][e], xr[3][e]); wr.z = cvtpk(xr[4][e], xr[5][e]); wr.w = cvtpk(xr[6][e], xr[7][e]);
                wi.x = cvtpk(xi[0][e], xi[1][e]); wi.y = cvtpk(xi[2][e], xi[3][e]); wi.z = cvtpk(xi[4][e], xi[5][e]); wi.w = cvtpk(xi[6][e], xi[7][e]);
                v4u* dst = (v4u*)(X1T + ((((size_t)(b * 64 + k1) * 8 + t2b) * 512 + ch) << 4)); dst[0] = wr; dst[1] = wi; }
        }
    }
}
__device__ __forceinline__ void phase_fft2(Frame& F, const Args& A) {
    typedef short bf16x8 __attribute__((ext_vector_type(8)));
    const bf16* X1T = (const bf16*)(F.ws + WS_MF); const bf16* T2 = (const bf16*)(F.ws + WS_T2); const bf16* MIXT = (const bf16*)(F.ws + WS_MIXT);
    bf16* mg = (bf16*)(F.ws + WS_X1); const float* bfour = A.in[5]; const float* gfour = A.in[7];
    const int lane = F.lane, q16 = lane & 15, g = lane >> 4;
    LAS unsigned char* slab = F.lds + F.wave * 16512;
    for (int u = GW_ID(F); u < NB * 64 * 4; u += N_GW(F)) {
        const int k2t = u & 3, k1 = (u >> 2) & 63, b = u >> 8;
        bf16x8 wb[2][4];
#pragma unroll
        for (int part = 0; part < 2; ++part)
#pragma unroll
            for (int ks = 0; ks < 4; ++ks) wb[part][ks] = *(const bf16x8*)(T2 + (part * 64 + 16 * k2t + q16) * 128 + 32 * ks + 8 * g);
        float ssq = 0.f;
#pragma unroll 1
        for (int grp = 0; grp < 8; ++grp) {
            f32x4 yr[4], yi[4];
#pragma unroll
            for (int ctile = 0; ctile < 4; ++ctile) {
                const int c = grp * 64 + 16 * ctile + q16; bf16x8 af[4];
#pragma unroll
                for (int ks = 0; ks < 4; ++ks) af[ks] = *(const bf16x8*)(X1T + ((((size_t)(b * 64 + k1) * 8 + 4 * (ks & 1) + g) * 512 + c) << 4) + (ks >> 1) * 8);
                f32x4 r = {0.f, 0.f, 0.f, 0.f}, im = {0.f, 0.f, 0.f, 0.f};
#pragma unroll
                for (int ks = 0; ks < 4; ++ks) { r = __builtin_amdgcn_mfma_f32_16x16x32_bf16(af[ks], wb[0][ks], r, 0, 0, 0); im = __builtin_amdgcn_mfma_f32_16x16x32_bf16(af[ks], wb[1][ks], im, 0, 0, 0); }
                yr[ctile] = r; yi[ctile] = im;
            }
            bf16x8 yb[4];
#pragma unroll
            for (int s = 0; s < 4; ++s) { const f32x4 lo = (s < 2) ? yr[2 * (s & 1)] : yi[2 * (s & 1)], hi = (s < 2) ? yr[2 * (s & 1) + 1] : yi[2 * (s & 1) + 1];
                v4u w; w.x = cvtpk(lo[0], lo[1]); w.y = cvtpk(lo[2], lo[3]); w.z = cvtpk(hi[0], hi[1]); w.w = cvtpk(hi[2], hi[3]); yb[s] = __builtin_bit_cast(bf16x8, w); }
#pragma unroll
            for (int dt = 0; dt < 4; ++dt) {
                f32x4 acc = {0.f, 0.f, 0.f, 0.f};
#pragma unroll
                for (int s = 0; s < 4; ++s) { const bf16x8 ma = *(const bf16x8*)(MIXT + ((size_t)(grp * 64 + 16 * dt + q16) << 7) + 32 * s + 8 * g); acc = __builtin_amdgcn_mfma_f32_16x16x32_bf16(ma, yb[s], acc, 0, 0, 0); }
                const f32x4 bv = *(const f32x4*)(bfour + grp * 64 + 16 * dt + 4 * g); acc += bv;
                ssq += (acc[0] * acc[0] + acc[1] * acc[1]) + (acc[2] * acc[2] + acc[3] * acc[3]);
                v2u w; w.x = cvtpk(acc[0], acc[1]); w.y = cvtpk(acc[2], acc[3]);
                *(LAS v2u*)(slab + q16 * 1032 + (grp * 64 + 16 * dt + 4 * g) * 2) = w;
            }
        }
        ssq += __shfl_xor(ssq, 16); ssq += __shfl_xor(ssq, 32);
        const float rstd = 1.0f / sqrtf(ssq * (1.f / 512.f) + EPS);
        LDS_WAIT(); asm volatile("" ::: "memory");
        const f32x4 g0 = *(const f32x4*)(gfour + lane * 8), g1 = *(const f32x4*)(gfour + lane * 8 + 4);
#pragma unroll 4
        for (int row = 0; row < 16; ++row) {
            const float rs = __shfl(rstd, row);
            const v2u a = *(const LAS v2u*)(slab + row * 1032 + lane * 16), c2 = *(const LAS v2u*)(slab + row * 1032 + lane * 16 + 8);
            v4u o; o.x = cvtpk(bflo(a.x) * rs * g0[0], bfhi(a.x) * rs * g0[1]); o.y = cvtpk(bflo(a.y) * rs * g0[2], bfhi(a.y) * rs * g0[3]);
            o.z = cvtpk(bflo(c2.x) * rs * g1[0], bfhi(c2.x) * rs * g1[1]); o.w = cvtpk(bflo(c2.y) * rs * g1[2], bfhi(c2.y) * rs * g1[3]);
            *(v4u*)(mg + ((size_t)b * T + k1 + 64 * (16 * k2t + row)) * D + DA + lane * 8) = o;
        }
        LDS_WAIT(); asm volatile("" ::: "memory");
    }
}
__device__ __forceinline__ void phase_router(Frame& F, const Args& A) {
    typedef short bf16x8 __attribute__((ext_vector_type(8)));
    LAS int* lcnt = (LAS int*)(F.lds + L_LCNT); LAS int* gbase = (LAS int*)(F.lds + L_GBASE); LAS int* rt = (LAS int*)(F.lds + L_RT);
    const bf16* h = (const bf16*)(F.ws + WS_XN);
    v4u* ent = (v4u*)(F.ws + WS_LIST);
    const float* brc = A.in[11]; const float* brf = A.in[13]; const int lane = F.lane, q16 = lane & 15, g = lane >> 4;
    for (int batch = F.vcu; batch < NTOK / 128; batch += F.G) {
        { const v4u* src = (const v4u*)(F.ws + WS_WR); for (int i = F.tid; i < 72 * 128; i += NWAVES * 64) *(LAS v4u*)(F.lds + (i >> 7) * RT_STRIDE + (i & 127) * 16) = src[i]; }
        if (F.tid < 32) lcnt[F.tid] = 0;
        __syncthreads();
        const int tok0 = batch * 128 + F.wave * 16;
        f32x4 acc[3]; float ssq = 0.f;
#pragma unroll
        for (int nt = 0; nt < 3; ++nt) acc[nt] = (f32x4){0.f, 0.f, 0.f, 0.f};
        const bf16* hp = h + (size_t)(tok0 + q16) * D + 8 * g;
        const LAS unsigned char* w0 = F.lds + q16 * RT_STRIDE + 16 * g; const LAS unsigned char* w1 = w0 + 16 * RT_STRIDE; const LAS unsigned char* w2 = F.lds + min(32 + q16, 35) * RT_STRIDE + 16 * g;
#pragma unroll 4
        for (int ks = 0; ks < 32; ++ks) {
            const bf16x8 hf = *(const bf16x8*)(hp + 32 * ks);
#pragma unroll
            for (int i = 0; i < 8; ++i) { const float v = __builtin_bit_cast(float, (unsigned)(unsigned short)hf[i] << 16); ssq += v * v; }
            acc[0] = __builtin_amdgcn_mfma_f32_16x16x32_bf16(*(const LAS bf16x8*)(w0 + 64 * ks), hf, acc[0], 0, 0, 0);
            acc[0] = __builtin_amdgcn_mfma_f32_16x16x32_bf16(*(const LAS bf16x8*)(w0 + 36 * RT_STRIDE + 64 * ks), hf, acc[0], 0, 0, 0);
            acc[1] = __builtin_amdgcn_mfma_f32_16x16x32_bf16(*(const LAS bf16x8*)(w1 + 64 * ks), hf, acc[1], 0, 0, 0);
            acc[1] = __builtin_amdgcn_mfma_f32_16x16x32_bf16(*(const LAS bf16x8*)(w1 + 36 * RT_STRIDE + 64 * ks), hf, acc[1], 0, 0, 0);
            acc[2] = __builtin_amdgcn_mfma_f32_16x16x32_bf16(*(const LAS bf16x8*)(w2 + 64 * ks), hf, acc[2], 0, 0, 0);
            acc[2] = __builtin_amdgcn_mfma_f32_16x16x32_bf16(*(const LAS bf16x8*)(w2 + 36 * RT_STRIDE + 64 * ks), hf, acc[2], 0, 0, 0);
        }
        ssq += __shfl_xor(ssq, 16); ssq += __shfl_xor(ssq, 32);
        __syncthreads();
        LAS float* lg = (LAS float*)F.lds + (F.wave * 16) * 37;
#pragma unroll
        for (int nt = 0; nt < 3; ++nt)
#pragma unroll
            for (int e = 0; e < 4; ++e) { const int j = 16 * nt + 4 * g + e; if (j < 36) lg[q16 * 37 + j] = acc[nt][e]; }
        LDS_WAIT(); asm volatile("" ::: "memory");
        if (lane < 16) {
            const int tl = F.wave * 16 + lane, tok = batch * 128 + tl; const float rs = 1.0f / sqrtf(ssq * (1.f / D) + EPS); const LAS float* L = lg + lane * 37;
            const float c0 = L[0] * rs + brc[0], c1 = L[1] * rs + brc[1], c2 = L[2] * rs + brc[2], c3 = L[3] * rs + brc[3];
            int gi = 0; float mx = c0;
            if (c1 > mx) { mx = c1; gi = 1; }
            if (c2 > mx) { mx = c2; gi = 2; }
            if (c3 > mx) { mx = c3; gi = 3; }
            const float gwt = 1.0f / (expf(c0 - mx) + expf(c1 - mx) + expf(c2 - mx) + expf(c3 - mx));
            float v0 = -1e30f, v1 = -1e30f; int i0 = 0, i1 = 0;
#pragma unroll
            for (int j = 0; j < 8; ++j) { const float fv = L[4 + gi * 8 + j] * rs + brf[gi * 8 + j];
                if (fv > v0) { v1 = v0; i1 = i0; v0 = fv; i0 = j; } else if (fv > v1) { v1 = fv; i1 = j; } }
            const float e1 = expf(v1 - v0), p0 = 1.f / (1.f + e1), p1 = e1 / (1.f + e1);
            const int ea = gi * 8 + i0, eb = gi * 8 + i1;
            const int ra = __hip_atomic_fetch_add(lcnt + ea, 1, __ATOMIC_RELAXED, __HIP_MEMORY_SCOPE_WORKGROUP);
            const int rb = __hip_atomic_fetch_add(lcnt + eb, 1, __ATOMIC_RELAXED, __HIP_MEMORY_SCOPE_WORKGROUP);
            rt[tl] = ea; rt[128 + tl] = eb; rt[256 + tl] = ra; rt[384 + tl] = rb;
            rt[512 + tl] = __builtin_bit_cast(int, p0 * gwt); rt[640 + tl] = __builtin_bit_cast(int, p1 * gwt); rt[768 + tl] = __builtin_bit_cast(int, rs);
        }
        __syncthreads();
        if (F.tid < 32) gbase[F.tid] = (int)__hip_atomic_fetch_add(F.ctl + CW_CNT + 64 * F.tid, (unsigned)lcnt[F.tid], __ATOMIC_RELAXED, __HIP_MEMORY_SCOPE_AGENT);
        __syncthreads();
        if (F.tid < 256) { const int tl = F.tid & 127, sl = F.tid >> 7, tok = batch * 128 + tl, ee = rt[sl * 128 + tl], rk = rt[256 + sl * 128 + tl] + gbase[ee];
            v4u en; en.x = (unsigned)(2 * tok + sl); en.y = (unsigned)rt[512 + sl * 128 + tl]; en.z = (unsigned)rt[768 + tl]; en.w = 0u;
            *(v4u*)(ent + (size_t)ee * pg8::MOE_CAP + rk) = en; }
        __syncthreads();
    }
}
__device__ __forceinline__ void moe_setup(Frame& F) {
    LAS int* pbase = (LAS int*)(F.lds + L_PBASE); LAS int* lcnt = (LAS int*)(F.lds + L_LCNT);
    if (F.tid < 32) lcnt[F.tid] = (int)__hip_atomic_load(F.ctl + CW_CNT + 64 * F.tid, __ATOMIC_RELAXED, __HIP_MEMORY_SCOPE_AGENT);
    __syncthreads();
    if (F.tid == 0) { int acc = 0; for (int e = 0; e < 32; ++e) { pbase[e] = acc; acc += (lcnt[e] + 255) >> 8; } pbase[32] = acc; }
    __syncthreads();
}
__device__ __forceinline__ void phase_final(Frame& F, const Args& A) {
    const bf16* h = (const bf16*)(F.ws + WS_XN); const bf16* y2 = (const bf16*)(F.ws + WS_X1); const int lane = F.lane;
    f32x4 gv[4];
#pragma unroll
    for (int j = 0; j < 4; ++j) gv[j] = ((const f32x4*)(A.in[17] + lane * 16))[j];
    for (int tok = GW_ID(F); tok < NTOK; tok += N_GW(F)) {
        const v4u* ph = (const v4u*)(h + (size_t)tok * D) + lane * 2; const v4u* p0 = (const v4u*)(y2 + (size_t)(2 * tok) * D) + lane * 2; const v4u* p1 = (const v4u*)(y2 + (size_t)(2 * tok + 1) * D) + lane * 2;
        f32x4 v[4]; float s = 0.f;
#pragma unroll
        for (int hh = 0; hh < 2; ++hh) { const v4u a = ph[hh], b = p0[hh], c = p1[hh];
            v[2 * hh] = (f32x4){bflo(a.x) + bflo(b.x) + bflo(c.x), bfhi(a.x) + bfhi(b.x) + bfhi(c.x), bflo(a.y) + bflo(b.y) + bflo(c.y), bfhi(a.y) + bfhi(b.y) + bfhi(c.y)};
            v[2 * hh + 1] = (f32x4){bflo(a.z) + bflo(b.z) + bflo(c.z), bfhi(a.z) + bfhi(b.z) + bfhi(c.z), bflo(a.w) + bflo(b.w) + bflo(c.w), bfhi(a.w) + bfhi(b.w) + bfhi(c.w)}; }
#pragma unroll
        for (int j = 0; j < 4; ++j) s += (v[j].x * v[j].x + v[j].y * v[j].y) + (v[j].z * v[j].z + v[j].w * v[j].w);
        const float rstd = 1.0f / sqrtf(wave_sum(s) * (1.f / D) + EPS);
        f32x4* dst = (f32x4*)(F.out + (size_t)tok * D + lane * 16);
#pragma unroll
        for (int j = 0; j < 4; ++j) dst[j] = v[j] * rstd * gv[j];
    }
}
__global__ void __launch_bounds__(NWAVES * 64, 2) mega_fwd(Args args) {
    extern __shared__ __attribute__((aligned(16))) unsigned char lds[];
    Frame F;
    F.lds = (LAS unsigned char*)lds;
    F.tid = threadIdx.x; F.lane = F.tid & 63; F.wave = __builtin_amdgcn_readfirstlane(F.tid >> 6);
    F.G = gridDim.x; { const int bx = blockIdx.x; F.vcu = (F.G % 8 == 0) ? (bx % 8) * (F.G / 8) + bx / 8 : bx; }
    F.ws = args.ws; F.ctl = (unsigned*)(args.ws + WS_CTL); F.out = args.out;
    for (int u = F.tid; u < (LDS_BYTES - LDSCTL_OFF) / 4; u += NWAVES * 64) ((LAS unsigned*)(F.lds + LDSCTL_OFF))[u] = 0u;
    __syncthreads();
    XcdBarrier bar = xcd_barrier_post(F.ctl + CW_BAR, (volatile LAS unsigned*)(F.lds + L_MISC) + 8);
#define GRID_BAR() xcd_barrier(bar)
    PG8_LAS unsigned char* ring = (PG8_LAS unsigned char*)lds;
    const pg8::bf16_t* XN = (const pg8::bf16_t*)(F.ws + WS_XN);

    phase_prep(F, args);
    GRID_BAR();
    {
        pg8::Gemm g{XN, (const pg8::bf16_t*)(F.ws + WS_WIN), NTOK, 1024, D}; pg8::StaticOrder S; S.init(NTOK, 1024, F.G, (int)blockIdx.x);
        pg8::EpiBf16 E{(pg8::bf16_t*)(F.ws + WS_QKVU), 512, 512, (size_t)NTOK * 512, QSCALE};
        pg8::gemm_phase<pg8::EpiBf16, pg8::StaticOrder, true, true>(ring, g, S, E);
    }
    {
        pg8::Gemm g{(const pg8::bf16_t*)(F.ws + WS_WIN) + (size_t)1536 * D, XN, 512, NTOK, D}; pg8::StaticOrder S; S.init(512, NTOK, F.G, (int)blockIdx.x);
        pg8::EpiBf16 E{(pg8::bf16_t*)(F.ws + WS_QKVU) + (size_t)3 * NTOK * 512, NTOK, NTOK, 0, 1.0f};
        pg8::gemm_phase<pg8::EpiBf16, pg8::StaticOrder, true, true>(ring, g, S, E);
    }
    {
        pg8::Gemm g{(const pg8::bf16_t*)(F.ws + WS_WIN) + (size_t)1024 * D, XN, 512, NTOK, D}; pg8::StaticOrder S; S.init(512, NTOK, F.G, (int)blockIdx.x);
        pg8::EpiBf16 E{(pg8::bf16_t*)(F.ws + WS_QKVU) + (size_t)2 * NTOK * 512, NTOK, NTOK, 0, 1.0f};
        pg8::gemm_phase<pg8::EpiBf16, pg8::StaticOrder, true, true, pg8::BGridT>(ring, g, S, E);
    }
    GRID_BAR();
    phase_attn(F, args);
    phase_fft1(F, args);
    GRID_BAR();
    phase_fft2(F, args);
    GRID_BAR();
    {
        pg8::Gemm g{(const pg8::bf16_t*)(F.ws + WS_X1), (const pg8::bf16_t*)(F.ws + WS_WOUT), NTOK, D, D}; pg8::StaticOrder S; S.init(NTOK, D, F.G, (int)blockIdx.x);
        pg8::EpiResH E{args.in[0], (pg8::bf16_t*)(F.ws + WS_XN), (const float*)(F.ws + WS_SSQ)};
        pg8::gemm_phase<pg8::EpiResH, pg8::StaticOrder, true, true>(ring, g, S, E);
    }
    GRID_BAR();
    phase_router(F, args);
    GRID_BAR();
    moe_setup(F);
    {
        const pg8::MoeCtx cx{(const PG8_LAS int*)(ring + L_PBASE), (const PG8_LAS int*)(ring + L_LCNT), (const pg8::MoeEnt*)(F.ws + WS_LIST), 2};
        pg8::Gemm g{(const pg8::bf16_t*)(F.ws + WS_XN), (const pg8::bf16_t*)(F.ws + WS_WGU), NTOK, NE * 512, D};
        pg8::MoeOrder S{cx, F.G, (int)blockIdx.x};
        pg8::EpiMoe1 E{cx, (pg8::bf16_t*)(F.ws + WS_HD)};
        pg8::gemm_phase<pg8::EpiMoe1, pg8::MoeOrder, true, true, pg8::BNat, pg8::AGather>(ring, g, S, E);
    }
    GRID_BAR();
    {
        const pg8::MoeCtx cx{(const PG8_LAS int*)(ring + L_PBASE), (const PG8_LAS int*)(ring + L_LCNT), (const pg8::MoeEnt*)(F.ws + WS_LIST), 4};
        pg8::Gemm g{(const pg8::bf16_t*)(F.ws + WS_HD), (const pg8::bf16_t*)(F.ws + WS_WD), MAXROWS, NE * 1024, DE};
        pg8::MoeOrder S{cx, F.G, (int)blockIdx.x};
        pg8::EpiMoe2 E{cx, (pg8::bf16_t*)(F.ws + WS_X1), 2 * NTOK};
        pg8::gemm_phase<pg8::EpiMoe2, pg8::MoeOrder, true, true>(ring, g, S, E);
    }
    GRID_BAR();
    phase_final(F, args);
}

extern "C" void kernel_launch(void* const* d_in, const int* in_sizes, int n_in, void* d_out, int out_size, void* d_ws, size_t ws_size, hipStream_t stream) {
    static int grid = 0;
    if (grid == 0) {
        if (n_in != 18 || out_size != NTOK * D || ws_size < WS_END) { fprintf(stderr, "kernel_launch: unexpected problem shape (n_in %d, out %d, ws %zu)\n", n_in, out_size, ws_size); grid = -1; return; }
        int dev = 0, cus = 0;
        if (hipGetDevice(&dev) != hipSuccess || hipDeviceGetAttribute(&cus, hipDeviceAttributeMultiprocessorCount, dev) != hipSuccess) { grid = -1; return; }
        if (hipFuncSetAttribute((const void*)mega_fwd, hipFuncAttributeMaxDynamicSharedMemorySize, LDS_BYTES) != hipSuccess) { fprintf(stderr, "kernel_launch: hipFuncSetAttribute failed\n"); grid = -1; return; }
        int per_cu = 0;
        if (hipOccupancyMaxActiveBlocksPerMultiprocessor(&per_cu, (const void*)mega_fwd, NWAVES * 64, LDS_BYTES) != hipSuccess || per_cu < 1) { fprintf(stderr, "kernel_launch: occupancy query says %d blocks per CU\n", per_cu); }
        (void)hipGetLastError();
        grid = cus;
    }
    if (grid < 0) return;
    (void)hipMemsetAsync((char*)d_ws + WS_CTL, 0, CTL_ZERO_BYTES, stream);
    Args a{};
    for (int i = 0; i < 18; ++i) a.in[i] = (const float*)d_in[i];
    a.out = (float*)d_out; a.ws = (unsigned char*)d_ws;
    hipLaunchKernelGGL(mega_fwd, dim3(grid), dim3(NWAVES * 64), LDS_BYTES, stream, a);
}
```
